# Optimizing an MI355X kernel written in HIP

```python
import math, functools
import jax, jax.numpy as jnp
from jax import lax
import numpy as np

D_MODEL = 1024
BATCH = 2
SEQ = 8192
DEPTH = 1
DEC_BATCH = 128
DEC_SEQ = 8
PAST_LEN = 8192
PAGE_SIZE = 128

MLA_HEADS = 8
MLA_NOPE = 64
MLA_ROPE = 32
MLA_V = 64
Q_LORA = 384
KV_LORA = 256
ROPE_THETA = 10000.0
MLA_SCALE = (MLA_NOPE + MLA_ROPE) ** -0.5
Q_BLOCK = 128
SSD_HEADS = 8
SSD_HEAD_DIM = 64
D_SSM = SSD_HEADS * SSD_HEAD_DIM
SSD_GROUPS = 2
D_STATE = 128
D_CONV = 4
SSD_CHUNK = 128
CONV_DIM = D_SSM + 2 * SSD_GROUPS * D_STATE
D_MIX = MLA_HEADS * MLA_V + D_SSM
IN_DIM = Q_LORA + KV_LORA + MLA_ROPE + D_SSM + CONV_DIM + SSD_HEADS
N_MEM = 256
MEM_HEADS = 4
MEM_HEAD_DIM = D_MODEL // MEM_HEADS
PEER_HEADS = 8
N_KEYS = 128
N_EXPERTS = N_KEYS * N_KEYS
PEER_KEY_DIM = 256
PEER_TOPK = 16
PEER_BLOCK = 256
DN_ALPHA = (2 * DEPTH) ** 0.25
DN_BETA = (8 * DEPTH) ** -0.25

kernel_name = 'hymba_mla_ssd_peer_deepnorm_step'


def rms_norm(x, g, eps=1e-6):
    xf = x.astype(jnp.float32)
    y = xf * lax.rsqrt(jnp.mean(xf * xf, axis=-1, keepdims=True) + eps)
    return (y * g.astype(jnp.float32)).astype(x.dtype)


def layer_norm(x, g, b, eps=1e-5):
    xf = x.astype(jnp.float32)
    mu = jnp.mean(xf, axis=-1, keepdims=True)
    var = jnp.mean(jnp.square(xf - mu), axis=-1, keepdims=True)
    y = (xf - mu) * lax.rsqrt(var + eps) * g.astype(jnp.float32) + b.astype(jnp.float32)
    return y.astype(x.dtype)


def post_norm(x, f, g, b):
    return layer_norm(DN_ALPHA * x + f.astype(x.dtype), g, b)


def rope(x, pos):
    half = MLA_ROPE // 2
    inv = ROPE_THETA ** (-jnp.arange(half, dtype=jnp.float32) / half)
    ang = pos.astype(jnp.float32)[:, None] * inv[None, :]
    shp = (ang.shape[0],) + (1,) * (x.ndim - 3) + (half,)
    cos, sin = jnp.cos(ang).reshape(shp), jnp.sin(ang).reshape(shp)
    xf = x.astype(jnp.float32)
    x1, x2 = xf[..., :half], xf[..., half:]
    return jnp.concatenate([x1 * cos - x2 * sin, x2 * cos + x1 * sin], axis=-1).astype(x.dtype)


def split_in(u):
    o1 = Q_LORA
    o2 = o1 + KV_LORA
    o3 = o2 + MLA_ROPE
    o4 = o3 + D_SSM
    o5 = o4 + CONV_DIM
    return jnp.split(u, [o1, o2, o3, o4, o5], axis=-1)


def mla_project(cq, ckv, kpe, pos, lw):
    cq = rms_norm(cq, lw['q_a_norm'])
    q = jnp.einsum('bsc,chd->bshd', cq, lw['w_uq'])
    q_nope, q_pe = q[..., :MLA_NOPE], rope(q[..., MLA_NOPE:], pos)
    c_kv = rms_norm(ckv, lw['kv_a_norm'])
    k_pe = rope(kpe, pos)
    return q_nope, q_pe, c_kv, k_pe


def mla_attend_prompt(q_nope, q_pe, c_kv, k_pe, lw):
    seq = q_nope.shape[1]
    k_nope = jnp.einsum('bkc,chd->bkhd', c_kv, lw['w_uk'])
    v = jnp.einsum('bkc,chv->bkhv', c_kv, lw['w_uv'])
    outs = []
    for i in range(seq // Q_BLOCK):
        lo, hi = i * Q_BLOCK, (i + 1) * Q_BLOCK
        s = (jnp.einsum('bqhd,bkhd->bhqk', q_nope[:, lo:hi], k_nope[:, :hi])
             + jnp.einsum('bqhr,bkr->bhqk', q_pe[:, lo:hi], k_pe[:, :hi])).astype(jnp.float32) * MLA_SCALE
        mask = jnp.arange(hi)[None, :] <= jnp.arange(lo, hi)[:, None]
        p = jax.nn.softmax(jnp.where(mask, s, -jnp.inf), axis=-1).astype(v.dtype)
        outs.append(jnp.einsum('bhqk,bkhv->bqhv', p, v[:, :hi]))
    return jnp.concatenate(outs, axis=1)


def mla_attend_sample(q_nope, q_pe, c_kv, k_pe, lw, cache_c, cache_r, page_table, layer):
    dbsz, dseq = q_nope.shape[:2]
    past = page_table.shape[1] * PAGE_SIZE
    c_past = cache_c[layer, page_table].reshape(dbsz, past, KV_LORA)
    r_past = cache_r[layer, page_table].reshape(dbsz, past, MLA_ROPE)
    q_lat = jnp.einsum('bqhd,chd->bqhc', q_nope, lw['w_uk'])
    s_past = (jnp.einsum('bqhc,bkc->bhqk', q_lat, c_past)
              + jnp.einsum('bqhr,bkr->bhqk', q_pe, r_past)).astype(jnp.float32)
    s_new = (jnp.einsum('bqhc,bkc->bhqk', q_lat, c_kv)
             + jnp.einsum('bqhr,bkr->bhqk', q_pe, k_pe)).astype(jnp.float32)
    s_new = jnp.where(jnp.tril(jnp.ones((dseq, dseq), bool)), s_new, -jnp.inf)
    p = jax.nn.softmax(jnp.concatenate([s_past, s_new], axis=-1) * MLA_SCALE, axis=-1).astype(c_kv.dtype)
    o_lat = (jnp.einsum('bhqk,bkc->bqhc', p[..., :past], c_past)
             + jnp.einsum('bhqk,bkc->bqhc', p[..., past:], c_kv))
    return jnp.einsum('bqhc,chv->bqhv', o_lat, lw['w_uv'])


def ssd_scan(x, a, bm, cm, h0, chunk):
    bsz, s, nh, hp = x.shape
    nc = s // chunk
    x = x.reshape(bsz, nc, chunk, nh, hp)
    bm = bm.reshape(bsz, nc, chunk, nh, D_STATE)
    cm = cm.reshape(bsz, nc, chunk, nh, D_STATE)
    a_cum = jnp.cumsum(a.reshape(bsz, nc, chunk, nh).transpose(0, 3, 1, 2), axis=-1)
    causal = jnp.tril(jnp.ones((chunk, chunk), bool))
    seg = a_cum[..., :, None] - a_cum[..., None, :]
    decay = jnp.exp(jnp.where(causal, seg, -jnp.inf))
    scores = jnp.einsum('bclhn,bcshn->bhcls', cm, bm) * decay
    y_diag = jnp.einsum('bhcls,bcshp->bclhp', scores, x)
    decay_states = jnp.exp(a_cum[..., -1:] - a_cum)
    states = jnp.einsum('bclhn,bhcl,bclhp->bchpn', bm, decay_states, x)
    chunk_decay = jnp.exp(a_cum[..., -1])

    def step(h, inp):
        dec, st = inp
        return dec[:, :, None, None] * h + st, h

    h_last, h_prev = lax.scan(step, h0, (chunk_decay.transpose(2, 0, 1), states.transpose(1, 0, 2, 3, 4)))
    y_off = jnp.einsum('bclhn,cbhpn,bhcl->bclhp', cm, h_prev, jnp.exp(a_cum))
    return (y_diag + y_off).reshape(bsz, s, nh, hp), h_last


def ssd_mixer(xbc, z, dt_raw, conv_state, ssm_state, chunk, lw):
    bsz, s, _ = xbc.shape
    full = jnp.concatenate([conv_state.astype(xbc.dtype), xbc], axis=1)
    conv = lax.conv_general_dilated(full, lw['conv_w'][:, None, :], window_strides=(1,), padding='VALID',
                                    dimension_numbers=('NWC', 'WIO', 'NWC'),
                                    feature_group_count=CONV_DIM) + lw['conv_b']
    new_conv = full[:, full.shape[1] - (D_CONV - 1):, :]
    u = jax.nn.silu(conv).astype(jnp.float32)
    rep = SSD_HEADS // SSD_GROUPS
    xs = u[..., :D_SSM].reshape(bsz, s, SSD_HEADS, SSD_HEAD_DIM)
    bm = jnp.repeat(u[..., D_SSM:D_SSM + SSD_GROUPS * D_STATE].reshape(bsz, s, SSD_GROUPS, D_STATE), rep, axis=2)
    cm = jnp.repeat(u[..., D_SSM + SSD_GROUPS * D_STATE:].reshape(bsz, s, SSD_GROUPS, D_STATE), rep, axis=2)
    dt = jax.nn.softplus(dt_raw.astype(jnp.float32) + lw['dt_bias'].astype(jnp.float32))
    a = -jnp.exp(lw['a_log'].astype(jnp.float32))
    y, h_last = ssd_scan(xs * dt[..., None], dt * a, bm, cm, ssm_state.astype(jnp.float32), chunk)
    y = (y + lw['d_skip'].astype(jnp.float32)[:, None] * xs).reshape(bsz, s, D_SSM)
    gated = (y * jax.nn.silu(z.astype(jnp.float32))).reshape(bsz, s, SSD_GROUPS, D_SSM // SSD_GROUPS)
    out = rms_norm(gated, lw['ssm_norm'].reshape(SSD_GROUPS, D_SSM // SSD_GROUPS)).reshape(bsz, s, D_SSM)
    return out.astype(z.dtype), new_conv, h_last


def mixer_sublayer(h, pos, conv_state, ssm_state, chunk, attend, lw):
    bsz, s, _ = h.shape
    cq, ckv, kpe, z, xbc, dt_raw = split_in(h @ lw['w_in'])
    q_nope, q_pe, c_kv, k_pe = mla_project(cq, ckv, kpe, pos, lw)
    o_attn = attend(q_nope, q_pe, c_kv, k_pe, lw).reshape(bsz, s, MLA_HEADS * MLA_V)
    o_attn = rms_norm(o_attn, lw['attn_out_norm'])
    y_ssm, new_conv, new_ssm = ssd_mixer(xbc, z, dt_raw, conv_state, ssm_state, chunk, lw)
    mix = jnp.concatenate([o_attn, y_ssm.astype(o_attn.dtype)], axis=-1) @ lw['w_out']
    return mix, c_kv, k_pe, new_conv, new_ssm


def memory_kv(mem, lw):
    b, m, _ = mem.shape
    k = (mem @ lw['mem_wk']).reshape(b, m, MEM_HEADS, MEM_HEAD_DIM)
    v = (mem @ lw['mem_wv']).reshape(b, m, MEM_HEADS, MEM_HEAD_DIM)
    return k, v


def memory_attend(x, mem_k, mem_v, lw):
    b, s, _ = x.shape
    q = (x @ lw['mem_wq']).reshape(b, s, MEM_HEADS, MEM_HEAD_DIM)
    sc = jnp.einsum('bshd,bmhd->bhsm', q, mem_k.astype(q.dtype)).astype(jnp.float32) * (MEM_HEAD_DIM ** -0.5)
    p = jax.nn.softmax(sc, axis=-1).astype(q.dtype)
    o = jnp.einsum('bhsm,bmhd->bshd', p, mem_v.astype(q.dtype)).reshape(b, s, D_MODEL)
    return o @ lw['mem_wo']


def peer_ffn(x, lw):
    lead = x.shape[:-1]
    t = x.reshape(-1, D_MODEL)
    n = t.shape[0]
    nb = -(-n // PEER_BLOCK)
    t = jnp.pad(t, ((0, nb * PEER_BLOCK - n), (0, 0))).reshape(nb, PEER_BLOCK, D_MODEL)
    half = PEER_KEY_DIM // 2

    def block(tb):
        q = (tb @ lw['peer_wq']).reshape(PEER_BLOCK, PEER_HEADS, 2, half)
        s = jnp.einsum('thjd,hjkd->thjk', q, lw['peer_keys']).astype(jnp.float32)
        top_s, top_i = lax.top_k(s, PEER_TOPK)
        cand_s = (top_s[:, :, 0, :, None] + top_s[:, :, 1, None, :]).reshape(PEER_BLOCK, PEER_HEADS, -1)
        cand_i = (top_i[:, :, 0, :, None] * N_KEYS + top_i[:, :, 1, None, :]).reshape(PEER_BLOCK, PEER_HEADS, -1)
        best_s, best_pos = lax.top_k(cand_s, PEER_TOPK)
        idx = jnp.take_along_axis(cand_i, best_pos, axis=-1)
        g = jax.nn.softmax(best_s, axis=-1)
        act = jax.nn.gelu(jnp.einsum('thkd,td->thk', lw['peer_u'][idx], tb), approximate=False)
        w = (g * act.astype(jnp.float32)).astype(tb.dtype)
        return jnp.einsum('thk,thkd->td', w, lw['peer_v'][idx])

    out = lax.map(block, t)
    return out.reshape(nb * PEER_BLOCK, D_MODEL)[:n].reshape(*lead, D_MODEL).astype(x.dtype)


def memory_and_channel(h, mem_k, mem_v, lw):
    h = post_norm(h, memory_attend(h, mem_k, mem_v, lw), lw['ln2_g'], lw['ln2_b'])
    return post_norm(h, peer_ffn(h, lw), lw['ln3_g'], lw['ln3_b'])


def setup_inputs(seed: int = 0) -> dict:
    key = jax.random.key(seed)
    keys = iter(jax.random.split(key, 64))
    f32 = jnp.float32

    def nrm(shape, scale=1.0):
        return scale * jax.random.normal(next(keys), shape, f32)

    def gain(shape):
        return 1.0 + 0.02 * jax.random.normal(next(keys), shape, f32)

    L = DEPTH
    n_pages = PAST_LEN // PAGE_SIZE
    n_used = DEC_BATCH * n_pages
    n_pool = n_used + max(1, n_used // 4)
    page_table = jax.random.permutation(next(keys), n_pool)[:n_used].reshape(DEC_BATCH, n_pages).astype(jnp.int32)
    dt0 = jnp.exp(jax.random.uniform(next(keys), (L, SSD_HEADS), f32, math.log(1e-3), math.log(1e-1)))
    dt_bias = dt0 + jnp.log(-jnp.expm1(-dt0))
    a_log = jnp.log(jax.random.uniform(next(keys), (L, SSD_HEADS), f32, 1.0, 16.0))
    return {
        'x_prompt': nrm((BATCH, SEQ, D_MODEL)),
        'x_sample': nrm((DEC_BATCH, DEC_SEQ, D_MODEL)),
        'mem_prompt': nrm((BATCH, N_MEM, D_MODEL)),
        'cache_kv_latent': nrm((L, n_pool, PAGE_SIZE, KV_LORA)),
        'cache_k_rope': nrm((L, n_pool, PAGE_SIZE, MLA_ROPE)),
        'state_conv': nrm((L, DEC_BATCH, D_CONV - 1, CONV_DIM)),
        'state_ssm': nrm((L, DEC_BATCH, SSD_HEADS, SSD_HEAD_DIM, D_STATE), 0.1),
        'cache_mem_k': nrm((L, DEC_BATCH, N_MEM, MEM_HEADS, MEM_HEAD_DIM)),
        'cache_mem_v': nrm((L, DEC_BATCH, N_MEM, MEM_HEADS, MEM_HEAD_DIM), DN_BETA),
        'page_table': page_table,
        'w_in': nrm((L, D_MODEL, IN_DIM), D_MODEL ** -0.5),
        'q_a_norm': gain((L, Q_LORA)),
        'w_uq': nrm((L, Q_LORA, MLA_HEADS, MLA_NOPE + MLA_ROPE), Q_LORA ** -0.5),
        'kv_a_norm': gain((L, KV_LORA)),
        'w_uk': nrm((L, KV_LORA, MLA_HEADS, MLA_NOPE), KV_LORA ** -0.5),
        'w_uv': nrm((L, KV_LORA, MLA_HEADS, MLA_V), DN_BETA * KV_LORA ** -0.5),
        'attn_out_norm': gain((L, MLA_HEADS * MLA_V)),
        'conv_w': nrm((L, D_CONV, CONV_DIM), D_CONV ** -0.5),
        'conv_b': nrm((L, CONV_DIM), 0.02),
        'dt_bias': dt_bias,
        'a_log': a_log,
        'd_skip': 1.0 + nrm((L, SSD_HEADS), 0.1),
        'ssm_norm': gain((L, D_SSM)),
        'w_out': nrm((L, D_MIX, D_MODEL), DN_BETA * D_MIX ** -0.5),
        'ln1_g': gain((L, D_MODEL)),
        'ln1_b': nrm((L, D_MODEL), 0.02),
        'mem_wq': nrm((L, D_MODEL, D_MODEL), D_MODEL ** -0.5),
        'mem_wk': nrm((L, D_MODEL, D_MODEL), D_MODEL ** -0.5),
        'mem_wv': nrm((L, D_MODEL, D_MODEL), DN_BETA * D_MODEL ** -0.5),
        'mem_wo': nrm((L, D_MODEL, D_MODEL), DN_BETA * D_MODEL ** -0.5),
        'ln2_g': gain((L, D_MODEL)),
        'ln2_b': nrm((L, D_MODEL), 0.02),
        'peer_wq': nrm((L, D_MODEL, PEER_HEADS * PEER_KEY_DIM), D_MODEL ** -0.5),
        'peer_keys': nrm((L, PEER_HEADS, 2, N_KEYS, PEER_KEY_DIM // 2), (PEER_KEY_DIM // 2) ** -0.5),
        'peer_u': nrm((L, N_EXPERTS, D_MODEL), D_MODEL ** -0.5),
        'peer_v': nrm((L, N_EXPERTS, D_MODEL), DN_BETA * PEER_HEADS ** -0.5),
        'ln3_g': gain((L, D_MODEL)),
        'ln3_b': nrm((L, D_MODEL), 0.02),
    }


def reference(x_prompt, x_sample, mem_prompt, cache_kv_latent, cache_k_rope, state_conv, state_ssm,
              cache_mem_k, cache_mem_v, page_table, w_in, q_a_norm, w_uq, kv_a_norm, w_uk, w_uv,
              attn_out_norm, conv_w, conv_b, dt_bias, a_log, d_skip, ssm_norm, w_out, ln1_g, ln1_b,
              mem_wq, mem_wk, mem_wv, mem_wo, ln2_g, ln2_b, peer_wq, peer_keys, peer_u, peer_v,
              ln3_g, ln3_b):
    bsz, seq, _ = x_prompt.shape
    dseq = x_sample.shape[1]
    past = page_table.shape[1] * PAGE_SIZE
    pos_p = jnp.arange(seq, dtype=jnp.int32)
    pos_s = past + jnp.arange(dseq, dtype=jnp.int32)
    hp, hs = x_prompt, x_sample
    kv_p, kr_p, cv_p, ss_p, mk_p, mv_p = [], [], [], [], [], []
    kv_s, kr_s, cv_s, ss_s = [], [], [], []
    for l in range(DEPTH):
        lw = dict(w_in=w_in[l], q_a_norm=q_a_norm[l], w_uq=w_uq[l], kv_a_norm=kv_a_norm[l], w_uk=w_uk[l],
                  w_uv=w_uv[l], attn_out_norm=attn_out_norm[l], conv_w=conv_w[l], conv_b=conv_b[l],
                  dt_bias=dt_bias[l], a_log=a_log[l], d_skip=d_skip[l], ssm_norm=ssm_norm[l], w_out=w_out[l],
                  ln1_g=ln1_g[l], ln1_b=ln1_b[l], mem_wq=mem_wq[l], mem_wk=mem_wk[l], mem_wv=mem_wv[l],
                  mem_wo=mem_wo[l], ln2_g=ln2_g[l], ln2_b=ln2_b[l], peer_wq=peer_wq[l], peer_keys=peer_keys[l],
                  peer_u=peer_u[l], peer_v=peer_v[l], ln3_g=ln3_g[l], ln3_b=ln3_b[l])
        conv0 = jnp.zeros((bsz, D_CONV - 1, CONV_DIM), hp.dtype)
        ssm0 = jnp.zeros((bsz, SSD_HEADS, SSD_HEAD_DIM, D_STATE), jnp.float32)
        mix, c_new, r_new, conv_new, ssm_new = mixer_sublayer(hp, pos_p, conv0, ssm0, SSD_CHUNK,
                                                              mla_attend_prompt, lw)
        hp = post_norm(hp, mix, lw['ln1_g'], lw['ln1_b'])
        mem_k, mem_v = memory_kv(mem_prompt, lw)
        hp = memory_and_channel(hp, mem_k, mem_v, lw)
        kv_p.append(c_new); kr_p.append(r_new); cv_p.append(conv_new); ss_p.append(ssm_new)
        mk_p.append(mem_k); mv_p.append(mem_v)
        attend_s = functools.partial(mla_attend_sample, cache_c=cache_kv_latent, cache_r=cache_k_rope,
                                     page_table=page_table, layer=l)
        mix, c_new, r_new, conv_new, ssm_new = mixer_sublayer(hs, pos_s, state_conv[l], state_ssm[l], dseq,
                                                              attend_s, lw)
        hs = post_norm(hs, mix, lw['ln1_g'], lw['ln1_b'])
        hs = memory_and_channel(hs, cache_mem_k[l], cache_mem_v[l], lw)
        kv_s.append(c_new); kr_s.append(r_new); cv_s.append(conv_new); ss_s.append(ssm_new)
    return (hp, hs, jnp.stack(kv_p), jnp.stack(kr_p), jnp.stack(cv_p), jnp.stack(ss_p), jnp.stack(mk_p),
            jnp.stack(mv_p), jnp.stack(kv_s), jnp.stack(kr_s), jnp.stack(cv_s), jnp.stack(ss_s))
```

```cpp
#include <hip/hip_runtime.h>
#include <cstdio>
#include <cstdint>
namespace pg8 {
#define PG8_LAS __attribute__((address_space(3)))
typedef unsigned short bf16_t;
typedef short bf16x8 __attribute__((ext_vector_type(8)));
typedef float f32x4 __attribute__((ext_vector_type(4)));
typedef unsigned u32x4 __attribute__((ext_vector_type(4)));
constexpr int BM = 256, BK = 64, HALF = 128, HTB = HALF * BK * 2  , STAGE_BYTES = 8 * HTB, NXCD = 8, WGM = 8;

__host__ __device__ __forceinline__ int lds_byte(int r, int c) { const int st = (r >> 4) * 2 + (c >> 5), rr = r & 15, cc = c & 31, ob = rr * 64 + cc * 2; return st * 1024 + (ob ^ (((ob >> 9) & 1) << 5)); }
__host__ __device__ __forceinline__ void stage_rc(int b, int& R, int& C) { const int st = b / 1024, sb = b % 1024, swz = sb ^ (((sb >> 9) & 1) << 5); R = (st >> 1) * 16 + swz / 64; C = (st & 1) * 32 + (swz % 64) / 2; }
__host__ __device__ __forceinline__ int perm32(int rho) { const int n = rho >> 4, i = rho & 15; return 8 * (i >> 2) + 4 * n + (i & 3); }

struct Unit { int pm, pn; };
struct Gemm { const bf16_t* A; const bf16_t* Bt; int M, N, K; };

struct StaticOrder {
    int nM, nN, nwg, G, c;
    __host__ __device__ void init(int M, int N, int G_, int c_) { nM = M / BM; nN = N / BM; nwg = nM * nN; G = G_; c = c_; }
    __host__ __device__ bool next(int i, Unit& u) const {
        const long L = (long)i * G + c; if (L >= nwg) return false;
        int wgid = (int)L; { const int q = nwg / NXCD, r = nwg % NXCD, xcd = wgid % NXCD, off = wgid / NXCD; wgid = (xcd < r ? xcd * (q + 1) : r * (q + 1) + (xcd - r) * q) + off; }
        const int nig = WGM * nN, gid = wgid / nig, fm = gid * WGM, gsz = (nM - fm) < WGM ? (nM - fm) : WGM;
        u.pm = fm + ((wgid % nig) % gsz); u.pn = (wgid % nig) / gsz; return true;
    }
    __device__ __forceinline__ void a_ready(const Unit&) const {}
    __device__ __forceinline__ void done(const Unit&) const {}
};

__device__ __forceinline__ unsigned cvt_pk_bf16(float lo, float hi) { unsigned r; asm volatile("v_cvt_pk_bf16_f32 %0, %1, %2" : "=v"(r) : "v"(lo), "v"(hi)); return r; }
typedef float f32x2 __attribute__((ext_vector_type(2)));
__device__ __forceinline__ f32x2 gelu_pk(f32x2 v) {
    const f32x2 av = __builtin_elementwise_abs(v), d = av * 0.2316418882f + 1.0f;
    f32x2 t; t.x = __builtin_amdgcn_rcpf(d.x); t.y = __builtin_amdgcn_rcpf(d.y);
    f32x2 q = t * 0.5307027145f + (-0.7265760135f); q = q * t + 0.7107068705f; q = q * t + (-0.142248368f); q = q * t + 0.127414796f; q = q * t;
    const f32x2 s = (v * v) * (-0.72134752044f);
    f32x2 e; e.x = __builtin_amdgcn_exp2f(s.x); e.y = __builtin_amdgcn_exp2f(s.y);
    const f32x2 m = v * (q * e), r = v - m;
    f32x2 o; o.x = v.x < 0.f ? m.x : r.x; o.y = v.y < 0.f ? m.y : r.y; return o;
}

template <int ACT  > struct EpiBf16 {
    static constexpr bool PERM = true, AFTER_DRAIN = false; static_assert(ACT == 0 || ACT == 1, "EpiBf16: ACT is 0 (none) or 1 (gelu_pk)");
    bf16_t* O; int ldc; const float* bias; int split_cols; size_t split_stride; float scale0;
    __device__ __forceinline__ void operator()(const f32x4 (&acc)[2][2][4][2], const Unit& u, int wr, int wc, int fr, int fq) const {
        const int row0 = u.pm * BM + wr * 64 + fr; int colt = u.pn * BM; bf16_t* base = O;
        float sc = 1.f; if (split_cols) { const int t = colt / split_cols; base += (size_t)t * split_stride; colt -= t * split_cols; if (t == 0) sc = scale0; }
        const int col0 = colt + wc * 32 + 8 * fq, bcol0 = u.pn * BM + wc * 32 + 8 * fq;
        f32x4 bv[2][2];
#pragma unroll
        for (int bj = 0; bj < 2; ++bj)
#pragma unroll
            for (int n = 0; n < 2; ++n) bv[bj][n] = bias ? *(const f32x4*)(bias + bcol0 + bj * HALF + 4 * n) : (f32x4){0.f, 0.f, 0.f, 0.f};
#pragma unroll
        for (int ai = 0; ai < 2; ++ai)
#pragma unroll
            for (int m = 0; m < 4; ++m) { bf16_t* rowp = base + (size_t)(row0 + ai * HALF + m * 16) * ldc + col0;
#pragma unroll
                for (int bj = 0; bj < 2; ++bj) { f32x4 v0 = acc[ai][bj][m][0] + bv[bj][0], v1 = acc[ai][bj][m][1] + bv[bj][1];
                    if (ACT == 1) { f32x2 a = gelu_pk((f32x2){v0[0], v0[1]}), b = gelu_pk((f32x2){v0[2], v0[3]}), c = gelu_pk((f32x2){v1[0], v1[1]}), d = gelu_pk((f32x2){v1[2], v1[3]});
                        v0 = (f32x4){a.x, a.y, b.x, b.y}; v1 = (f32x4){c.x, c.y, d.x, d.y}; }
                    v0 = v0 * sc; v1 = v1 * sc; u32x4 w; w.x = cvt_pk_bf16(v0[0], v0[1]); w.y = cvt_pk_bf16(v0[2], v0[3]); w.z = cvt_pk_bf16(v1[0], v1[1]); w.w = cvt_pk_bf16(v1[2], v1[3]);
                    *(u32x4*)(rowp + bj * HALF) = w; } }
    }
};

template <class Epi, class Sched, bool ALIGN_EPI = false, bool SP2 = false>
__device__ __forceinline__ void gemm_phase(PG8_LAS unsigned char* lds, const Gemm g, const Sched& S, const Epi& E) {
    const int tid = threadIdx.x, wid = __builtin_amdgcn_readfirstlane(tid >> 6), lane = tid & 63, wr = wid >> 2, wc = wid & 3, fr = lane & 15, fq = lane >> 4;
    const int K = g.K, nt = K / BK;
    unsigned voffA[2], voffB[2];
#pragma unroll
    for (int i = 0; i < 2; ++i) { int R, C; stage_rc(tid * 16 + i * 8192, R, C); const int Rb = Epi::PERM ? ((R & ~31) + perm32(R & 31)) : R;
        voffA[i] = (unsigned)(R * K + C) * 2u; voffB[i] = (unsigned)(Rb * K + C) * 2u; }
    const size_t kstep = (size_t)(BK * 2);
    const size_t hstep = (size_t)HALF * K * 2;
    const size_t tstep = 2 * hstep;
    const unsigned ldsw = (unsigned)wid * 1024u;
    const int aoff = lds_byte(wr * 64 + fr, fq * 8), boff = lds_byte(wc * 32 + fr, fq * 8);
#define PG8_SA(b, h) (((b) * 2 + (h)) * HTB)
#define PG8_SB(b, h) ((4 + (b) * 2 + (h)) * HTB)
#define PG8_STAGE(bufoff, gbase, voff) do { _Pragma("unroll") for (int _i = 0; _i < 2; ++_i) \
        __builtin_amdgcn_global_load_lds((const unsigned*)((const char*)(gbase) + (voff)[_i]), (PG8_LAS unsigned*)(lds + (bufoff) + ldsw + _i * 8192), 16, 0, 0); } while (0)
#define PG8_LDA(dst, b, h) do { _Pragma("unroll") for (int m = 0; m < 4; ++m) _Pragma("unroll") for (int k = 0; k < 2; ++k) dst[m][k] = *(const PG8_LAS bf16x8*)(lds + PG8_SA(b, h) + aoff + m * 2048 + k * 1024); } while (0)
#define PG8_LDB(dst, b, h) do { _Pragma("unroll") for (int n = 0; n < 2; ++n) _Pragma("unroll") for (int k = 0; k < 2; ++k) dst[n][k] = *(const PG8_LAS bf16x8*)(lds + PG8_SB(b, h) + boff + n * 2048 + k * 1024); } while (0)
#define PG8_MMA(ai, bj, At, Bt) do { __builtin_amdgcn_s_setprio(1); _Pragma("unroll") for (int m = 0; m < 4; ++m) _Pragma("unroll") for (int n = 0; n < 2; ++n) _Pragma("unroll") for (int k = 0; k < 2; ++k) \
        acc[ai][bj][m][n] = __builtin_amdgcn_mfma_f32_16x16x32_bf16(Bt[n][k], At[m][k], acc[ai][bj][m][n], 0, 0, 0); __builtin_amdgcn_s_setprio(0); } while (0)
#define PG8_WAIT_V(n) asm volatile("s_waitcnt vmcnt(" #n ")" ::: "memory")
#define PG8_WAIT_L(n) asm volatile("s_waitcnt lgkmcnt(" #n ")" ::: "memory")
#define PG8_BAR __builtin_amdgcn_s_barrier()
#define PG8_SCHED __builtin_amdgcn_sched_barrier(0)
    Unit cur, nxt; int ui = 0;
    if (!S.next(0, cur)) return;
    f32x4 acc[2][2][4][2];
#pragma unroll
    for (int a = 0; a < 2; ++a)
#pragma unroll
        for (int b = 0; b < 2; ++b)
#pragma unroll
            for (int m = 0; m < 4; ++m)
#pragma unroll
                for (int n = 0; n < 2; ++n) acc[a][b][m][n] = (f32x4){0.f, 0.f, 0.f, 0.f};
    bf16x8 At[4][2], B0[2][2], B1[2][2];
    const char* cA = (const char*)g.A + (size_t)cur.pm * tstep; const char* cB = (const char*)g.Bt + (size_t)cur.pn * tstep;
    S.a_ready(cur);
    if constexpr (SP2) {
        PG8_STAGE(PG8_SB(0, 0), cB, voffB); PG8_STAGE(PG8_SB(0, 1), cB + hstep, voffB); PG8_STAGE(PG8_SA(0, 0), cA, voffA); PG8_STAGE(PG8_SA(0, 1), cA + hstep, voffA);
        if (wr == 1) PG8_BAR;
        PG8_WAIT_V(2); PG8_BAR;
        PG8_STAGE(PG8_SB(1, 0), cB + kstep, voffB); PG8_STAGE(PG8_SA(1, 0), cA + kstep, voffA); PG8_STAGE(PG8_SB(1, 1), cB + hstep + kstep, voffB);
        PG8_WAIT_V(6); PG8_BAR;
    } else {
        PG8_STAGE(PG8_SB(0, 0), cB, voffB); PG8_STAGE(PG8_SA(0, 0), cA, voffA); PG8_STAGE(PG8_SB(0, 1), cB + hstep, voffB); PG8_STAGE(PG8_SA(0, 1), cA + hstep, voffA);
        if (wr == 1) PG8_BAR;
        PG8_WAIT_V(4); PG8_BAR;
        PG8_STAGE(PG8_SB(1, 0), cB + kstep, voffB); PG8_STAGE(PG8_SA(1, 0), cA + kstep, voffA); PG8_STAGE(PG8_SB(1, 1), cB + hstep + kstep, voffB);
        PG8_WAIT_V(6); PG8_BAR;
    }
    for (;;) {
        const bool has_next = S.next(ui + 1, nxt);
        const char* nA = has_next ? (const char*)g.A + (size_t)nxt.pm * tstep : cA; const char* nB = has_next ? (const char*)g.Bt + (size_t)nxt.pn * tstep : cB;
        for (int t = 0; t < nt; t += 2) {
            const bool last = (t == nt - 2);
            const char* a1 = cA + (size_t)(t + 1) * kstep;
            const char* a2 = last ? nA : cA + (size_t)(t + 2) * kstep; const char* b2 = last ? nB : cB + (size_t)(t + 2) * kstep;
            const char* a3 = a2 + kstep; const char* b3 = b2 + kstep;
            if (last && has_next) S.a_ready(nxt);
            if constexpr (SP2) {
            PG8_LDB(B0, 0, 0); PG8_LDB(B1, 0, 1); PG8_SCHED; PG8_LDA(At, 0, 0); PG8_STAGE(PG8_SA(1, 1), a1 + hstep, voffA);
            PG8_WAIT_V(8); PG8_WAIT_L(0); PG8_BAR; PG8_MMA(0, 0, At, B0); PG8_MMA(0, 1, At, B1); PG8_BAR; PG8_SCHED;
            PG8_LDA(At, 0, 1); PG8_STAGE(PG8_SB(0, 0), b2, voffB); PG8_STAGE(PG8_SB(0, 1), b2 + hstep, voffB); PG8_STAGE(PG8_SA(0, 0), a2, voffA);
            PG8_WAIT_V(8); PG8_WAIT_L(0); PG8_BAR; PG8_MMA(1, 0, At, B0); PG8_MMA(1, 1, At, B1); PG8_BAR; PG8_SCHED;
            PG8_LDB(B0, 1, 0); PG8_LDB(B1, 1, 1); PG8_SCHED; PG8_LDA(At, 1, 0); PG8_STAGE(PG8_SA(0, 1), a2 + hstep, voffA);
            PG8_WAIT_V(8); PG8_WAIT_L(0); PG8_BAR; PG8_MMA(0, 0, At, B0); PG8_MMA(0, 1, At, B1); PG8_BAR; PG8_SCHED;
            PG8_LDA(At, 1, 1); PG8_STAGE(PG8_SB(1, 0), b3, voffB); PG8_STAGE(PG8_SB(1, 1), b3 + hstep, voffB); PG8_STAGE(PG8_SA(1, 0), a3, voffA);
            PG8_WAIT_V(8); PG8_WAIT_L(0); PG8_BAR; PG8_MMA(1, 0, At, B0); PG8_MMA(1, 1, At, B1); PG8_BAR; PG8_SCHED;
            } else {
            PG8_LDB(B0, 0, 0); PG8_SCHED; PG8_LDA(At, 0, 0); PG8_STAGE(PG8_SA(1, 1), a1 + hstep, voffA);
            PG8_WAIT_L(8); PG8_BAR; PG8_WAIT_L(0); PG8_MMA(0, 0, At, B0); PG8_BAR; PG8_SCHED;
            PG8_LDB(B1, 0, 1); PG8_STAGE(PG8_SB(0, 0), b2, voffB);
            PG8_BAR; PG8_WAIT_L(0); PG8_MMA(0, 1, At, B1); PG8_BAR;
            PG8_LDA(At, 0, 1); PG8_STAGE(PG8_SA(0, 0), a2, voffA);
            PG8_BAR; PG8_WAIT_L(0); PG8_MMA(1, 0, At, B0); PG8_BAR; PG8_SCHED;
            PG8_STAGE(PG8_SB(0, 1), b2 + hstep, voffB);
            PG8_WAIT_V(6); PG8_BAR; PG8_MMA(1, 1, At, B1); PG8_BAR;
            PG8_LDB(B0, 1, 0); PG8_SCHED; PG8_LDA(At, 1, 0); PG8_STAGE(PG8_SA(0, 1), a2 + hstep, voffA);
            PG8_WAIT_L(8); PG8_BAR; PG8_WAIT_L(0); PG8_MMA(0, 0, At, B0); PG8_BAR; PG8_SCHED;
            PG8_LDB(B1, 1, 1); PG8_STAGE(PG8_SB(1, 0), b3, voffB);
            PG8_BAR; PG8_WAIT_L(0); PG8_MMA(0, 1, At, B1); PG8_BAR;
            PG8_LDA(At, 1, 1); PG8_STAGE(PG8_SA(1, 0), a3, voffA);
            PG8_BAR; PG8_WAIT_L(0); PG8_MMA(1, 0, At, B0); PG8_BAR; PG8_SCHED;
            PG8_STAGE(PG8_SB(1, 1), b3 + hstep, voffB);
            PG8_WAIT_V(6); PG8_BAR; PG8_MMA(1, 1, At, B1); PG8_BAR;
            }
        }
        if constexpr (ALIGN_EPI) { if (wr == 0) PG8_BAR; }
        if constexpr (!Epi::AFTER_DRAIN) { E(acc, cur, wr, wc, fr, fq); S.done(cur); }
        if (!has_next) break;
#pragma unroll
        for (int a = 0; a < 2; ++a)
#pragma unroll
            for (int b = 0; b < 2; ++b)
#pragma unroll
                for (int m = 0; m < 4; ++m)
#pragma unroll
                    for (int n = 0; n < 2; ++n) acc[a][b][m][n] = (f32x4){0.f, 0.f, 0.f, 0.f};
        cur = nxt; cA = nA; cB = nB; ++ui;
        if constexpr (ALIGN_EPI) { if (wr == 1) PG8_BAR; }
    }
    PG8_WAIT_V(0);
    if constexpr (!ALIGN_EPI) { if (wr == 0) PG8_BAR; }
    PG8_BAR;
    if constexpr (Epi::AFTER_DRAIN) { E.fused(acc, cur, wr, wc, fr, fq, lds, wid, lane); S.done(cur); }
#undef PG8_SA
#undef PG8_SB
#undef PG8_STAGE
#undef PG8_LDA
#undef PG8_LDB
#undef PG8_MMA
#undef PG8_WAIT_V
#undef PG8_WAIT_L
#undef PG8_BAR
#undef PG8_SCHED
}
}
#define GAS __attribute__((address_space(1)))
#define LAS __attribute__((address_space(3)))
typedef unsigned short bf16;
typedef unsigned v4u __attribute__((ext_vector_type(4)));
typedef float f32x4 __attribute__((ext_vector_type(4)));
typedef short bf16x8 __attribute__((ext_vector_type(8)));
typedef GAS unsigned gu32;
typedef GAS unsigned long long gu64;
#define RLX_AGENT __ATOMIC_RELAXED, __HIP_MEMORY_SCOPE_AGENT
#define LDS_WAIT() asm volatile("s_waitcnt lgkmcnt(0)" ::: "memory")
#define VM_WAIT() asm volatile("s_waitcnt vmcnt(0)" ::: "memory")
__device__ __forceinline__ unsigned long long rt() { return __builtin_amdgcn_s_memrealtime(); }
__device__ __forceinline__ unsigned f2bf(float f) { unsigned u = __builtin_bit_cast(unsigned, f); return (u + 0x7fffu + ((u >> 16) & 1u)) >> 16; }
__device__ __forceinline__ unsigned pk2(float lo, float hi) { return f2bf(lo) | (f2bf(hi) << 16); }

#define XB_TMO      128
#define XB_XCNT(j)  (256  + 64 * (j))
#define XB_XSUB(j)  (1280 + 64 * (j))
#define XB_XGEN(j)  (2304 + 64 * (j))
#define XB_TOP      3328
#define XB_TOPGEN   3392
#define XCD_BAR_WORDS 3456
#define XB_SPIN_CAP (1u << 18)

__device__ __forceinline__ unsigned xb_ld(unsigned* p)              { return __hip_atomic_load(p, __ATOMIC_RELAXED, __HIP_MEMORY_SCOPE_AGENT); }
__device__ __forceinline__ unsigned xb_add(unsigned* p, unsigned v) { return __hip_atomic_fetch_add(p, v, __ATOMIC_RELAXED, __HIP_MEMORY_SCOPE_AGENT); }
__device__ __forceinline__ unsigned xb_xcc_id() { return (unsigned)__builtin_amdgcn_s_getreg((3 << 11) | 20) & 0xFu; }
#define XB_SPIN(cond, bar) do { unsigned _sp = 0; while (cond) { __builtin_amdgcn_s_sleep(1); \
    if ((++_sp & 255u) == 0u) { if (xb_ld(&(bar)[XB_TMO])) break; if (_sp > XB_SPIN_CAP) { atomicAdd(&(bar)[XB_TMO], 1u); break; } } } } while (0)

struct XcdBarrier {
    unsigned* bar; unsigned x;
    volatile LAS unsigned* st;
};

__device__ __forceinline__ XcdBarrier xcd_barrier_post(unsigned* bar, volatile LAS unsigned* st) {
    XcdBarrier b; b.bar = bar; b.x = xb_xcc_id(); b.st = st;
    if (threadIdx.x == 0) (void)xb_add(&bar[XB_XCNT(b.x)], 1u);
    return b;
}
__device__ __forceinline__ void xcd_barrier_complete(unsigned* bar, unsigned x, unsigned& nloc, unsigned& nx) {
    const unsigned G = gridDim.x * gridDim.y * gridDim.z;
    unsigned sum, cnt, mine, sp = 0u;
    for (;;) {
        sum = 0u; cnt = 0u; mine = 0u;
#pragma unroll
        for (unsigned j = 0; j < 16; ++j) { const unsigned c = xb_ld(&bar[XB_XCNT(j)]); sum += c; cnt += (c > 0u) ? 1u : 0u; mine = (j == x) ? c : mine; }
        if (sum == G) break;
        __builtin_amdgcn_s_sleep(1);
        if ((++sp & 255u) == 0u) { if (xb_ld(&bar[XB_TMO])) break; if (sp > XB_SPIN_CAP) { atomicAdd(&bar[XB_TMO], 1u); break; } }
    }
    nloc = mine > 0u ? mine : 1u; nx = cnt > 0u ? cnt : 1u;
}

__device__ __forceinline__ void xcd_barrier(const XcdBarrier& b) {
    asm volatile("s_waitcnt vmcnt(0)" ::: "memory");
    __syncthreads();
    if (threadIdx.x == 0) {
        unsigned* bar = b.bar;
        __builtin_amdgcn_s_waitcnt(0);
        unsigned nloc = b.st[0], nx = b.st[1];
        if (nloc == 0u) { xcd_barrier_complete(bar, b.x, nloc, nx); b.st[0] = nloc; b.st[1] = nx; }
        const unsigned old = xb_add(&bar[XB_XSUB(b.x)], 1u);
        const unsigned gen = old / nloc;
        if (old + 1u == (gen + 1u) * nloc) {
            __builtin_amdgcn_fence(__ATOMIC_RELEASE, "agent");
            asm volatile("s_waitcnt vmcnt(0)" ::: "memory");
            const unsigned og = xb_add(&bar[XB_TOP], 1u);
            const unsigned tg = og / nx;
            if (og + 1u == (tg + 1u) * nx) xb_add(&bar[XB_TOPGEN], 1u);
            else XB_SPIN(xb_ld(&bar[XB_TOPGEN]) == tg, bar);
            __builtin_amdgcn_fence(__ATOMIC_ACQUIRE, "agent");
            xb_add(&bar[XB_XGEN(b.x)], 1u);
            asm volatile("s_waitcnt vmcnt(0)" ::: "memory");
        } else {
            XB_SPIN(xb_ld(&bar[XB_XGEN(b.x)]) == gen, bar);
            __builtin_amdgcn_fence(__ATOMIC_ACQUIRE, "agent");
            asm volatile("s_waitcnt vmcnt(0)" ::: "memory");
        }
    }
    __syncthreads();
}


constexpr int NWAVES = 8, NTHR = 512;
constexpr int DM = 1024, TP = 16384, TS = 1024, TALL = TP + TS, SEQ = 8192, DSEQ = 8, DBATCH = 128, PAST = 8192, PAGE = 128, NPAGES = 64;
constexpr int QLORA = 384, KVLORA = 256, ROPE = 32, NOPE = 64, QHD = 96, VHD = 64, NH = 8;
constexpr int DSSM = 512, NSTATE = 128, CONVD = 1024, SSD_HD = 64, CHUNK = 128, NCHUNK = SEQ / CHUNK;
constexpr int IN_DIM = 2216, IN_PAD = 2304;
constexpr int O_CQ = 0, O_CKV = 384, O_KPE = 640, O_Z = 672, O_XBC = 1184, O_DT = 2208;
constexpr int NMEM = 256, MH = 4, MHD = 256;
constexpr int PH = 8, NKEYS = 128, NEXP = 16384, PTOPK = 16;
constexpr float DN_ALPHA = 1.189207115002721f;
constexpr float MLA_SCALE = 0.10206207261596577f;
constexpr float LOG2E = 1.4426950408889634f;
constexpr int NPOS = 8200;

constexpr size_t OUT_YP = 0, OUT_YS = OUT_YP + (size_t)TP * DM, OUT_KVP = OUT_YS + (size_t)TS * DM, OUT_KRP = OUT_KVP + (size_t)TP * KVLORA,
    OUT_CVP = OUT_KRP + (size_t)TP * ROPE, OUT_SSP = OUT_CVP + 2 * 3 * CONVD, OUT_MKP = OUT_SSP + 2 * 8 * 64 * 128, OUT_MVP = OUT_MKP + 512 * 1024,
    OUT_KVS = OUT_MVP + 512 * 1024, OUT_KRS = OUT_KVS + (size_t)TS * KVLORA, OUT_CVS = OUT_KRS + (size_t)TS * ROPE, OUT_SSS = OUT_CVS + 128 * 3 * CONVD,
    OUT_END = OUT_SSS + (size_t)128 * 8 * 64 * 128;

constexpr size_t al64k(size_t x) { return (x + 65535) & ~(size_t)65535; }
constexpr size_t WS_CTL = 0, CTL_ZERO_BYTES = 1u << 20;
constexpr size_t WS_ROPE = WS_CTL + CTL_ZERO_BYTES;
constexpr size_t WS_WIN = WS_ROPE + al64k((size_t)NPOS * 16 * 2 * 4);
constexpr size_t WS_WUQ = WS_WIN + al64k((size_t)IN_PAD * DM * 2);
constexpr size_t WS_WABS = WS_WUQ + al64k((size_t)768 * 384 * 2);
constexpr size_t WS_WKV = WS_WABS + al64k((size_t)2048 * 384 * 2);
constexpr size_t WS_WUVBD = WS_WKV + al64k((size_t)1024 * 256 * 2);
constexpr size_t WS_WOUT = WS_WUVBD + al64k((size_t)512 * 2048 * 2);
constexpr size_t WS_MWQ = WS_WOUT + al64k((size_t)DM * DM * 2);
constexpr size_t WS_MWO = WS_MWQ + al64k((size_t)DM * DM * 2);
constexpr size_t WS_MWKV = WS_MWO + al64k((size_t)DM * DM * 2);
constexpr size_t WS_PWQ = WS_MWKV + al64k((size_t)2048 * DM * 2);
constexpr size_t WS_PKEYS = WS_PWQ + al64k((size_t)2048 * DM * 2);
constexpr size_t WS_PU = WS_PKEYS + al64k((size_t)16 * 128 * 128 * 2);
constexpr size_t WS_PV = WS_PU + al64k((size_t)NEXP * DM * 2);
constexpr size_t WS_XB = WS_PV + al64k((size_t)NEXP * DM * 2);
constexpr size_t WS_MEMB = WS_XB + al64k((size_t)TALL * DM * 2);
constexpr size_t WS_U = WS_MEMB + al64k((size_t)512 * DM * 2);
constexpr size_t WS_CQN = WS_U + al64k((size_t)TALL * IN_PAD * 2);
constexpr size_t WS_CKV = WS_CQN + al64k((size_t)TALL * QLORA * 2);
constexpr size_t WS_KR = WS_CKV + al64k((size_t)TALL * KVLORA * 2);
constexpr size_t WS_XBC = WS_KR + al64k((size_t)TALL * ROPE * 2);
constexpr size_t WS_DT = WS_XBC + al64k((size_t)TALL * CONVD * 2);
constexpr size_t WS_Q = WS_DT + al64k((size_t)TALL * 8 * 4);
constexpr size_t WS_KNV = WS_Q + al64k((size_t)TALL * 768 * 2);
constexpr size_t WS_QLAT = WS_KNV + al64k((size_t)TP * 1024 * 2);
constexpr size_t WS_MK = WS_QLAT + al64k((size_t)TS * 2048 * 2);
constexpr size_t WS_MV = WS_MK + al64k((size_t)512 * DM * 2);
constexpr size_t WS_MKS = WS_MV + al64k((size_t)512 * DM * 2);
constexpr size_t WS_MVS = WS_MKS + al64k((size_t)128 * 256 * DM * 2);
constexpr size_t WS_OATT = WS_MVS + al64k((size_t)128 * 256 * DM * 2);
constexpr size_t WS_OLAT = WS_OATT + al64k((size_t)TALL * 512 * 2);
constexpr size_t WS_APART = WS_OLAT + al64k((size_t)TS * 2048 * 2);
constexpr size_t WS_STATES = WS_APART + al64k((size_t)128 * 2 * 64 * 264 * 4);
constexpr size_t WS_HPREV = WS_STATES + al64k((size_t)2 * 64 * 8 * 64 * 128 * 4);
constexpr size_t WS_CDEC = WS_HPREV + al64k((size_t)2 * 64 * 8 * 64 * 128 * 2);
constexpr size_t WS_MIXA = WS_CDEC + al64k((size_t)2 * 64 * 8 * 4);
constexpr size_t WS_MIX = WS_MIXA + al64k((size_t)TALL * DM * 2);
constexpr size_t WS_H1 = WS_MIX + al64k((size_t)TALL * DM * 2);
constexpr size_t WS_H1B = WS_H1 + al64k((size_t)TALL * DM * 4);
constexpr size_t WS_H2 = WS_H1B + al64k((size_t)TALL * DM * 2);
constexpr size_t WS_H2B = WS_H2 + al64k((size_t)TALL * DM * 4);
constexpr size_t WS_QM = WS_H2B + al64k((size_t)TALL * DM * 2);
constexpr size_t WS_OM = WS_QM + al64k((size_t)TALL * DM * 2);
constexpr size_t WS_PQ = WS_OM + al64k((size_t)TALL * DM * 2);
constexpr size_t WS_PTOPS = WS_PQ + al64k((size_t)TALL * 2048 * 2);
constexpr size_t WS_PTOPI = WS_PTOPS + al64k((size_t)TALL * 256 * 4);
constexpr size_t WS_PIDX = WS_PTOPI + al64k((size_t)TALL * 256 * 4);
constexpr size_t WS_PG = WS_PIDX + al64k((size_t)TALL * 128 * 4);
constexpr size_t WS_YG = WS_PG + al64k((size_t)TALL * 128 * 4);
constexpr size_t WS_MIX2 = WS_YG + al64k((size_t)TALL * 512 * 2);
constexpr size_t WS_END = WS_MIX2 + al64k((size_t)TALL * DM * 2);
constexpr int CW_DIAG = 65536;

constexpr int CW_TMO = 0, CW_CODE = 1;
constexpr int CW_BAR = 4096;

constexpr int RING_OFF = 0, RING_BYTES = 131072;
constexpr int LDSCTL_OFF = RING_BYTES, MISC_OFF = LDSCTL_OFF + 320;
constexpr int LDS_BYTES = 147456;

struct Args { const void* in[38]; float* out; unsigned char* ws; int ph_lo, ph_hi; };

struct Frame {
    LAS unsigned char* lds;
    volatile LAS unsigned* MISC;
    gu32* ctl;
    int tid, lane, wave;
    int vcu, G;
};

__device__ __forceinline__ float wave_sum(float v) {
#pragma unroll
    for (int o = 1; o < 64; o <<= 1) v += __shfl_xor(v, o);
    return v;
}
__device__ __forceinline__ float bf2f(unsigned short b) { return __uint_as_float((unsigned)b << 16); }
__device__ __forceinline__ float bflo(unsigned u) { return __uint_as_float(u << 16); }
__device__ __forceinline__ float bfhi(unsigned u) { return __uint_as_float(u & 0xffff0000u); }
__device__ __forceinline__ float siluf(float x) { return x / (1.f + __expf(-x)); }

__device__ __forceinline__ void transpose_tile(const float* W, int ldw, int nvalid, bf16* WT, int ldwt, LAS float* scr, int k0, int n0, int lane) {
#pragma unroll 8
    for (int i = 0; i < 32; ++i) { const int kk = 2 * i + (lane >> 5); const int n = n0 + (lane & 31);
        scr[kk * 33 + (lane & 31)] = (n < nvalid) ? W[(size_t)(k0 + kk) * ldw + n] : 0.f; }
    LDS_WAIT(); asm volatile("" ::: "memory");
    const int c = lane & 7;
#pragma unroll
    for (int j = 0; j < 4; ++j) { const int n = (lane >> 3) + 8 * j; const LAS float* s = scr + (8 * c) * 33 + n;
        v4u o; o.x = pk2(s[0 * 33], s[1 * 33]); o.y = pk2(s[2 * 33], s[3 * 33]); o.z = pk2(s[4 * 33], s[5 * 33]); o.w = pk2(s[6 * 33], s[7 * 33]);
        *(GAS v4u*)(WT + (size_t)(n0 + n) * ldwt + k0 + 8 * c) = o; }
    LDS_WAIT(); asm volatile("" ::: "memory");
}
__device__ __forceinline__ void transpose_mat(const Frame& F, const float* W, int K, int N, int Npad, int ldw, bf16* WT, int ldwt) {
    LAS float* scr = (LAS float*)(F.lds + RING_OFF + F.wave * 16384);
    const int gw = F.vcu * NWAVES + F.wave, NGW = F.G * NWAVES;
    const int nblk = Npad / 32, items = (K / 64) * nblk;
    for (int it = gw; it < items; it += NGW) { const int kb = it / nblk, nb = it % nblk; transpose_tile(W, ldw, N, WT, ldwt, scr, 64 * kb, 32 * nb, F.lane); }
}
__device__ __forceinline__ void convert_bf16(const Frame& F, const float* src, bf16* dst, size_t n) {
    const size_t gt = (size_t)F.vcu * NTHR + F.tid, NGT = (size_t)F.G * NTHR;
    for (size_t i = gt; i < n / 8; i += NGT) { const f32x4 a = *(const GAS f32x4*)(src + 8 * i), b = *(const GAS f32x4*)(src + 8 * i + 4);
        v4u o; o.x = pk2(a.x, a.y); o.y = pk2(a.z, a.w); o.z = pk2(b.x, b.y); o.w = pk2(b.z, b.w); *(GAS v4u*)(dst + 8 * i) = o; }
}

struct P {
    const float *x_prompt, *x_sample, *mem_prompt, *cache_c, *cache_r, *state_conv, *state_ssm, *cache_mk, *cache_mv; const int* page_table;
    const float *w_in, *q_a_norm, *w_uq, *kv_a_norm, *w_uk, *w_uv, *attn_out_norm, *conv_w, *conv_b, *dt_bias, *a_log, *d_skip, *ssm_norm, *w_out, *ln1_g, *ln1_b,
        *mem_wq, *mem_wk, *mem_wv, *mem_wo, *ln2_g, *ln2_b, *peer_wq, *peer_keys, *peer_u, *peer_v, *ln3_g, *ln3_b;
    float* out; unsigned char* ws;
};

__device__ __forceinline__ void p0_prologue(const Frame& F, const P& p) {
    unsigned char* ws = p.ws;
    transpose_mat(F, p.w_in, DM, IN_DIM, IN_PAD, IN_DIM, (bf16*)(ws + WS_WIN), DM);
    transpose_mat(F, p.w_uq, QLORA, 768, 768, 768, (bf16*)(ws + WS_WUQ), QLORA);
    transpose_mat(F, p.w_uk, KVLORA, 512, 512, 512, (bf16*)(ws + WS_WKV), KVLORA);
    transpose_mat(F, p.w_uv, KVLORA, 512, 512, 512, (bf16*)(ws + WS_WKV) + (size_t)512 * KVLORA, KVLORA);
    transpose_mat(F, p.w_out, DM, DM, DM, DM, (bf16*)(ws + WS_WOUT), DM);
    transpose_mat(F, p.mem_wq, DM, DM, DM, DM, (bf16*)(ws + WS_MWQ), DM);
    transpose_mat(F, p.mem_wo, DM, DM, DM, DM, (bf16*)(ws + WS_MWO), DM);
    transpose_mat(F, p.mem_wk, DM, DM, DM, DM, (bf16*)(ws + WS_MWKV), DM);
    transpose_mat(F, p.mem_wv, DM, DM, DM, DM, (bf16*)(ws + WS_MWKV) + (size_t)DM * DM, DM);
    transpose_mat(F, p.peer_wq, DM, 2048, 2048, 2048, (bf16*)(ws + WS_PWQ), DM);
    const size_t gt = (size_t)F.vcu * NTHR + F.tid, NGT = (size_t)F.G * NTHR;
    { bf16* WB = (bf16*)(ws + WS_WUVBD);
      for (size_t i = gt; i < (size_t)512 * 2048 / 8; i += NGT) { const int n = (int)(i / 256), k8 = (int)(i % 256) * 8; const int h = n >> 6, h2 = k8 >> 8;
          v4u o = (v4u){0u, 0u, 0u, 0u};
          if (h == h2) { const int c = k8 & 255; float v[8];
#pragma unroll
              for (int j = 0; j < 8; ++j) v[j] = p.w_uv[(size_t)(c + j) * 512 + n];
              o.x = pk2(v[0], v[1]); o.y = pk2(v[2], v[3]); o.z = pk2(v[4], v[5]); o.w = pk2(v[6], v[7]); }
          *(GAS v4u*)(WB + (size_t)n * 2048 + k8) = o; } }
    { bf16* WA = (bf16*)(ws + WS_WABS);
      for (size_t i = gt; i < (size_t)2048 * QLORA; i += NGT) { const int n = (int)(i / QLORA), k = (int)(i % QLORA); const int h = n >> 8, c = n & 255;
          const float* a = p.w_uq + (size_t)k * 768 + h * 96; const float* b = p.w_uk + (size_t)c * 512 + h * 64; float s = 0.f;
#pragma unroll 8
          for (int d = 0; d < 64; ++d) s += a[d] * b[d];
          WA[i] = (bf16)f2bf(s); } }
    { float* tab = (float*)(ws + WS_ROPE);
      for (size_t i = gt; i < (size_t)NPOS * 16; i += NGT) { const int pos = (int)(i >> 4), f = (int)(i & 15);
          const float inv = powf(10000.0f, -(float)f / 16.0f); const float ang = (float)pos * inv; float sn, cs; sincosf(ang, &sn, &cs);
          tab[2 * i] = cs; tab[2 * i + 1] = sn; } }
    convert_bf16(F, p.peer_keys, (bf16*)(ws + WS_PKEYS), (size_t)16 * 128 * 128);
    convert_bf16(F, p.peer_u, (bf16*)(ws + WS_PU), (size_t)NEXP * DM);
    convert_bf16(F, p.peer_v, (bf16*)(ws + WS_PV), (size_t)NEXP * DM);
    convert_bf16(F, p.x_prompt, (bf16*)(ws + WS_XB), (size_t)TP * DM);
    convert_bf16(F, p.x_sample, (bf16*)(ws + WS_XB) + (size_t)TP * DM, (size_t)TS * DM);
    convert_bf16(F, p.mem_prompt, (bf16*)(ws + WS_MEMB), (size_t)512 * DM);
}

template <class Fn> struct EpiGen8 {
    static constexpr bool PERM = true, AFTER_DRAIN = false; Fn f;
    __device__ __forceinline__ void operator()(const pg8::f32x4 (&acc)[2][2][4][2], const pg8::Unit& u, int wr, int wc, int fr, int fq) const {
#pragma unroll
        for (int ai = 0; ai < 2; ++ai)
#pragma unroll
            for (int m = 0; m < 4; ++m) { const int row = u.pm * 256 + ai * 128 + wr * 64 + m * 16 + fr;
#pragma unroll
                for (int bj = 0; bj < 2; ++bj) { const int col = u.pn * 256 + bj * 128 + wc * 32 + 8 * fq; f(row, col, acc[ai][bj][m][0], acc[ai][bj][m][1]); } }
    }
};
struct StoreBf16 { bf16* O; int ldc; float scale;
    __device__ __forceinline__ void operator()(int row, int col, f32x4 v0, f32x4 v1) const {
        v4u w; w.x = pk2(v0[0] * scale, v0[1] * scale); w.y = pk2(v0[2] * scale, v0[3] * scale); w.z = pk2(v1[0] * scale, v1[1] * scale); w.w = pk2(v1[2] * scale, v1[3] * scale);
        *(GAS v4u*)(O + (size_t)row * ldc + col) = w; } };
struct StoreMemKV { float* ok; float* ov; bf16* bk; bf16* bv;
    __device__ __forceinline__ void operator()(int row, int col, f32x4 v0, f32x4 v1) const {
        const bool isv = col >= 1024; const int c = col & 1023; float* of = (isv ? ov : ok) + (size_t)row * 1024 + c; bf16* ob = (isv ? bv : bk) + (size_t)row * 1024 + c;
        *(GAS f32x4*)of = v0; *(GAS f32x4*)(of + 4) = v1;
        v4u w; w.x = pk2(v0[0], v0[1]); w.y = pk2(v0[2], v0[3]); w.z = pk2(v1[0], v1[1]); w.w = pk2(v1[2], v1[3]); *(GAS v4u*)ob = w; } };

__device__ __forceinline__ void p2_rows(const Frame& F, const P& p) {
    unsigned char* ws = p.ws;
    const bf16* U = (const bf16*)(ws + WS_U); bf16* CQN = (bf16*)(ws + WS_CQN); bf16* CKV = (bf16*)(ws + WS_CKV); bf16* KR = (bf16*)(ws + WS_KR);
    bf16* XBC = (bf16*)(ws + WS_XBC); float* DT = (float*)(ws + WS_DT); const float* tab = (const float*)(ws + WS_ROPE);
    const int lane = F.lane; const int gw = F.vcu * NWAVES + F.wave, NGW = F.G * NWAVES;
    for (int t = gw; t < TALL; t += NGW) {
        const bool smp = t >= TP; const int ts = t - TP; const int tl = smp ? (ts & 7) : (t & (SEQ - 1)); const int pos = smp ? PAST + tl : tl;
        const unsigned* urow = (const unsigned*)(U + (size_t)t * IN_PAD);
        { unsigned w[3]; float ss = 0.f;
#pragma unroll
          for (int i = 0; i < 3; ++i) { w[i] = urow[O_CQ / 2 + lane + 64 * i]; const float a = bflo(w[i]), b = bfhi(w[i]); ss += a * a + b * b; }
          const float r = rsqrtf(wave_sum(ss) * (1.f / QLORA) + 1e-6f);
#pragma unroll
          for (int i = 0; i < 3; ++i) { const int e = 2 * (lane + 64 * i); ((unsigned*)(CQN + (size_t)t * QLORA))[lane + 64 * i] = pk2(bflo(w[i]) * r * p.q_a_norm[e], bfhi(w[i]) * r * p.q_a_norm[e + 1]); } }
        { unsigned w[2]; float ss = 0.f;
#pragma unroll
          for (int i = 0; i < 2; ++i) { w[i] = urow[O_CKV / 2 + lane + 64 * i]; const float a = bflo(w[i]), b = bfhi(w[i]); ss += a * a + b * b; }
          const float r = rsqrtf(wave_sum(ss) * (1.f / KVLORA) + 1e-6f);
          float* of = smp ? p.out + OUT_KVS + (size_t)ts * KVLORA : p.out + OUT_KVP + (size_t)t * KVLORA;
#pragma unroll
          for (int i = 0; i < 2; ++i) { const int e = 2 * (lane + 64 * i); const float a = bflo(w[i]) * r * p.kv_a_norm[e], b = bfhi(w[i]) * r * p.kv_a_norm[e + 1];
              of[e] = a; of[e + 1] = b; ((unsigned*)(CKV + (size_t)t * KVLORA))[lane + 64 * i] = pk2(a, b); } }
        if (lane < 16) { const unsigned short* ur = (const unsigned short*)(U + (size_t)t * IN_PAD + O_KPE); const float x1 = bf2f(ur[lane]), x2 = bf2f(ur[lane + 16]);
          const float cs = tab[((size_t)pos * 16 + lane) * 2], sn = tab[((size_t)pos * 16 + lane) * 2 + 1];
          const float o1 = x1 * cs - x2 * sn, o2 = x2 * cs + x1 * sn;
          float* of = smp ? p.out + OUT_KRS + (size_t)ts * ROPE : p.out + OUT_KRP + (size_t)t * ROPE; of[lane] = o1; of[lane + 16] = o2;
          KR[(size_t)t * ROPE + lane] = (bf16)f2bf(o1); KR[(size_t)t * ROPE + lane + 16] = (bf16)f2bf(o2); }
        if (lane < 8) { const float raw = bf2f(U[(size_t)t * IN_PAD + O_DT + lane]) + p.dt_bias[lane]; DT[(size_t)t * 8 + lane] = raw > 20.f ? raw : log1pf(__expf(raw)); }
#pragma unroll
        for (int i = 0; i < 8; ++i) { const int pr = lane + 64 * i, c = 2 * pr; float a0 = p.conv_b[c], a1 = p.conv_b[c + 1];
#pragma unroll
            for (int k = 0; k < 4; ++k) { const int f = tl + k; float x0, x1;
                if (f >= 3) { const unsigned w = ((const unsigned*)(U + (size_t)(t - 3 + k) * IN_PAD + O_XBC))[pr]; x0 = bflo(w); x1 = bfhi(w); }
                else if (smp) { const float* sc = p.state_conv + ((size_t)(ts >> 3) * 3 + f) * CONVD + c; x0 = sc[0]; x1 = sc[1]; }
                else { x0 = 0.f; x1 = 0.f; }
                a0 += p.conv_w[k * CONVD + c] * x0; a1 += p.conv_w[k * CONVD + c + 1] * x1; }
            ((unsigned*)(XBC + (size_t)t * CONVD))[pr] = pk2(siluf(a0), siluf(a1)); }
        if (!smp && tl >= SEQ - 3) { float* of = p.out + OUT_CVP + ((size_t)(t >> 13) * 3 + (tl - (SEQ - 3))) * CONVD;
#pragma unroll
            for (int i = 0; i < 8; ++i) { const int pr = lane + 64 * i; const unsigned w = urow[O_XBC / 2 + pr]; of[2 * pr] = bflo(w); of[2 * pr + 1] = bfhi(w); } }
        if (smp && tl >= DSEQ - 3) { float* of = p.out + OUT_CVS + ((size_t)(ts >> 3) * 3 + (tl - (DSEQ - 3))) * CONVD;
#pragma unroll
            for (int i = 0; i < 8; ++i) { const int pr = lane + 64 * i; const unsigned w = urow[O_XBC / 2 + pr]; of[2 * pr] = bflo(w); of[2 * pr + 1] = bfhi(w); } }
    }
}

typedef unsigned u32x2 __attribute__((ext_vector_type(2)));
typedef short s16x4 __attribute__((ext_vector_type(4)));
typedef short v4i16_t __attribute__((ext_vector_type(4)));
struct EpiQRope {
    static constexpr bool PERM = false, AFTER_DRAIN = false;
    bf16* Q; const float* tab; float scale;
    __device__ __forceinline__ void operator()(const pg8::f32x4 (&acc)[2][2][4][2], const pg8::Unit& u, int wr, int wc, int fr, int fq) const {
#pragma unroll
        for (int ai = 0; ai < 2; ++ai)
#pragma unroll
            for (int m = 0; m < 4; ++m) { const int row = u.pm * 256 + ai * 128 + wr * 64 + m * 16 + fr;
                const int pos = row < TP ? (row & (SEQ - 1)) : PAST + ((row - TP) & 7);
#pragma unroll
                for (int bj = 0; bj < 2; ++bj) { const int grp = 8 * u.pn + 4 * bj + wc; const int col = 32 * grp + 4 * fq;
                    f32x4 a = acc[ai][bj][m][0], b = acc[ai][bj][m][1];
                    if (grp % 3 == 2) { const f32x4 t0 = *(const GAS f32x4*)(tab + ((size_t)pos * 16 + 4 * fq) * 2), t1 = *(const GAS f32x4*)(tab + ((size_t)pos * 16 + 4 * fq) * 2 + 4);
                        const float cs[4] = {t0[0], t0[2], t1[0], t1[2]}, sn[4] = {t0[1], t0[3], t1[1], t1[3]}; f32x4 o1, o2;
#pragma unroll
                        for (int i = 0; i < 4; ++i) { o1[i] = a[i] * cs[i] - b[i] * sn[i]; o2[i] = b[i] * cs[i] + a[i] * sn[i]; }
                        a = o1; b = o2; }
                    u32x2 w0, w1; w0.x = pk2(a[0] * scale, a[1] * scale); w0.y = pk2(a[2] * scale, a[3] * scale); w1.x = pk2(b[0] * scale, b[1] * scale); w1.y = pk2(b[2] * scale, b[3] * scale);
                    *(GAS u32x2*)(Q + (size_t)row * 768 + col) = w0; *(GAS u32x2*)(Q + (size_t)row * 768 + col + 16) = w1; }
                asm volatile("" ::: "memory"); }
    }
};

__device__ __forceinline__ s16x4 tr_read(const LAS unsigned char* p) { return __builtin_bit_cast(s16x4, __builtin_amdgcn_ds_read_tr16_b64_v4i16((LAS v4i16_t*)p)); }
__device__ __forceinline__ bf16x8 cat8(s16x4 a, s16x4 b) { return (bf16x8){a[0], a[1], a[2], a[3], b[0], b[1], b[2], b[3]}; }
__device__ __forceinline__ bf16x8 pack8(f32x4 a, f32x4 b) { v4u w; w.x = pk2(a[0], a[1]); w.y = pk2(a[2], a[3]); w.z = pk2(b[0], b[1]); w.w = pk2(b[2], b[3]); return __builtin_bit_cast(bf16x8, w); }
#define MFMA16(a, b, c) __builtin_amdgcn_mfma_f32_16x16x32_bf16((a), (b), (c), 0, 0, 0)

__device__ __forceinline__ bf16x8 rope_frag(bf16x8 v, int pos, int g, const float* tab) {
    const v4u m = __builtin_bit_cast(v4u, v); v4u o; o.x = (unsigned)__shfl_xor((int)m.x, 32); o.y = (unsigned)__shfl_xor((int)m.y, 32); o.z = (unsigned)__shfl_xor((int)m.z, 32); o.w = (unsigned)__shfl_xor((int)m.w, 32);
    const float* tp = tab + ((size_t)pos * 16 + 8 * (g & 1)) * 2; const f32x4 t0 = *(const GAS f32x4*)tp, t1 = *(const GAS f32x4*)(tp + 4), t2 = *(const GAS f32x4*)(tp + 8), t3 = *(const GAS f32x4*)(tp + 12);
    const float sg = g < 2 ? -1.f : 1.f;
    v4u r;
    r.x = pk2(bflo(m.x) * t0[0] + sg * bflo(o.x) * t0[1], bfhi(m.x) * t0[2] + sg * bfhi(o.x) * t0[3]);
    r.y = pk2(bflo(m.y) * t1[0] + sg * bflo(o.y) * t1[1], bfhi(m.y) * t1[2] + sg * bfhi(o.y) * t1[3]);
    r.z = pk2(bflo(m.z) * t2[0] + sg * bflo(o.z) * t2[1], bfhi(m.z) * t2[2] + sg * bfhi(o.z) * t2[3]);
    r.w = pk2(bflo(m.w) * t3[0] + sg * bflo(o.w) * t3[1], bfhi(m.w) * t3[2] + sg * bfhi(o.w) * t3[3]);
    return __builtin_bit_cast(bf16x8, r);
}

constexpr int PA_KST = 104, PA_VST = 72;
constexpr int PA_KBYTES = 64 * PA_KST * 2, PA_VBYTES = 64 * PA_VST * 2, PA_BUF = PA_KBYTES + PA_VBYTES;
__device__ __forceinline__ void attn_prompt_unit(const Frame& F, const P& p, int b, int h, int qb) {
    unsigned char* ws = p.ws;
    const bf16* Q = (const bf16*)(ws + WS_Q); const bf16* KNV = (const bf16*)(ws + WS_KNV); const bf16* KR = (const bf16*)(ws + WS_KR); bf16* OATT = (bf16*)(ws + WS_OATT);
    const int tid = F.tid, lane = F.lane, w = F.wave, li = lane & 15, g = lane >> 4;
    const size_t rowbase = (size_t)b * SEQ; const int q0 = qb * 256 + w * 32;
    LAS unsigned char* lds = F.lds + RING_OFF;
    bf16x8 qf[2][3];
#pragma unroll
    for (int j = 0; j < 2; ++j)
#pragma unroll
        for (int ks = 0; ks < 3; ++ks) qf[j][ks] = *(const GAS bf16x8*)(Q + (rowbase + q0 + 16 * j + li) * 768 + h * 96 + 32 * ks + 8 * g);
#pragma unroll
    for (int j = 0; j < 2; ++j) qf[j][2] = rope_frag(qf[j][2], q0 + 16 * j + li, g, (const float*)(ws + WS_ROPE));
    f32x4 o[4][2];
#pragma unroll
    for (int d = 0; d < 4; ++d)
#pragma unroll
        for (int j = 0; j < 2; ++j) o[d][j] = (f32x4){0.f, 0.f, 0.f, 0.f};
    float mrun[2] = {-INFINITY, -INFINITY}, lrun[2] = {0.f, 0.f};
    const int NT = 4 * (qb + 1); const int tq = 4 * qb + (w >> 1);
    const int srow = tid >> 3, sch = tid & 7, rrow = tid >> 2, rch = tid & 3;
    v4u sk, sv, sr = (v4u){0u, 0u, 0u, 0u};
#define PA_LOAD(t) do { const size_t kr_ = rowbase + (size_t)(t) * 64; \
        sk = *(const GAS v4u*)(KNV + (kr_ + srow) * 1024 + h * 64 + sch * 8); sv = *(const GAS v4u*)(KNV + (kr_ + srow) * 1024 + 512 + h * 64 + sch * 8); \
        if (tid < 256) sr = *(const GAS v4u*)(KR + (kr_ + rrow) * 32 + rch * 8); } while (0)
#define PA_STORE(buf) do { LAS unsigned char* kb_ = lds + (buf) * PA_BUF; \
        *(LAS v4u*)(kb_ + (srow * PA_KST + sch * 8) * 2) = sk; *(LAS v4u*)(kb_ + PA_KBYTES + (srow * PA_VST + sch * 8) * 2) = sv; \
        if (tid < 256) *(LAS v4u*)(kb_ + (rrow * PA_KST + 64 + rch * 8) * 2) = sr; } while (0)
    __syncthreads();
    PA_LOAD(0); PA_STORE(0); __syncthreads();
    for (int t = 0; t < NT; ++t) {
        const int buf = t & 1;
        if (t + 1 < NT) PA_LOAD(t + 1);
        if (t <= tq) {
            const LAS unsigned char* kb = lds + buf * PA_BUF; const LAS unsigned char* vb = kb + PA_KBYTES;
            f32x4 s[4][2];
#pragma unroll
            for (int kt = 0; kt < 4; ++kt) {
                bf16x8 kf[3];
#pragma unroll
                for (int ks = 0; ks < 3; ++ks) kf[ks] = *(const LAS bf16x8*)(kb + ((16 * kt + li) * PA_KST + 32 * ks + 8 * g) * 2);
#pragma unroll
                for (int j = 0; j < 2; ++j) { f32x4 a = (f32x4){0.f, 0.f, 0.f, 0.f};
#pragma unroll
                    for (int ks = 0; ks < 3; ++ks) a = MFMA16(kf[ks], qf[j][ks], a);
                    s[kt][j] = a; } }
            if (t == tq) {
#pragma unroll
                for (int j = 0; j < 2; ++j) { const int qa = q0 + 16 * j + li;
#pragma unroll
                    for (int kt = 0; kt < 4; ++kt)
#pragma unroll
                        for (int r = 0; r < 4; ++r) if (64 * t + 16 * kt + 4 * g + r > qa) s[kt][j][r] = -INFINITY; } }
            bf16x8 pf[2][2];
#pragma unroll
            for (int j = 0; j < 2; ++j) {
                float mx = -INFINITY;
#pragma unroll
                for (int kt = 0; kt < 4; ++kt)
#pragma unroll
                    for (int r = 0; r < 4; ++r) mx = fmaxf(mx, s[kt][j][r]);
                mx = fmaxf(mx, __shfl_xor(mx, 16)); mx = fmaxf(mx, __shfl_xor(mx, 32));
                const float mn = fmaxf(mrun[j], mx); const float alpha = __builtin_amdgcn_exp2f(mrun[j] - mn); mrun[j] = mn;
                float ps = 0.f;
#pragma unroll
                for (int kt = 0; kt < 4; ++kt)
#pragma unroll
                    for (int r = 0; r < 4; ++r) { const float e = __builtin_amdgcn_exp2f(s[kt][j][r] - mn); s[kt][j][r] = e; ps += e; }
                lrun[j] = lrun[j] * alpha + ps;
#pragma unroll
                for (int d = 0; d < 4; ++d) o[d][j] = o[d][j] * alpha;
                pf[j][0] = pack8(s[0][j], s[1][j]); pf[j][1] = pack8(s[2][j], s[3][j]);
            }
#pragma unroll
            for (int kk = 0; kk < 2; ++kk)
#pragma unroll
                for (int d = 0; d < 4; ++d) {
                    const LAS unsigned char* va = vb + ((32 * kk + 4 * g + (li >> 2)) * PA_VST + 16 * d + 4 * (li & 3)) * 2;
                    const bf16x8 vf = cat8(tr_read(va), tr_read(va + 16 * PA_VST * 2));
#pragma unroll
                    for (int j = 0; j < 2; ++j) o[d][j] = MFMA16(vf, pf[j][kk], o[d][j]); }
        }
        if (t + 1 < NT) PA_STORE(buf ^ 1);
        __syncthreads();
    }
#undef PA_LOAD
#undef PA_STORE
#pragma unroll
    for (int j = 0; j < 2; ++j) { float l = lrun[j]; l += __shfl_xor(l, 16); l += __shfl_xor(l, 32); const float rl = 1.f / l;
        bf16* orow = OATT + (rowbase + q0 + 16 * j + li) * 512 + h * 64 + 4 * g;
#pragma unroll
        for (int d = 0; d < 4; ++d) { u32x2 wv; wv.x = pk2(o[d][j][0] * rl, o[d][j][1] * rl); wv.y = pk2(o[d][j][2] * rl, o[d][j][3] * rl); *(GAS u32x2*)(orow + 16 * d) = wv; } }
}

constexpr int SA_ST = 296;
constexpr int SA_BUF = 64 * SA_ST * 2;
constexpr int AP_ST = 264;
__device__ __forceinline__ void attn_sample_unit(const Frame& F, const P& p, int b, int split) {
    unsigned char* ws = p.ws;
    const bf16* Q = (const bf16*)(ws + WS_Q); const bf16* QLAT = (const bf16*)(ws + WS_QLAT); const bf16* CKV = (const bf16*)(ws + WS_CKV); const bf16* KR = (const bf16*)(ws + WS_KR);
    float* APART = (float*)(ws + WS_APART);
    const int tid = F.tid, lane = F.lane, w = F.wave, li = lane & 15, g = lane >> 4, jq = w & 3, ch = w >> 2;
    LAS unsigned char* lds = F.lds + RING_OFF;
    bf16x8 qf[9];
    { const int r = 16 * jq + li, tk = r >> 3, hh = r & 7; const bf16* ql = QLAT + (size_t)(b * 8 + tk) * 2048 + hh * 256; const bf16* qp = Q + (size_t)(TP + b * 8 + tk) * 768 + hh * 96 + 64;
#pragma unroll
      for (int ks = 0; ks < 8; ++ks) qf[ks] = *(const GAS bf16x8*)(ql + 32 * ks + 8 * g);
      qf[8] = rope_frag(*(const GAS bf16x8*)(qp + 8 * g), PAST + tk, g, (const float*)(ws + WS_ROPE)); }
    f32x4 o[8];
#pragma unroll
    for (int c = 0; c < 8; ++c) o[c] = (f32x4){0.f, 0.f, 0.f, 0.f};
    float mrun = -INFINITY, lrun = 0.f;
    const int NT = 64 + split;
    const int* pt = p.page_table + b * NPAGES + split * 32;
    f32x4 st[9];
#define SA_LOAD(t) do { if ((t) < 64) { const int pg_ = pt[(t) >> 1]; const float* cl_ = p.cache_c + ((size_t)pg_ * PAGE + ((t) & 1) * 64) * KVLORA; const float* cr_ = p.cache_r + ((size_t)pg_ * PAGE + ((t) & 1) * 64) * ROPE; \
        _Pragma("unroll") for (int i_ = 0; i_ < 8; ++i_) st[i_] = __builtin_nontemporal_load((const GAS f32x4*)(cl_ + (size_t)(tid + 512 * i_) * 4)); \
        st[8] = __builtin_nontemporal_load((const GAS f32x4*)(cr_ + (size_t)tid * 4)); } } while (0)
#define SA_STORE(t, buf) do { LAS unsigned char* kb_ = lds + (buf) * SA_BUF; if ((t) < 64) { \
        _Pragma("unroll") for (int i_ = 0; i_ < 8; ++i_) { const int q_ = tid + 512 * i_; u32x2 w_; w_.x = pk2(st[i_][0], st[i_][1]); w_.y = pk2(st[i_][2], st[i_][3]); *(LAS u32x2*)(kb_ + ((q_ >> 6) * SA_ST + (q_ & 63) * 4) * 2) = w_; } \
        { u32x2 w_; w_.x = pk2(st[8][0], st[8][1]); w_.y = pk2(st[8][2], st[8][3]); *(LAS u32x2*)(kb_ + ((tid >> 3) * SA_ST + 256 + (tid & 7) * 4) * 2) = w_; } } \
      else {   \
        for (int q_ = tid; q_ < 64 * 36; q_ += 512) { const int row_ = q_ / 36, c8_ = q_ % 36; v4u v_ = (v4u){0u, 0u, 0u, 0u}; \
            if (row_ < 8) v_ = c8_ < 32 ? *(const GAS v4u*)(CKV + (size_t)(TP + b * 8 + row_) * KVLORA + c8_ * 8) : *(const GAS v4u*)(KR + (size_t)(TP + b * 8 + row_) * ROPE + (c8_ - 32) * 8); \
            *(LAS v4u*)(kb_ + (row_ * SA_ST + c8_ * 8) * 2) = v_; } } } while (0)
    __syncthreads();
    SA_LOAD(0); SA_STORE(0, 0); __syncthreads();
    for (int t = 0; t < NT; ++t) {
        const int buf = t & 1;
        if (t + 1 < NT) SA_LOAD(t + 1);
        const LAS unsigned char* kb = lds + buf * SA_BUF;
        f32x4 s[4];
#pragma unroll
        for (int kt = 0; kt < 4; ++kt) { f32x4 a = (f32x4){0.f, 0.f, 0.f, 0.f};
#pragma unroll
            for (int ks = 0; ks < 9; ++ks) { const bf16x8 kf = *(const LAS bf16x8*)(kb + ((16 * kt + li) * SA_ST + 32 * ks + 8 * g) * 2); a = MFMA16(kf, qf[ks], a); }
            s[kt] = a; }
        if (t == 64) { const int tk = (16 * jq + li) >> 3;
#pragma unroll
            for (int kt = 0; kt < 4; ++kt)
#pragma unroll
                for (int r = 0; r < 4; ++r) if (16 * kt + 4 * g + r > tk) s[kt][r] = -INFINITY; }
        float mx = -INFINITY;
#pragma unroll
        for (int kt = 0; kt < 4; ++kt)
#pragma unroll
            for (int r = 0; r < 4; ++r) mx = fmaxf(mx, s[kt][r]);
        mx = fmaxf(mx, __shfl_xor(mx, 16)); mx = fmaxf(mx, __shfl_xor(mx, 32));
        const float mn = fmaxf(mrun, mx); const float alpha = __builtin_amdgcn_exp2f(mrun - mn); mrun = mn;
        float ps = 0.f;
#pragma unroll
        for (int kt = 0; kt < 4; ++kt)
#pragma unroll
            for (int r = 0; r < 4; ++r) { const float e = __builtin_amdgcn_exp2f(s[kt][r] - mn); s[kt][r] = e; ps += e; }
        lrun = lrun * alpha + ps;
#pragma unroll
        for (int c = 0; c < 8; ++c) o[c] = o[c] * alpha;
        const bf16x8 pf0 = pack8(s[0], s[1]), pf1 = pack8(s[2], s[3]);
#pragma unroll
        for (int c = 0; c < 8; ++c) {
            const LAS unsigned char* va = kb + ((4 * g + (li >> 2)) * SA_ST + 128 * ch + 16 * c + 4 * (li & 3)) * 2;
            const bf16x8 v0 = cat8(tr_read(va), tr_read(va + 16 * SA_ST * 2)); const bf16x8 v1 = cat8(tr_read(va + 32 * SA_ST * 2), tr_read(va + 48 * SA_ST * 2));
            o[c] = MFMA16(v0, pf0, o[c]); o[c] = MFMA16(v1, pf1, o[c]); }
        if (t + 1 < NT) SA_STORE(t + 1, buf ^ 1);
        __syncthreads();
    }
#undef SA_LOAD
#undef SA_STORE
    { float l = lrun; l += __shfl_xor(l, 16); l += __shfl_xor(l, 32);
      float* pr = APART + ((size_t)(b * 2 + split) * 64 + 16 * jq + li) * AP_ST;
#pragma unroll
      for (int c = 0; c < 8; ++c) *(GAS f32x4*)(pr + 128 * ch + 16 * c + 4 * g) = o[c];
      if (ch == 0 && g == 0) { pr[256] = mrun; pr[257] = l; } }
}
__device__ __forceinline__ void attn_sample_combine(const Frame& F, const P& p) {
    const float* APART = (const float*)(p.ws + WS_APART); bf16* OLAT = (bf16*)(p.ws + WS_OLAT);
    const int gw = F.vcu * NWAVES + F.wave, NGW = F.G * NWAVES, lane = F.lane;
    for (int it = gw; it < DBATCH * 64; it += NGW) { const int b = it >> 6, r = it & 63;
        const float* p0 = APART + ((size_t)(b * 2 + 0) * 64 + r) * AP_ST; const float* p1 = APART + ((size_t)(b * 2 + 1) * 64 + r) * AP_ST;
        const float m0 = p0[256], l0 = p0[257], m1 = p1[256], l1 = p1[257]; const float m = fmaxf(m0, m1); const float w0 = __builtin_amdgcn_exp2f(m0 - m), w1 = __builtin_amdgcn_exp2f(m1 - m);
        const float rl = 1.f / (w0 * l0 + w1 * l1);
        const f32x4 a = *(const GAS f32x4*)(p0 + 4 * lane), c = *(const GAS f32x4*)(p1 + 4 * lane);
        u32x2 wv; wv.x = pk2((w0 * a[0] + w1 * c[0]) * rl, (w0 * a[1] + w1 * c[1]) * rl); wv.y = pk2((w0 * a[2] + w1 * c[2]) * rl, (w0 * a[3] + w1 * c[3]) * rl);
        *(GAS u32x2*)(OLAT + (size_t)(b * 8 + (r >> 3)) * 2048 + (r & 7) * 256 + 4 * lane) = wv; }
}

constexpr int SD_XST = 72, SD_BST = 136;
__device__ __forceinline__ void cumsum128(LAS float* a, LAS float* acum, int lane) {
    float v0 = a[2 * lane], v1 = a[2 * lane + 1]; float s = v0 + v1;
#pragma unroll
    for (int o = 1; o < 64; o <<= 1) { const float n = __shfl_up(s, o); if (lane >= o) s += n; }
    acum[2 * lane] = s - v1; acum[2 * lane + 1] = s;
}
__device__ __forceinline__ void ssd_a_unit(const Frame& F, const P& p, int b, int c, int h) {
    unsigned char* ws = p.ws; const bf16* XBC = (const bf16*)(ws + WS_XBC); const float* DT = (const float*)(ws + WS_DT);
    float* STATES = (float*)(ws + WS_STATES); float* CDEC = (float*)(ws + WS_CDEC);
    const int tid = F.tid, lane = F.lane, w = F.wave, li = lane & 15, g = lane >> 4, g2 = h >> 2;
    LAS unsigned char* lds = F.lds + RING_OFF;
    LAS unsigned char* xs_l = lds;
    LAS unsigned char* b_l = lds + 18432;
    LAS float* a_l = (LAS float*)(lds + 18432 + 34816);
    LAS float* ac_l = a_l + 128; LAS float* dt_l = a_l + 256;
    const size_t t0 = (size_t)b * SEQ + (size_t)c * CHUNK;
    const float Ah = -__expf(p.a_log[h]);
    __syncthreads();
    if (tid < 128) { const float d = DT[(t0 + tid) * 8 + h]; dt_l[tid] = d; a_l[tid] = d * Ah; }
#pragma unroll
    for (int i = 0; i < 4; ++i) { const int q = tid + 512 * i, row = q >> 4, ch8 = q & 15; *(LAS v4u*)(b_l + (row * SD_BST + ch8 * 8) * 2) = *(const GAS v4u*)(XBC + (t0 + row) * CONVD + 512 + g2 * 128 + ch8 * 8); }
    __syncthreads();
    if (w == 0) cumsum128(a_l, ac_l, lane);
    __syncthreads();
    const float alast = ac_l[127];
#pragma unroll
    for (int i = 0; i < 2; ++i) { const int q = tid + 512 * i, row = q >> 3, ch8 = q & 7; const v4u v = *(const GAS v4u*)(XBC + (t0 + row) * CONVD + h * 64 + ch8 * 8);
        const float sc = dt_l[row] * __expf(alast - ac_l[row]); v4u o;
        o.x = pk2(bflo(v.x) * sc, bfhi(v.x) * sc); o.y = pk2(bflo(v.y) * sc, bfhi(v.y) * sc); o.z = pk2(bflo(v.z) * sc, bfhi(v.z) * sc); o.w = pk2(bflo(v.w) * sc, bfhi(v.w) * sc);
        *(LAS v4u*)(xs_l + (row * SD_XST + ch8 * 8) * 2) = o; }
    __syncthreads();
    if (tid == 0) CDEC[(b * NCHUNK + c) * 8 + h] = __expf(alast);
    f32x4 acc[4];
#pragma unroll
    for (int pt = 0; pt < 4; ++pt) acc[pt] = (f32x4){0.f, 0.f, 0.f, 0.f};
#pragma unroll
    for (int kk = 0; kk < 4; ++kk) {
        const LAS unsigned char* ba = b_l + ((32 * kk + 8 * g + (li >> 2)) * SD_BST + 16 * w + 4 * (li & 3)) * 2;
        const bf16x8 bfr = cat8(tr_read(ba), tr_read(ba + 4 * SD_BST * 2));
#pragma unroll
        for (int pt = 0; pt < 4; ++pt) {
            const LAS unsigned char* xa = xs_l + ((32 * kk + 8 * g + (li >> 2)) * SD_XST + 16 * pt + 4 * (li & 3)) * 2;
            const bf16x8 xfr = cat8(tr_read(xa), tr_read(xa + 4 * SD_XST * 2));
            acc[pt] = MFMA16(xfr, bfr, acc[pt]); } }
    float* so = STATES + ((size_t)((b * NCHUNK + c) * 8 + h) * 64) * 128;
#pragma unroll
    for (int pt = 0; pt < 4; ++pt)
#pragma unroll
        for (int r = 0; r < 4; ++r) so[(size_t)(16 * pt + 4 * g + r) * 128 + 16 * w + li] = acc[pt][r];
}
__device__ __forceinline__ void ssd_b_scan(const Frame& F, const P& p) {
    unsigned char* ws = p.ws; const float* STATES = (const float*)(ws + WS_STATES); const float* CDEC = (const float*)(ws + WS_CDEC); bf16* HPREV = (bf16*)(ws + WS_HPREV);
    const size_t gt = (size_t)F.vcu * NTHR + F.tid, NGT = (size_t)F.G * NTHR;
    for (size_t e = gt; e < (size_t)2 * 8 * 64 * 128; e += NGT) { const int b = (int)(e >> 16), h = (int)(e >> 13) & 7, pn = (int)(e & 8191);
        float hcur = 0.f;
        for (int c0 = 0; c0 < NCHUNK; c0 += 16) { float sv[16];
#pragma unroll
            for (int i = 0; i < 16; ++i) sv[i] = STATES[((size_t)((b * NCHUNK + c0 + i) * 8 + h)) * 8192 + pn];
#pragma unroll
            for (int i = 0; i < 16; ++i) { HPREV[((size_t)((b * NCHUNK + c0 + i) * 8 + h)) * 8192 + pn] = (bf16)f2bf(hcur); hcur = CDEC[(b * NCHUNK + c0 + i) * 8 + h] * hcur + sv[i]; } }
        p.out[OUT_SSP + e] = hcur; }
}
__device__ __forceinline__ void ssd_c_unit(const Frame& F, const P& p, int b, int c, int h) {
    unsigned char* ws = p.ws; const bf16* XBC = (const bf16*)(ws + WS_XBC); const float* DT = (const float*)(ws + WS_DT); const bf16* HPREV = (const bf16*)(ws + WS_HPREV);
    const bf16* U = (const bf16*)(ws + WS_U);
    const int tid = F.tid, lane = F.lane, w = F.wave, li = lane & 15, g = lane >> 4, g2 = h >> 2;
    LAS unsigned char* lds = F.lds + RING_OFF;
    LAS unsigned char* x_l = lds;
    LAS unsigned char* b_l = lds + 18432;
    LAS unsigned char* c_l = lds + 18432 + 34816;
    LAS unsigned char* h_l = lds + 18432 + 2 * 34816;
    LAS float* a_l = (LAS float*)(lds + 18432 + 2 * 34816 + 17408);
    LAS float* ac_l = a_l + 128; LAS float* dt_l = a_l + 256;
    const size_t t0 = (size_t)b * SEQ + (size_t)c * CHUNK;
    const float Ah = -__expf(p.a_log[h]);
    __syncthreads();
    if (tid < 128) { const float d = DT[(t0 + tid) * 8 + h]; dt_l[tid] = d; a_l[tid] = d * Ah; }
#pragma unroll
    for (int i = 0; i < 4; ++i) { const int q = tid + 512 * i, row = q >> 4, ch8 = q & 15;
        *(LAS v4u*)(b_l + (row * SD_BST + ch8 * 8) * 2) = *(const GAS v4u*)(XBC + (t0 + row) * CONVD + 512 + g2 * 128 + ch8 * 8);
        *(LAS v4u*)(c_l + (row * SD_BST + ch8 * 8) * 2) = *(const GAS v4u*)(XBC + (t0 + row) * CONVD + 768 + g2 * 128 + ch8 * 8); }
#pragma unroll
    for (int i = 0; i < 2; ++i) { const int q = tid + 512 * i, row = q >> 4, ch8 = q & 15;
        *(LAS v4u*)(h_l + (row * SD_BST + ch8 * 8) * 2) = *(const GAS v4u*)(HPREV + ((size_t)((b * NCHUNK + c) * 8 + h) * 64 + row) * 128 + ch8 * 8); }
    __syncthreads();
    if (w == 0) cumsum128(a_l, ac_l, lane);
    __syncthreads();
#pragma unroll
    for (int i = 0; i < 2; ++i) { const int q = tid + 512 * i, row = q >> 3, ch8 = q & 7; const v4u v = *(const GAS v4u*)(XBC + (t0 + row) * CONVD + h * 64 + ch8 * 8);
        const float sc = dt_l[row]; v4u o;
        o.x = pk2(bflo(v.x) * sc, bfhi(v.x) * sc); o.y = pk2(bflo(v.y) * sc, bfhi(v.y) * sc); o.z = pk2(bflo(v.z) * sc, bfhi(v.z) * sc); o.w = pk2(bflo(v.w) * sc, bfhi(v.w) * sc);
        *(LAS v4u*)(x_l + (row * SD_XST + ch8 * 8) * 2) = o; }
    __syncthreads();
    bf16x8 cf[4];
#pragma unroll
    for (int ks = 0; ks < 4; ++ks) cf[ks] = *(const LAS bf16x8*)(c_l + ((16 * w + li) * SD_BST + 32 * ks + 8 * g) * 2);
    const float acl = ac_l[16 * w + li];
    f32x4 yd[4], yo[4];
#pragma unroll
    for (int pt = 0; pt < 4; ++pt) { yd[pt] = (f32x4){0.f, 0.f, 0.f, 0.f}; yo[pt] = (f32x4){0.f, 0.f, 0.f, 0.f}; }
#pragma unroll
    for (int kk = 0; kk < 4; ++kk) {
        if (2 * kk <= w) {
            f32x4 sg[2];
#pragma unroll
            for (int u = 0; u < 2; ++u) { const int stile = 2 * kk + u; f32x4 a = (f32x4){0.f, 0.f, 0.f, 0.f};
                if (stile <= w) {
#pragma unroll
                    for (int ks = 0; ks < 4; ++ks) { const bf16x8 bfr = *(const LAS bf16x8*)(b_l + ((16 * stile + li) * SD_BST + 32 * ks + 8 * g) * 2); a = MFMA16(bfr, cf[ks], a); }
#pragma unroll
                    for (int r = 0; r < 4; ++r) { const int s = 16 * stile + 4 * g + r; const int l = 16 * w + li; a[r] = (s <= l) ? a[r] * __expf(acl - ac_l[s]) : 0.f; } }
                sg[u] = a; }
            const bf16x8 pf = pack8(sg[0], sg[1]);
#pragma unroll
            for (int pt = 0; pt < 4; ++pt) {
                const LAS unsigned char* xa = x_l + ((32 * kk + 4 * g + (li >> 2)) * SD_XST + 16 * pt + 4 * (li & 3)) * 2;
                const bf16x8 xfr = cat8(tr_read(xa), tr_read(xa + 16 * SD_XST * 2));
                yd[pt] = MFMA16(xfr, pf, yd[pt]); } } }
#pragma unroll
    for (int pt = 0; pt < 4; ++pt)
#pragma unroll
        for (int ks = 0; ks < 4; ++ks) { const bf16x8 hfr = *(const LAS bf16x8*)(h_l + ((16 * pt + li) * SD_BST + 32 * ks + 8 * g) * 2); yo[pt] = MFMA16(hfr, cf[ks], yo[pt]); }
    const float eal = __expf(acl); const float dsk = p.d_skip[h]; const size_t t = t0 + 16 * w + li;
    bf16* YGB = (bf16*)(ws + WS_YG);
#pragma unroll
    for (int pt = 0; pt < 4; ++pt) { const int pc = h * 64 + 16 * pt + 4 * g;
        const u32x2 xv = *(const GAS u32x2*)(XBC + t * CONVD + pc); const u32x2 zv = *(const GAS u32x2*)(U + t * IN_PAD + O_Z + pc);
        const float xs[4] = {bflo(xv.x), bfhi(xv.x), bflo(xv.y), bfhi(xv.y)}, zs[4] = {bflo(zv.x), bfhi(zv.x), bflo(zv.y), bfhi(zv.y)}; float y[4];
#pragma unroll
        for (int r = 0; r < 4; ++r) y[r] = (yd[pt][r] + eal * yo[pt][r] + dsk * xs[r]) * siluf(zs[r]);
        u32x2 wv; wv.x = pk2(y[0], y[1]); wv.y = pk2(y[2], y[3]); *(GAS u32x2*)(YGB + t * 512 + pc) = wv; }
}

__device__ __forceinline__ void ssd_sample_unit(const Frame& F, const P& p, int b, int h) {
    unsigned char* ws = p.ws; const bf16* XBC = (const bf16*)(ws + WS_XBC); const float* DT = (const float*)(ws + WS_DT); const bf16* U = (const bf16*)(ws + WS_U);
    bf16* YGB = (bf16*)(ws + WS_YG);
    const int tid = F.tid, g2 = h >> 2; const int pp = tid >> 3, nc = (tid & 7) * 16;
    LAS float* fl = (LAS float*)(F.lds + RING_OFF);
    LAS float* Bs = fl;
    LAS float* Cs = fl + 1024;
    LAS float* Xs = fl + 2048;
    LAS float* Gs = fl + 2560;
    LAS float* ac = fl + 2624;
    LAS float* dts = fl + 2632;
    const size_t t0 = (size_t)TP + (size_t)b * 8;
    __syncthreads();
    for (int q = tid; q < 1024; q += 512) { const int l = q >> 7, n = q & 127; Bs[q] = bf2f(XBC[(t0 + l) * CONVD + 512 + g2 * 128 + n]); Cs[q] = bf2f(XBC[(t0 + l) * CONVD + 768 + g2 * 128 + n]); }
    { const int l = tid >> 6, pq = tid & 63; Xs[tid] = bf2f(XBC[(t0 + l) * CONVD + h * 64 + pq]); }
    if (tid == 0) { const float Ah = -__expf(p.a_log[h]); float s = 0.f; for (int l = 0; l < 8; ++l) { const float d = DT[(t0 + l) * 8 + h]; dts[l] = d; s += d * Ah; ac[l] = s; } }
    __syncthreads();
    { const int l = pp >> 3, s = pp & 7; float a = 0.f;
#pragma unroll
      for (int i = 0; i < 16; ++i) a += Cs[l * 128 + nc + i] * Bs[s * 128 + nc + i];
      a += __shfl_xor(a, 1); a += __shfl_xor(a, 2); a += __shfl_xor(a, 4);
      if ((tid & 7) == 0) Gs[pp] = a; }
    const float* h0p = p.state_ssm + ((size_t)(b * 8 + h) * 64 + pp) * 128 + nc; float h0[16];
#pragma unroll
    for (int i = 0; i < 4; ++i) { const f32x4 v = *(const GAS f32x4*)(h0p + 4 * i); h0[4 * i] = v[0]; h0[4 * i + 1] = v[1]; h0[4 * i + 2] = v[2]; h0[4 * i + 3] = v[3]; }
    __syncthreads();
    float yoff[8];
#pragma unroll
    for (int l = 0; l < 8; ++l) { float a = 0.f;
#pragma unroll
        for (int i = 0; i < 16; ++i) a += Cs[l * 128 + nc + i] * h0[i];
        a += __shfl_xor(a, 1); a += __shfl_xor(a, 2); a += __shfl_xor(a, 4); yoff[l] = a; }
    const float a7 = ac[7]; float hn[16]; const float e7 = __expf(a7);
#pragma unroll
    for (int i = 0; i < 16; ++i) hn[i] = e7 * h0[i];
#pragma unroll
    for (int l = 0; l < 8; ++l) { const float cf = Xs[l * 64 + pp] * dts[l] * __expf(a7 - ac[l]);
#pragma unroll
        for (int i = 0; i < 16; ++i) hn[i] += cf * Bs[l * 128 + nc + i]; }
    float* ho = p.out + OUT_SSS + ((size_t)(b * 8 + h) * 64 + pp) * 128 + nc;
#pragma unroll
    for (int i = 0; i < 4; ++i) *(GAS f32x4*)(ho + 4 * i) = (f32x4){hn[4 * i], hn[4 * i + 1], hn[4 * i + 2], hn[4 * i + 3]};
    { const int l = tid & 7; float yv = 0.f;
#pragma unroll
      for (int l2 = 0; l2 < 8; ++l2) { float yd = 0.f;
#pragma unroll
          for (int s = 0; s < 8; ++s) if (s <= l2) yd += Gs[l2 * 8 + s] * __expf(ac[l2] - ac[s]) * Xs[s * 64 + pp] * dts[s];
          const float tot = yd + __expf(ac[l2]) * yoff[l2] + p.d_skip[h] * Xs[l2 * 64 + pp];
          if (l2 == l) yv = tot; }
      const float z = bf2f(U[(t0 + l) * IN_PAD + O_Z + h * 64 + pp]);
      YGB[(t0 + l) * 512 + h * 64 + pp] = (bf16)f2bf(yv * siluf(z)); }
}

__device__ __forceinline__ void mixa_rows(const Frame& F, const P& p) {
    const bf16* OATT = (const bf16*)(p.ws + WS_OATT); const bf16* YG = (const bf16*)(p.ws + WS_YG); bf16* MIXA = (bf16*)(p.ws + WS_MIXA);
    const int lane = F.lane; const int gw = F.vcu * NWAVES + F.wave, NGW = F.G * NWAVES;
    for (int t = gw; t < TALL; t += NGW) {
        { const v4u v = *(const GAS v4u*)(OATT + (size_t)t * 512 + 8 * lane); float x[8] = {bflo(v.x), bfhi(v.x), bflo(v.y), bfhi(v.y), bflo(v.z), bfhi(v.z), bflo(v.w), bfhi(v.w)}; float ss = 0.f;
#pragma unroll
          for (int i = 0; i < 8; ++i) ss += x[i] * x[i];
          const float r = rsqrtf(wave_sum(ss) * (1.f / 512.f) + 1e-6f); const float* gn = p.attn_out_norm + 8 * lane; v4u o;
          o.x = pk2(x[0] * r * gn[0], x[1] * r * gn[1]); o.y = pk2(x[2] * r * gn[2], x[3] * r * gn[3]); o.z = pk2(x[4] * r * gn[4], x[5] * r * gn[5]); o.w = pk2(x[6] * r * gn[6], x[7] * r * gn[7]);
          *(GAS v4u*)(MIXA + (size_t)t * DM + 8 * lane) = o; }
        { const v4u v = *(const GAS v4u*)(YG + (size_t)t * 512 + 8 * lane); float x[8] = {bflo(v.x), bfhi(v.x), bflo(v.y), bfhi(v.y), bflo(v.z), bfhi(v.z), bflo(v.w), bfhi(v.w)}; float ss = 0.f;
#pragma unroll
          for (int i = 0; i < 8; ++i) ss += x[i] * x[i];
#pragma unroll
          for (int o_ = 1; o_ < 32; o_ <<= 1) ss += __shfl_xor(ss, o_);
          const float r = rsqrtf(ss * (1.f / 256.f) + 1e-6f); const float* gn = p.ssm_norm + 8 * lane; v4u o;
          o.x = pk2(x[0] * r * gn[0], x[1] * r * gn[1]); o.y = pk2(x[2] * r * gn[2], x[3] * r * gn[3]); o.z = pk2(x[4] * r * gn[4], x[5] * r * gn[5]); o.w = pk2(x[6] * r * gn[6], x[7] * r * gn[7]);
          *(GAS v4u*)(MIXA + (size_t)t * DM + 512 + 8 * lane) = o; }
    }
}

__device__ __forceinline__ void ln_rows(const Frame& F, const float* res_p, const float* res_s, const bf16* delta, const float* gam, const float* bet, float* outf, bf16* outb) {
    const int lane = F.lane; const int gw = F.vcu * NWAVES + F.wave, NGW = F.G * NWAVES;
    for (int t = gw; t < TALL; t += NGW) {
        const float* rr = t < TP ? res_p + (size_t)t * DM : res_s + (size_t)(t - TP) * DM;
        f32x4 v[4]; float s = 0.f;
#pragma unroll
        for (int j = 0; j < 4; ++j) { const f32x4 r = *(const GAS f32x4*)(rr + 256 * j + 4 * lane); const u32x2 d = *(const GAS u32x2*)(delta + (size_t)t * DM + 256 * j + 4 * lane);
            v[j] = (f32x4){DN_ALPHA * r[0] + bflo(d.x), DN_ALPHA * r[1] + bfhi(d.x), DN_ALPHA * r[2] + bflo(d.y), DN_ALPHA * r[3] + bfhi(d.y)}; s += (v[j][0] + v[j][1]) + (v[j][2] + v[j][3]); }
        const float mean = wave_sum(s) * (1.f / DM); float s2 = 0.f;
#pragma unroll
        for (int j = 0; j < 4; ++j) { v[j] = v[j] - mean; s2 += (v[j][0] * v[j][0] + v[j][1] * v[j][1]) + (v[j][2] * v[j][2] + v[j][3] * v[j][3]); }
        const float rstd = rsqrtf(wave_sum(s2) * (1.f / DM) + 1e-5f);
#pragma unroll
        for (int j = 0; j < 4; ++j) { const f32x4 gg = *(const GAS f32x4*)(gam + 256 * j + 4 * lane), bb = *(const GAS f32x4*)(bet + 256 * j + 4 * lane); const f32x4 o = v[j] * rstd * gg + bb;
            *(GAS f32x4*)(outf + (size_t)t * DM + 256 * j + 4 * lane) = o;
            if (outb) { u32x2 w; w.x = pk2(o[0], o[1]); w.y = pk2(o[2], o[3]); *(GAS u32x2*)(outb + (size_t)t * DM + 256 * j + 4 * lane) = w; } }
    }
}

constexpr int MA_ST = 264;
constexpr int MA_TILE = 64 * MA_ST * 2;
__device__ __forceinline__ void mem_attn_prompt_unit(const Frame& F, const P& p, int b, int hm, int qblk) {
    unsigned char* ws = p.ws; const bf16* QM = (const bf16*)(ws + WS_QM); const bf16* MK = (const bf16*)(ws + WS_MK); const bf16* MV = (const bf16*)(ws + WS_MV); bf16* OM = (bf16*)(ws + WS_OM);
    const int tid = F.tid, lane = F.lane, w = F.wave, li = lane & 15, g = lane >> 4;
    LAS unsigned char* kl = F.lds + RING_OFF; LAS unsigned char* vl = kl + MA_TILE;
    const size_t qrow = (size_t)b * SEQ + (size_t)qblk * 128 + 16 * w + li;
    bf16x8 qf[8];
#pragma unroll
    for (int ks = 0; ks < 8; ++ks) qf[ks] = *(const GAS bf16x8*)(QM + qrow * DM + hm * 256 + 32 * ks + 8 * g);
    f32x4 o[16];
#pragma unroll
    for (int d = 0; d < 16; ++d) o[d] = (f32x4){0.f, 0.f, 0.f, 0.f};
    float mrun = -INFINITY, lrun = 0.f;
    v4u sk[4], sv[4];
#define MA_LOAD(t) do { _Pragma("unroll") for (int i_ = 0; i_ < 4; ++i_) { const int q_ = tid + 512 * i_, row_ = q_ >> 5, c8_ = q_ & 31; const size_t off_ = ((size_t)b * NMEM + (t) * 64 + row_) * DM + hm * 256 + c8_ * 8; \
        sk[i_] = *(const GAS v4u*)(MK + off_); sv[i_] = *(const GAS v4u*)(MV + off_); } } while (0)
#define MA_STORE() do { _Pragma("unroll") for (int i_ = 0; i_ < 4; ++i_) { const int q_ = tid + 512 * i_, row_ = q_ >> 5, c8_ = q_ & 31; \
        *(LAS v4u*)(kl + (row_ * MA_ST + c8_ * 8) * 2) = sk[i_]; *(LAS v4u*)(vl + (row_ * MA_ST + c8_ * 8) * 2) = sv[i_]; } } while (0)
    MA_LOAD(0);
    for (int t = 0; t < 4; ++t) {
        __syncthreads();
        MA_STORE();
        __syncthreads();
        if (t + 1 < 4) MA_LOAD(t + 1);
        f32x4 s[4];
#pragma unroll
        for (int kt = 0; kt < 4; ++kt) { f32x4 a = (f32x4){0.f, 0.f, 0.f, 0.f};
#pragma unroll
            for (int ks = 0; ks < 8; ++ks) { const bf16x8 kf = *(const LAS bf16x8*)(kl + ((16 * kt + li) * MA_ST + 32 * ks + 8 * g) * 2); a = MFMA16(kf, qf[ks], a); }
            s[kt] = a; }
        float mx = -INFINITY;
#pragma unroll
        for (int kt = 0; kt < 4; ++kt)
#pragma unroll
            for (int r = 0; r < 4; ++r) mx = fmaxf(mx, s[kt][r]);
        mx = fmaxf(mx, __shfl_xor(mx, 16)); mx = fmaxf(mx, __shfl_xor(mx, 32));
        const float mn = fmaxf(mrun, mx); const float alpha = __builtin_amdgcn_exp2f(mrun - mn); mrun = mn;
        float ps = 0.f;
#pragma unroll
        for (int kt = 0; kt < 4; ++kt)
#pragma unroll
            for (int r = 0; r < 4; ++r) { const float e = __builtin_amdgcn_exp2f(s[kt][r] - mn); s[kt][r] = e; ps += e; }
        lrun = lrun * alpha + ps;
#pragma unroll
        for (int d = 0; d < 16; ++d) o[d] = o[d] * alpha;
        const bf16x8 pf0 = pack8(s[0], s[1]), pf1 = pack8(s[2], s[3]);
#pragma unroll
        for (int d = 0; d < 16; ++d) {
            const LAS unsigned char* va = vl + ((4 * g + (li >> 2)) * MA_ST + 16 * d + 4 * (li & 3)) * 2;
            const bf16x8 v0 = cat8(tr_read(va), tr_read(va + 16 * MA_ST * 2)); const bf16x8 v1 = cat8(tr_read(va + 32 * MA_ST * 2), tr_read(va + 48 * MA_ST * 2));
            o[d] = MFMA16(v0, pf0, o[d]); o[d] = MFMA16(v1, pf1, o[d]); }
    }
#undef MA_LOAD
#undef MA_STORE
    { float l = lrun; l += __shfl_xor(l, 16); l += __shfl_xor(l, 32); const float rl = 1.f / l; bf16* orow = OM + qrow * DM + hm * 256 + 4 * g;
#pragma unroll
      for (int d = 0; d < 16; ++d) { u32x2 wv; wv.x = pk2(o[d][0] * rl, o[d][1] * rl); wv.y = pk2(o[d][2] * rl, o[d][3] * rl); *(GAS u32x2*)(orow + 16 * d) = wv; } }
    __syncthreads();
}
__device__ __forceinline__ void mem_attn_sample_unit(const Frame& F, const P& p, int b, int hm) {
    unsigned char* ws = p.ws; const bf16* QM = (const bf16*)(ws + WS_QM); bf16* OM = (bf16*)(ws + WS_OM);
    const int tid = F.tid; LAS float* fl = (LAS float*)(F.lds + RING_OFF);
    LAS float* Qs = fl;
    LAS float* Ps = fl + 2048;
    LAS float* Rs = fl + 4096;
    __syncthreads();
    for (int q = tid; q < 2048; q += 512) { const int tk = q >> 8, d = q & 255; Qs[q] = bf2f(QM[(size_t)(TP + b * 8 + tk) * DM + hm * 256 + d]); }
    __syncthreads();
    { const int m = tid & 255, half = tid >> 8; const float* kr = p.cache_mk + (((size_t)b * NMEM + m) * MH + hm) * MHD; float acc[4] = {0.f, 0.f, 0.f, 0.f};
#pragma unroll 8
      for (int d4 = 0; d4 < 64; ++d4) { const f32x4 kv = __builtin_nontemporal_load((const GAS f32x4*)(kr + 4 * d4));
#pragma unroll
          for (int tk = 0; tk < 4; ++tk) { const LAS float* qq = Qs + (4 * half + tk) * 256 + 4 * d4; acc[tk] += kv[0] * qq[0] + kv[1] * qq[1] + kv[2] * qq[2] + kv[3] * qq[3]; } }
#pragma unroll
      for (int tk = 0; tk < 4; ++tk) Ps[(4 * half + tk) * 256 + m] = acc[tk]; }
    __syncthreads();
    { const int w = F.wave, lane = F.lane; float v[4]; float mx = -INFINITY;
#pragma unroll
      for (int i = 0; i < 4; ++i) { v[i] = Ps[w * 256 + lane + 64 * i]; mx = fmaxf(mx, v[i]); }
#pragma unroll
      for (int o_ = 1; o_ < 64; o_ <<= 1) mx = fmaxf(mx, __shfl_xor(mx, o_));
      float s = 0.f;
#pragma unroll
      for (int i = 0; i < 4; ++i) { v[i] = __builtin_amdgcn_exp2f(v[i] - mx); s += v[i]; Ps[w * 256 + lane + 64 * i] = v[i]; }
      s = wave_sum(s); if (lane == 0) Rs[w] = 1.f / s; }
    __syncthreads();
    { const int dv = tid & 255, half = tid >> 8; const float* vr = p.cache_mv + ((size_t)b * NMEM * MH + hm) * MHD + dv; float acc[4] = {0.f, 0.f, 0.f, 0.f};
#pragma unroll 8
      for (int m = 0; m < NMEM; ++m) { const float vv = __builtin_nontemporal_load(vr + (size_t)m * (MH * MHD));
#pragma unroll
          for (int tk = 0; tk < 4; ++tk) acc[tk] += Ps[(4 * half + tk) * 256 + m] * vv; }
#pragma unroll
      for (int tk = 0; tk < 4; ++tk) OM[(size_t)(TP + b * 8 + 4 * half + tk) * DM + hm * 256 + dv] = (bf16)f2bf(acc[tk] * Rs[4 * half + tk]); }
}

__device__ __forceinline__ void peer_scores_unit(const Frame& F, const P& p, int tb, int gg) {
    unsigned char* ws = p.ws; const bf16* PQ = (const bf16*)(ws + WS_PQ); const bf16* KEYS = (const bf16*)(ws + WS_PKEYS); float* TOPS = (float*)(ws + WS_PTOPS);
    const int lane = F.lane, w = F.wave, li = lane & 15, g = lane >> 4;
    bf16x8 tf[2][4];
#pragma unroll
    for (int j = 0; j < 2; ++j)
#pragma unroll
        for (int ks = 0; ks < 4; ++ks) tf[j][ks] = *(const GAS bf16x8*)(PQ + (size_t)(tb * 256 + 32 * w + 16 * j + li) * 2048 + gg * 128 + 32 * ks + 8 * g);
    f32x4 s[2][8];
#pragma unroll
    for (int kt = 0; kt < 8; ++kt) { bf16x8 kf[4];
#pragma unroll
        for (int ks = 0; ks < 4; ++ks) kf[ks] = *(const GAS bf16x8*)(KEYS + ((size_t)gg * 128 + 16 * kt + li) * 128 + 32 * ks + 8 * g);
#pragma unroll
        for (int j = 0; j < 2; ++j) { f32x4 a = (f32x4){0.f, 0.f, 0.f, 0.f};
#pragma unroll
            for (int ks = 0; ks < 4; ++ks) a = MFMA16(kf[ks], tf[j][ks], a);
            s[j][kt] = a; } }
#pragma unroll
    for (int j = 0; j < 2; ++j) {
        float top[16];
#pragma unroll
        for (int i = 0; i < 16; ++i) top[i] = -INFINITY;
#pragma unroll
        for (int kt = 0; kt < 8; ++kt)
#pragma unroll
            for (int r = 0; r < 4; ++r) { float cv = __uint_as_float((__float_as_uint(s[j][kt][r]) & ~127u) | (unsigned)(16 * kt + 4 * g + r));
#pragma unroll
                for (int i = 0; i < 16; ++i) { const float hi_ = fmaxf(top[i], cv), lo_ = fminf(top[i], cv); top[i] = hi_; cv = lo_; } }
#pragma unroll
        for (int off = 16; off <= 32; off <<= 1) {
            float c[16];
#pragma unroll
            for (int i = 0; i < 16; ++i) c[i] = fmaxf(top[i], __shfl_xor(top[15 - i], off));
#pragma unroll
            for (int d = 8; d >= 1; d >>= 1)
#pragma unroll
                for (int i = 0; i < 16; ++i) if ((i & d) == 0) { const float hi_ = fmaxf(c[i], c[i + d]), lo_ = fminf(c[i], c[i + d]); c[i] = hi_; c[i + d] = lo_; }
#pragma unroll
            for (int i = 0; i < 16; ++i) top[i] = c[i]; }
        float* to = TOPS + ((size_t)(tb * 256 + 32 * w + 16 * j + li) * 16 + gg) * 16;
        *(GAS f32x4*)(to + 4 * g) = (f32x4){g == 0 ? top[0] : g == 1 ? top[4] : g == 2 ? top[8] : top[12], g == 0 ? top[1] : g == 1 ? top[5] : g == 2 ? top[9] : top[13],
                                            g == 0 ? top[2] : g == 1 ? top[6] : g == 2 ? top[10] : top[14], g == 0 ? top[3] : g == 1 ? top[7] : g == 2 ? top[11] : top[15]};
    }
}
__device__ __forceinline__ void peer_cand(const Frame& F, const P& p) {
    const float* TOPS = (const float*)(p.ws + WS_PTOPS); int* PIDX = (int*)(p.ws + WS_PIDX); float* PG = (float*)(p.ws + WS_PG);
    const size_t gt = (size_t)F.vcu * NTHR + F.tid, NGT = (size_t)F.G * NTHR;
    for (size_t it = gt; it < (size_t)TALL * PH; it += NGT) {
        const float* ta = TOPS + it * 32; const float* tb_ = ta + 16;
        float val[16]; int idx[16];
#pragma unroll
        for (int i = 0; i < 16; ++i) { val[i] = -INFINITY; idx[i] = 0; }
        for (int i = 0; i < 16; ++i) { const unsigned ua = __float_as_uint(ta[i]); const float va = __uint_as_float(ua & ~127u); const int ia = (int)(ua & 127u); const int nj = 16 / (i + 1);
            for (int j = 0; j < nj; ++j) { const unsigned ub = __float_as_uint(tb_[j]); float cv = va + __uint_as_float(ub & ~127u); int ci = ia * NKEYS + (int)(ub & 127u);
#pragma unroll
                for (int k = 0; k < 16; ++k) { const bool gt_ = cv > val[k]; const float nv = gt_ ? cv : val[k]; const float nc = gt_ ? val[k] : cv; const int ni = gt_ ? ci : idx[k]; const int nci = gt_ ? idx[k] : ci;
                    val[k] = nv; cv = nc; idx[k] = ni; ci = nci; } } }
        float s = 0.f; float e[16];
#pragma unroll
        for (int k = 0; k < 16; ++k) { e[k] = __expf(val[k] - val[0]); s += e[k]; }
        const float rs = 1.f / s;
#pragma unroll
        for (int k = 0; k < 16; ++k) { PIDX[it * 16 + k] = idx[k]; PG[it * 16 + k] = e[k] * rs; }
    }
}
typedef __bf16 bf16x2_t __attribute__((ext_vector_type(2)));
__device__ __forceinline__ float dot2bf(unsigned a, unsigned b, float c) {
#if __has_builtin(__builtin_amdgcn_fdot2_f32_bf16)
    return __builtin_amdgcn_fdot2_f32_bf16(__builtin_bit_cast(bf16x2_t, a), __builtin_bit_cast(bf16x2_t, b), c, false);
#else
    return c + bflo(a) * bflo(b) + bfhi(a) * bfhi(b);
#endif
}
__device__ __forceinline__ void peer_gather(const Frame& F, const P& p) {
    unsigned char* ws = p.ws; const bf16* H2B = (const bf16*)(ws + WS_H2B); const float* H2 = (const float*)(ws + WS_H2); const bf16* PU = (const bf16*)(ws + WS_PU); const bf16* PV = (const bf16*)(ws + WS_PV);
    const int* PIDX = (const int*)(ws + WS_PIDX); const float* PG = (const float*)(ws + WS_PG);
    const int lane = F.lane, sub = lane & 15, rs = lane >> 4; const int gw = F.vcu * NWAVES + F.wave, NGW = F.G * NWAVES;
    LAS float* wl = (LAS float*)(F.lds + RING_OFF) + F.wave * 128;
    for (int t = gw; t < TALL; t += NGW) {
        v4u xv[8];
#pragma unroll
        for (int c = 0; c < 8; ++c) xv[c] = *(const GAS v4u*)(H2B + (size_t)t * DM + 128 * c + 8 * sub);
        const int* ip = PIDX + (size_t)t * 128; const float* gp = PG + (size_t)t * 128;
#pragma unroll 2
        for (int it = 0; it < 32; ++it) { const int k = 4 * it + rs; const int e = ip[k]; const bf16* ur = PU + (size_t)e * DM + 8 * sub; float a = 0.f;
            v4u uv[8];
#pragma unroll
            for (int c = 0; c < 8; ++c) uv[c] = *(const GAS v4u*)(ur + 128 * c);
#pragma unroll
            for (int c = 0; c < 8; ++c) { a = dot2bf(uv[c].x, xv[c].x, a); a = dot2bf(uv[c].y, xv[c].y, a); a = dot2bf(uv[c].z, xv[c].z, a); a = dot2bf(uv[c].w, xv[c].w, a); }
            a += __shfl_xor(a, 1); a += __shfl_xor(a, 2); a += __shfl_xor(a, 4); a += __shfl_xor(a, 8);
            const float act = 0.5f * a * (1.f + erff(a * 0.70710678118654752f));
            if (sub == 0) wl[k] = gp[k] * act; }
        LDS_WAIT(); asm volatile("" ::: "memory");
        float acc[64];
#pragma unroll
        for (int i = 0; i < 64; ++i) acc[i] = 0.f;
#pragma unroll 2
        for (int it = 0; it < 32; ++it) { const int k = 4 * it + rs; const int e = ip[k]; const bf16* vr = PV + (size_t)e * DM + 8 * sub; const float wk = wl[k];
            v4u vv[8];
#pragma unroll
            for (int c = 0; c < 8; ++c) vv[c] = *(const GAS v4u*)(vr + 128 * c);
#pragma unroll
            for (int c = 0; c < 8; ++c) { acc[8 * c + 0] += wk * bflo(vv[c].x); acc[8 * c + 1] += wk * bfhi(vv[c].x); acc[8 * c + 2] += wk * bflo(vv[c].y); acc[8 * c + 3] += wk * bfhi(vv[c].y);
                acc[8 * c + 4] += wk * bflo(vv[c].z); acc[8 * c + 5] += wk * bfhi(vv[c].z); acc[8 * c + 6] += wk * bflo(vv[c].w); acc[8 * c + 7] += wk * bfhi(vv[c].w); } }
#pragma unroll
        for (int i = 0; i < 64; ++i) { acc[i] += __shfl_xor(acc[i], 16); acc[i] += __shfl_xor(acc[i], 32); }
        LDS_WAIT(); asm volatile("" ::: "memory");
        float v[16]; float s = 0.f;
#pragma unroll
        for (int cc = 0; cc < 2; ++cc) {
#pragma unroll
            for (int i = 0; i < 8; ++i) { float a = 0.f;
#pragma unroll
                for (int r2 = 0; r2 < 4; ++r2) if (rs == r2) a = acc[8 * (2 * r2 + cc) + i];
                v[8 * cc + i] = a; } }
        const int e0 = 128 * (2 * rs) + 8 * sub, e1 = 128 * (2 * rs + 1) + 8 * sub;
#pragma unroll
        for (int i = 0; i < 8; ++i) { v[i] += DN_ALPHA * H2[(size_t)t * DM + e0 + i]; v[8 + i] += DN_ALPHA * H2[(size_t)t * DM + e1 + i]; }
#pragma unroll
        for (int i = 0; i < 16; ++i) s += v[i];
        const float mean = wave_sum(s) * (1.f / DM); float s2 = 0.f;
#pragma unroll
        for (int i = 0; i < 16; ++i) { v[i] -= mean; s2 += v[i] * v[i]; }
        const float rstd = rsqrtf(wave_sum(s2) * (1.f / DM) + 1e-5f);
        float* yo = p.out + OUT_YP + (size_t)t * DM;
#pragma unroll
        for (int i = 0; i < 8; ++i) { yo[e0 + i] = v[i] * rstd * p.ln3_g[e0 + i] + p.ln3_b[e0 + i]; yo[e1 + i] = v[8 + i] * rstd * p.ln3_g[e1 + i] + p.ln3_b[e1 + i]; }
    }
}

#if MK_DIAG
__constant__ int DG_TL[24] = {0, 1, 2, 3, 15, 16, 17, 31, 32, 33, 63, 64, 65, 127, 128, 129, 255, 256, 257, 511, 512, 4095, 4096, 8191};
constexpr int NCHK = 24;
__device__ __forceinline__ unsigned dh(unsigned i, unsigned k) { unsigned x = i * 2654435761u + k * 40503u + 12345u; x ^= x >> 15; x *= 2246822519u; x ^= x >> 13; return x; }
struct DAcc { float d2, r2; };
__device__ __forceinline__ void dacc(DAcc& a, float fast, float ref) { float e = fast - ref; if (!(e == e) || !(fabsf(e) < 1e18f)) e = 1e18f; a.d2 += e * e; a.r2 += ref * ref; }
__device__ __forceinline__ void dflush(const Frame& F, int k, DAcc a) { const float d = wave_sum(a.d2), r = wave_sum(a.r2); if (F.lane == 0) { float* dg = (float*)(F.ctl + CW_DIAG) + 2 * k; atomicAdd(dg, d); atomicAdd(dg + 1, r); } }
__device__ __forceinline__ float xin(const P& p, int t, int k) { return t < TP ? p.x_prompt[(size_t)t * DM + k] : p.x_sample[(size_t)(t - TP) * DM + k]; }
__device__ __forceinline__ float gelu_ref(float a) { return 0.5f * a * (1.f + erff(a * 0.70710678118654752f)); }

__device__ __forceinline__ void diag_phase(const Frame& F, const P& p, const XcdBarrier& bar) {
    unsigned char* ws = p.ws; const int lane = F.lane; const int gw = F.vcu * NWAVES + F.wave, NGW = F.G * NWAVES;
    const bf16* U = (const bf16*)(ws + WS_U); const bf16* CQN = (const bf16*)(ws + WS_CQN); const bf16* CKV = (const bf16*)(ws + WS_CKV); const bf16* KR = (const bf16*)(ws + WS_KR);
    const bf16* XBC = (const bf16*)(ws + WS_XBC); const float* DT = (const float*)(ws + WS_DT); const bf16* Q = (const bf16*)(ws + WS_Q); const bf16* KNV = (const bf16*)(ws + WS_KNV);
    const bf16* QLAT = (const bf16*)(ws + WS_QLAT); const bf16* OATT = (const bf16*)(ws + WS_OATT); const bf16* OLAT = (const bf16*)(ws + WS_OLAT); const bf16* HPREV = (const bf16*)(ws + WS_HPREV);
    const bf16* YG = (const bf16*)(ws + WS_YG); const bf16* MIXA = (const bf16*)(ws + WS_MIXA); const bf16* MIX = (const bf16*)(ws + WS_MIX); const float* H1 = (const float*)(ws + WS_H1);
    const bf16* H1B = (const bf16*)(ws + WS_H1B); const bf16* QM = (const bf16*)(ws + WS_QM); const bf16* MK = (const bf16*)(ws + WS_MK); const bf16* MV = (const bf16*)(ws + WS_MV);
    const bf16* OM = (const bf16*)(ws + WS_OM); const bf16* MIX2 = (const bf16*)(ws + WS_MIX2); const float* H2 = (const float*)(ws + WS_H2); const bf16* H2B = (const bf16*)(ws + WS_H2B);
    const bf16* PQ = (const bf16*)(ws + WS_PQ); const float* TOPS = (const float*)(ws + WS_PTOPS); const int* PIDX = (const int*)(ws + WS_PIDX); const float* PG = (const float*)(ws + WS_PG);
    LAS float* wl = (LAS float*)(F.lds + RING_OFF) + F.wave * 4096;
    const float QSC = MLA_SCALE * LOG2E;
    { DAcc a{0.f, 0.f};
      for (int it = gw; it < 512; it += NGW) { const int t = dh(it, 1) % TALL, n = dh(it, 2) % IN_DIM; float s = 0.f;
          for (int j = 0; j < 16; ++j) { const int k = lane + 64 * j; s += xin(p, t, k) * p.w_in[(size_t)k * IN_DIM + n]; }
          s = wave_sum(s); if (lane == 0) dacc(a, bf2f(U[(size_t)t * IN_PAD + n]), s); }
      dflush(F, 1, a); }
    { DAcc a{0.f, 0.f};
      for (int it = gw; it < 96; it += NGW) { int t;
          if (it < 8) t = it; else if (it < 16) t = SEQ + (it - 8); else if (it < 20) t = SEQ - 4 + (it - 16); else if (it < 24) t = TP - 4 + (it - 20); else if (it < 40) t = TP + 8 * (dh(it, 3) % DBATCH) + ((it - 24) & 7); else t = dh(it, 4) % TALL;
          const bool smp = t >= TP; const int ts = t - TP; const int tl = smp ? (ts & 7) : (t & (SEQ - 1)); const int pos = smp ? PAST + tl : tl; const bf16* ur = U + (size_t)t * IN_PAD;
          { float v[6]; float ss = 0.f; for (int i = 0; i < 6; ++i) { v[i] = bf2f(ur[O_CQ + lane + 64 * i]); ss += v[i] * v[i]; } const float r = rsqrtf(wave_sum(ss) / 384.f + 1e-6f);
            for (int i = 0; i < 6; ++i) dacc(a, bf2f(CQN[(size_t)t * QLORA + lane + 64 * i]), v[i] * r * p.q_a_norm[lane + 64 * i]); }
          { float v[4]; float ss = 0.f; for (int i = 0; i < 4; ++i) { v[i] = bf2f(ur[O_CKV + lane + 64 * i]); ss += v[i] * v[i]; } const float r = rsqrtf(wave_sum(ss) / 256.f + 1e-6f);
            const float* of = smp ? p.out + OUT_KVS + (size_t)ts * KVLORA : p.out + OUT_KVP + (size_t)t * KVLORA;
            for (int i = 0; i < 4; ++i) { const float rf = v[i] * r * p.kv_a_norm[lane + 64 * i]; dacc(a, bf2f(CKV[(size_t)t * KVLORA + lane + 64 * i]), rf); dacc(a, of[lane + 64 * i], rf); } }
          if (lane < 32) { const int i = lane & 15; const float x1 = bf2f(ur[O_KPE + i]), x2 = bf2f(ur[O_KPE + 16 + i]); const float ang = (float)pos * powf(10000.f, -(float)i / 16.f); const float c = cosf(ang), s = sinf(ang);
            const float rf = lane < 16 ? x1 * c - x2 * s : x2 * c + x1 * s; const float* of = smp ? p.out + OUT_KRS + (size_t)ts * ROPE : p.out + OUT_KRP + (size_t)t * ROPE;
            dacc(a, bf2f(KR[(size_t)t * ROPE + lane]), rf); dacc(a, of[lane], rf); }
          if (lane < 8) { const float raw = bf2f(ur[O_DT + lane]) + p.dt_bias[lane]; dacc(a, DT[(size_t)t * 8 + lane], log1pf(expf(raw))); }
          for (int i = 0; i < 16; ++i) { const int c = lane + 64 * i; float acc = p.conv_b[c];
              for (int k = 0; k < 4; ++k) { const int f = tl + k; float x; if (f >= 3) x = bf2f(U[(size_t)(t + k - 3) * IN_PAD + O_XBC + c]); else x = smp ? p.state_conv[((size_t)(ts >> 3) * 3 + f) * CONVD + c] : 0.f; acc += p.conv_w[k * CONVD + c] * x; }
              dacc(a, bf2f(XBC[(size_t)t * CONVD + c]), acc / (1.f + expf(-acc)));
              if (!smp && tl >= SEQ - 3) dacc(a, p.out[OUT_CVP + ((size_t)(t >> 13) * 3 + (tl - (SEQ - 3))) * CONVD + c], bf2f(ur[O_XBC + c]));
              if (smp && tl >= DSEQ - 3) dacc(a, p.out[OUT_CVS + ((size_t)(ts >> 3) * 3 + (tl - (DSEQ - 3))) * CONVD + c], bf2f(ur[O_XBC + c])); } }
      dflush(F, 2, a); }
    { DAcc a{0.f, 0.f};
      for (int it = gw; it < 512; it += NGW) { const int t = dh(it, 5) % TALL, c = dh(it, 6) % 768; float s = 0.f;
          for (int j = 0; j < 6; ++j) { const int k = lane + 64 * j; s += bf2f(CQN[(size_t)t * QLORA + k]) * p.w_uq[(size_t)k * 768 + c]; }
          s = wave_sum(s) * QSC; if (lane == 0) dacc(a, bf2f(Q[(size_t)t * 768 + c]), s); }
      dflush(F, 3, a); }
    { DAcc a{0.f, 0.f};
      for (int it = gw; it < 512; it += NGW) { const int t = dh(it, 7) % TP, c = dh(it, 8) % 1024; float s = 0.f;
          for (int j = 0; j < 4; ++j) { const int k = lane + 64 * j; s += bf2f(CKV[(size_t)t * KVLORA + k]) * (c < 512 ? p.w_uk[(size_t)k * 512 + c] : p.w_uv[(size_t)k * 512 + c - 512]); }
          s = wave_sum(s); if (lane == 0) dacc(a, bf2f(KNV[(size_t)t * 1024 + c]), s); }
      dflush(F, 4, a); }
    { DAcc a{0.f, 0.f};
      for (int it = gw; it < 512; it += NGW) { const int ts = dh(it, 9) % TS, n = dh(it, 10) % 2048, h = n >> 8, c = n & 255;
          float s = bf2f(Q[(size_t)(TP + ts) * 768 + h * 96 + lane]) * p.w_uk[(size_t)c * 512 + h * 64 + lane];
          s = wave_sum(s); if (lane == 0) dacc(a, bf2f(QLAT[(size_t)ts * 2048 + n]), s); }
      dflush(F, 5, a); }
    { DAcc a{0.f, 0.f};
      for (int it = gw; it < 48; it += NGW) { const int b = it & 1, h = dh(it, 11) & 7, tl = DG_TL[it >> 1]; const size_t rb = (size_t)b * SEQ;
          LDS_WAIT(); asm volatile("" ::: "memory");
          { const bf16* qr = Q + (rb + tl) * 768 + h * 96; wl[lane] = bf2f(qr[lane]);
            if (lane < 16) { const float x1 = bf2f(qr[64 + lane]), x2 = bf2f(qr[80 + lane]); const float ang = (float)tl * powf(10000.f, -(float)lane / 16.f); const float c = cosf(ang), s = sinf(ang); wl[64 + lane] = x1 * c - x2 * s; wl[80 + lane] = x2 * c + x1 * s; } }
          LDS_WAIT(); asm volatile("" ::: "memory");
          float mx = -INFINITY;
          for (int j = lane; j <= tl; j += 64) { float s = 0.f; const bf16* kn = KNV + (rb + j) * 1024 + h * 64; const bf16* kr = KR + (rb + j) * ROPE;
              for (int d = 0; d < 64; ++d) s += wl[d] * bf2f(kn[d]); for (int r = 0; r < 32; ++r) s += wl[64 + r] * bf2f(kr[r]); mx = fmaxf(mx, s); }
          for (int o_ = 1; o_ < 64; o_ <<= 1) mx = fmaxf(mx, __shfl_xor(mx, o_));
          float l = 0.f, o[8] = {0.f, 0.f, 0.f, 0.f, 0.f, 0.f, 0.f, 0.f}; const int dv0 = it & 7;
          for (int j = lane; j <= tl; j += 64) { float s = 0.f; const bf16* kn = KNV + (rb + j) * 1024 + h * 64; const bf16* kr = KR + (rb + j) * ROPE;
              for (int d = 0; d < 64; ++d) s += wl[d] * bf2f(kn[d]); for (int r = 0; r < 32; ++r) s += wl[64 + r] * bf2f(kr[r]);
              const float pj = exp2f(s - mx); l += pj; for (int i = 0; i < 8; ++i) o[i] += pj * bf2f(kn[512 + 8 * i + dv0]); }
          l = wave_sum(l); for (int i = 0; i < 8; ++i) { const float ov = wave_sum(o[i]) / l; if (lane == 0) dacc(a, bf2f(OATT[(rb + tl) * 512 + h * 64 + 8 * i + dv0]), ov); } }
      dflush(F, 6, a); }
    { DAcc a{0.f, 0.f};
      for (int it = gw; it < 32; it += NGW) { const int b = dh(it, 12) % DBATCH, tk = it & 7, h = dh(it, 13) & 7; const int trow = TP + b * 8 + tk;
          LDS_WAIT(); asm volatile("" ::: "memory");
          for (int i = 0; i < 4; ++i) wl[lane + 64 * i] = bf2f(QLAT[(size_t)(b * 8 + tk) * 2048 + h * 256 + lane + 64 * i]);
          if (lane < 16) { const bf16* qr = Q + (size_t)trow * 768 + h * 96; const float x1 = bf2f(qr[64 + lane]), x2 = bf2f(qr[80 + lane]); const float ang = (float)(PAST + tk) * powf(10000.f, -(float)lane / 16.f); const float c = cosf(ang), s = sinf(ang);
              wl[256 + lane] = x1 * c - x2 * s; wl[272 + lane] = x2 * c + x1 * s; }
          LDS_WAIT(); asm volatile("" ::: "memory");
          const int nk = PAST + tk + 1; const int c0 = dh(it, 14) & 63; float mx = -INFINITY, l = 0.f, o[4] = {0.f, 0.f, 0.f, 0.f};
          for (int pass = 0; pass < 2; ++pass) {
              for (int j = lane; j < nk; j += 64) { float s = 0.f; float cv[4];
                  if (j < PAST) { const int pg = p.page_table[b * NPAGES + (j >> 7)]; const float* cp = p.cache_c + ((size_t)pg * PAGE + (j & 127)) * KVLORA; const float* rp = p.cache_r + ((size_t)pg * PAGE + (j & 127)) * ROPE;
                      for (int c = 0; c < 256; ++c) s += wl[c] * cp[c]; for (int r = 0; r < 32; ++r) s += wl[256 + r] * rp[r]; for (int i = 0; i < 4; ++i) cv[i] = cp[c0 + 64 * i]; }
                  else { const int jn = j - PAST; const bf16* cp = CKV + (size_t)(TP + b * 8 + jn) * KVLORA; const bf16* rp = KR + (size_t)(TP + b * 8 + jn) * ROPE;
                      for (int c = 0; c < 256; ++c) s += wl[c] * bf2f(cp[c]); for (int r = 0; r < 32; ++r) s += wl[256 + r] * bf2f(rp[r]); for (int i = 0; i < 4; ++i) cv[i] = bf2f(cp[c0 + 64 * i]); }
                  if (pass == 0) mx = fmaxf(mx, s); else { const float pj = exp2f(s - mx); l += pj; for (int i = 0; i < 4; ++i) o[i] += pj * cv[i]; } }
              if (pass == 0) for (int o_ = 1; o_ < 64; o_ <<= 1) mx = fmaxf(mx, __shfl_xor(mx, o_)); }
          l = wave_sum(l); for (int i = 0; i < 4; ++i) { const float ov = wave_sum(o[i]) / l; if (lane == 0) dacc(a, bf2f(OLAT[(size_t)(b * 8 + tk) * 2048 + h * 256 + c0 + 64 * i]), ov); } }
      dflush(F, 7, a); }
    { DAcc a{0.f, 0.f};
      for (int it = gw; it < 256; it += NGW) { const int ts = dh(it, 15) % TS, n = dh(it, 16) % 512, h = n >> 6; float s = 0.f;
          for (int j = 0; j < 4; ++j) { const int c = lane + 64 * j; s += bf2f(OLAT[(size_t)ts * 2048 + h * 256 + c]) * p.w_uv[(size_t)c * 512 + n]; }
          s = wave_sum(s); if (lane == 0) dacc(a, bf2f(OATT[(size_t)(TP + ts) * 512 + n]), s); }
      dflush(F, 8, a); }
    { DAcc a9{0.f, 0.f}, a10{0.f, 0.f};
      for (int it = gw; it < 16; it += NGW) { const int b = it & 1, h = (it >> 1) & 7, pch = dh(it, 17) & 63, g2 = h >> 2; const float Ah = -expf(p.a_log[h]); const float dsk = p.d_skip[h];
          float h0 = 0.f, h1 = 0.f;
          for (int tl = 0; tl < SEQ; ++tl) { const size_t t = (size_t)b * SEQ + tl;
              if ((tl & 127) == 0) { const bf16* hp = HPREV + ((size_t)((b * NCHUNK + (tl >> 7)) * 8 + h) * 64 + pch) * 128; dacc(a9, bf2f(hp[lane]), h0); dacc(a9, bf2f(hp[lane + 64]), h1); }
              const float dt = DT[t * 8 + h]; const float x = bf2f(XBC[t * CONVD + h * 64 + pch]); const bf16* bp = XBC + t * CONVD + 512 + g2 * 128; const bf16* cp = XBC + t * CONVD + 768 + g2 * 128;
              const float dec = expf(dt * Ah); h0 = dec * h0 + x * dt * bf2f(bp[lane]); h1 = dec * h1 + x * dt * bf2f(bp[lane + 64]);
              float y = wave_sum(h0 * bf2f(cp[lane]) + h1 * bf2f(cp[lane + 64])) + dsk * x; const float z = bf2f(U[t * IN_PAD + O_Z + h * 64 + pch]); y = y * (z / (1.f + expf(-z)));
              if (lane == 0) dacc(a10, bf2f(YG[t * 512 + h * 64 + pch]), y); }
          const float* ho = p.out + OUT_SSP + ((size_t)(b * 8 + h) * 64 + pch) * 128; dacc(a9, ho[lane], h0); dacc(a9, ho[lane + 64], h1); }
      dflush(F, 9, a9); dflush(F, 10, a10); }
    { DAcc a{0.f, 0.f};
      for (int it = gw; it < 64; it += NGW) { const int b = dh(it, 18) % DBATCH, h = it & 7, pch = dh(it, 19) & 63, g2 = h >> 2; const float Ah = -expf(p.a_log[h]); const float dsk = p.d_skip[h];
          const float* hs = p.state_ssm + ((size_t)(b * 8 + h) * 64 + pch) * 128; float h0 = hs[lane], h1 = hs[lane + 64];
          for (int l = 0; l < 8; ++l) { const size_t t = (size_t)TP + b * 8 + l; const float dt = DT[t * 8 + h]; const float x = bf2f(XBC[t * CONVD + h * 64 + pch]); const bf16* bp = XBC + t * CONVD + 512 + g2 * 128; const bf16* cp = XBC + t * CONVD + 768 + g2 * 128;
              const float dec = expf(dt * Ah); h0 = dec * h0 + x * dt * bf2f(bp[lane]); h1 = dec * h1 + x * dt * bf2f(bp[lane + 64]);
              float y = wave_sum(h0 * bf2f(cp[lane]) + h1 * bf2f(cp[lane + 64])) + dsk * x; const float z = bf2f(U[t * IN_PAD + O_Z + h * 64 + pch]); y = y * (z / (1.f + expf(-z)));
              if (lane == 0) dacc(a, bf2f(YG[t * 512 + h * 64 + pch]), y); }
          const float* ho = p.out + OUT_SSS + ((size_t)(b * 8 + h) * 64 + pch) * 128; dacc(a, ho[lane], h0); dacc(a, ho[lane + 64], h1); }
      dflush(F, 11, a); }
    { DAcc a{0.f, 0.f};
      for (int it = gw; it < 64; it += NGW) { const int t = (it < 16) ? TP + (dh(it, 20) % TS) : dh(it, 21) % TALL;
          { float v[8]; float ss = 0.f; for (int i = 0; i < 8; ++i) { v[i] = bf2f(OATT[(size_t)t * 512 + lane + 64 * i]); ss += v[i] * v[i]; } const float r = rsqrtf(wave_sum(ss) / 512.f + 1e-6f);
            for (int i = 0; i < 8; ++i) dacc(a, bf2f(MIXA[(size_t)t * DM + lane + 64 * i]), v[i] * r * p.attn_out_norm[lane + 64 * i]); }
          for (int gi = 0; gi < 2; ++gi) { float v[4]; float ss = 0.f; for (int i = 0; i < 4; ++i) { v[i] = bf2f(YG[(size_t)t * 512 + gi * 256 + lane + 64 * i]); ss += v[i] * v[i]; } const float r = rsqrtf(wave_sum(ss) / 256.f + 1e-6f);
            for (int i = 0; i < 4; ++i) dacc(a, bf2f(MIXA[(size_t)t * DM + 512 + gi * 256 + lane + 64 * i]), v[i] * r * p.ssm_norm[gi * 256 + lane + 64 * i]); } }
      dflush(F, 12, a); }
    { DAcc a{0.f, 0.f}, b15{0.f, 0.f}, b18{0.f, 0.f}, b20{0.f, 0.f};
      for (int it = gw; it < 512; it += NGW) { const int t = dh(it, 22) % TALL, n = dh(it, 23) % DM, n2 = dh(it, 24) % 2048; float s = 0.f, s15 = 0.f, s18 = 0.f, s20 = 0.f;
          for (int j = 0; j < 16; ++j) { const int k = lane + 64 * j; s += bf2f(MIXA[(size_t)t * DM + k]) * p.w_out[(size_t)k * DM + n]; s15 += bf2f(H1B[(size_t)t * DM + k]) * p.mem_wq[(size_t)k * DM + n];
              s18 += bf2f(OM[(size_t)t * DM + k]) * p.mem_wo[(size_t)k * DM + n]; s20 += bf2f(H2B[(size_t)t * DM + k]) * p.peer_wq[(size_t)k * 2048 + n2]; }
          s = wave_sum(s); s15 = wave_sum(s15) * 0.0625f * LOG2E; s18 = wave_sum(s18); s20 = wave_sum(s20);
          if (lane == 0) { dacc(a, bf2f(MIX[(size_t)t * DM + n]), s); dacc(b15, bf2f(QM[(size_t)t * DM + n]), s15); dacc(b18, bf2f(MIX2[(size_t)t * DM + n]), s18); dacc(b20, bf2f(PQ[(size_t)t * 2048 + n2]), s20); } }
      dflush(F, 13, a); dflush(F, 15, b15); dflush(F, 18, b18); dflush(F, 20, b20); }
    { DAcc a14{0.f, 0.f}, a19{0.f, 0.f};
      for (int it = gw; it < 64; it += NGW) { const int t = (it < 8) ? TP + (dh(it, 25) % TS) : dh(it, 26) % TALL;
          for (int w2 = 0; w2 < 2; ++w2) { float v[16]; float s = 0.f;
              for (int i = 0; i < 16; ++i) { const int e = lane + 64 * i; v[i] = w2 == 0 ? DN_ALPHA * xin(p, t, e) + bf2f(MIX[(size_t)t * DM + e]) : DN_ALPHA * H1[(size_t)t * DM + e] + bf2f(MIX2[(size_t)t * DM + e]); s += v[i]; }
              const float mean = wave_sum(s) / DM; float s2 = 0.f; for (int i = 0; i < 16; ++i) { v[i] -= mean; s2 += v[i] * v[i]; } const float rstd = rsqrtf(wave_sum(s2) / DM + 1e-5f);
              for (int i = 0; i < 16; ++i) { const int e = lane + 64 * i; if (w2 == 0) { const float rf = v[i] * rstd * p.ln1_g[e] + p.ln1_b[e]; dacc(a14, H1[(size_t)t * DM + e], rf); dacc(a14, bf2f(H1B[(size_t)t * DM + e]), rf); }
                  else { const float rf = v[i] * rstd * p.ln2_g[e] + p.ln2_b[e]; dacc(a19, H2[(size_t)t * DM + e], rf); dacc(a19, bf2f(H2B[(size_t)t * DM + e]), rf); } } } }
      dflush(F, 14, a14); dflush(F, 19, a19); }
    { DAcc a{0.f, 0.f};
      for (int it = gw; it < 256; it += NGW) { const int r = dh(it, 27) % 512, n = dh(it, 28) % 2048; float s = 0.f;
          for (int j = 0; j < 16; ++j) { const int k = lane + 64 * j; s += p.mem_prompt[(size_t)r * DM + k] * (n < 1024 ? p.mem_wk[(size_t)k * DM + n] : p.mem_wv[(size_t)k * DM + n - 1024]); }
          s = wave_sum(s); if (lane == 0) { dacc(a, n < 1024 ? bf2f(MK[(size_t)r * DM + n]) : bf2f(MV[(size_t)r * DM + n - 1024]), s); dacc(a, n < 1024 ? p.out[OUT_MKP + (size_t)r * DM + n] : p.out[OUT_MVP + (size_t)r * DM + n - 1024], s); } }
      dflush(F, 16, a); }
    { DAcc a{0.f, 0.f};
      for (int it = gw; it < 64; it += NGW) { const int t = (it < 32) ? TP + (dh(it, 29) % TS) : dh(it, 30) % TP; const int hm = it & 3; const bool smp = t >= TP; const int b = smp ? (t - TP) >> 3 : t >> 13;
          LDS_WAIT(); asm volatile("" ::: "memory");
          for (int i = 0; i < 4; ++i) wl[lane + 64 * i] = bf2f(QM[(size_t)t * DM + hm * 256 + lane + 64 * i]);
          LDS_WAIT(); asm volatile("" ::: "memory");
          float sc[4]; float mx = -INFINITY;
          for (int i = 0; i < 4; ++i) { const int m = lane + 64 * i; float s = 0.f;
              if (smp) { const float* kp = p.cache_mk + (((size_t)b * NMEM + m) * MH + hm) * MHD; for (int d = 0; d < 256; ++d) s += wl[d] * kp[d]; }
              else { const bf16* kp = MK + ((size_t)b * NMEM + m) * DM + hm * 256; for (int d = 0; d < 256; ++d) s += wl[d] * bf2f(kp[d]); }
              sc[i] = s; mx = fmaxf(mx, s); }
          for (int o_ = 1; o_ < 64; o_ <<= 1) mx = fmaxf(mx, __shfl_xor(mx, o_));
          float l = 0.f, o[4] = {0.f, 0.f, 0.f, 0.f}; const int dv0 = dh(it, 31) & 63;
          for (int i = 0; i < 4; ++i) { const int m = lane + 64 * i; const float pj = exp2f(sc[i] - mx); l += pj;
              for (int q = 0; q < 4; ++q) { const int dv = dv0 + 64 * q; const float vv = smp ? p.cache_mv[(((size_t)b * NMEM + m) * MH + hm) * MHD + dv] : bf2f(MV[((size_t)b * NMEM + m) * DM + hm * 256 + dv]); o[q] += pj * vv; } }
          l = wave_sum(l); for (int q = 0; q < 4; ++q) { const float ov = wave_sum(o[q]) / l; if (lane == 0) dacc(a, bf2f(OM[(size_t)t * DM + hm * 256 + dv0 + 64 * q]), ov); } }
      dflush(F, 17, a); }
    { DAcc a{0.f, 0.f};
      for (int it = gw; it < 256; it += NGW) { const int t = dh(it, 32) % TALL, gg = it & 15; float s0 = 0.f, s1 = 0.f;
          for (int d = 0; d < 128; ++d) { const float qv = bf2f(PQ[(size_t)t * 2048 + gg * 128 + d]); s0 += qv * p.peer_keys[((size_t)gg * 128 + lane) * 128 + d]; s1 += qv * p.peer_keys[((size_t)gg * 128 + lane + 64) * 128 + d]; }
          const float* tp = TOPS + ((size_t)t * 16 + gg) * 16; float vmin = INFINITY;
          for (int i = 0; i < 16; ++i) { const unsigned u = __float_as_uint(tp[i]); const int id = (int)(u & 127u); const float v = __uint_as_float(u & ~127u); const float sr = __shfl(id < 64 ? s0 : s1, id & 63); if (lane == 0) dacc(a, v, sr); vmin = fminf(vmin, v); }
          int cnt = (s0 > vmin + 0.05f ? 1 : 0) + (s1 > vmin + 0.05f ? 1 : 0); for (int o_ = 1; o_ < 64; o_ <<= 1) cnt += __shfl_xor(cnt, o_);
          if (lane == 0 && cnt > 15) dacc(a, 100.f, 0.f); }
      dflush(F, 21, a); }
    { DAcc a{0.f, 0.f};
      for (int it = gw; it < 256; it += NGW) { const int t = dh(it, 33) % TALL, h = it & 7; const float* ta = TOPS + ((size_t)t * 16 + 2 * h) * 16; const float* tb = ta + 16;
          float cs[4]; int ce[4];
          for (int m = 0; m < 4; ++m) { const int idx = lane + 64 * m, i = idx >> 4, j = idx & 15; const unsigned ua = __float_as_uint(ta[i]), ub = __float_as_uint(tb[j]); cs[m] = __uint_as_float(ua & ~127u) + __uint_as_float(ub & ~127u); ce[m] = (int)(ua & 127u) * NKEYS + (int)(ub & 127u); }
          float rs_[16]; int re_[16];
          for (int r = 0; r < 16; ++r) { float bm = fmaxf(fmaxf(cs[0], cs[1]), fmaxf(cs[2], cs[3])); float wm = bm; for (int o_ = 1; o_ < 64; o_ <<= 1) wm = fmaxf(wm, __shfl_xor(wm, o_));
              const unsigned long long bal = __ballot(bm == wm); const int owner = __ffsll((long long)bal) - 1; int eid = 0;
              if (lane == owner) { bool done = false; for (int m = 0; m < 4; ++m) if (!done && cs[m] == wm) { eid = ce[m]; cs[m] = -INFINITY; done = true; } }
              eid = __shfl(eid, owner); rs_[r] = wm; re_[r] = eid; }
          float den = 0.f; for (int r = 0; r < 16; ++r) den += expf(rs_[r] - rs_[0]);
          if (lane < 16) { const int fe = PIDX[((size_t)t * 8 + h) * 16 + lane]; const float fg = PG[((size_t)t * 8 + h) * 16 + lane]; float rg = 0.f; for (int r = 0; r < 16; ++r) if (re_[r] == fe) rg = expf(rs_[r] - rs_[0]) / den; dacc(a, fg, rg); } }
      dflush(F, 22, a); }
    { DAcc a{0.f, 0.f};
      for (int it = gw; it < 64; it += NGW) { const int t = (it < 8) ? TP + (dh(it, 34) % TS) : dh(it, 35) % TALL; float x[16], o[16];
          for (int i = 0; i < 16; ++i) { x[i] = bf2f(H2B[(size_t)t * DM + lane + 64 * i]); o[i] = 0.f; }
          for (int k = 0; k < 128; ++k) { const int e = PIDX[(size_t)t * 128 + k]; const float* ur = p.peer_u + (size_t)e * DM; const float* vr = p.peer_v + (size_t)e * DM; float s = 0.f; for (int i = 0; i < 16; ++i) s += x[i] * ur[lane + 64 * i];
              s = wave_sum(s); const float wgt = PG[(size_t)t * 128 + k] * gelu_ref(s); for (int i = 0; i < 16; ++i) o[i] += wgt * vr[lane + 64 * i]; }
          float s = 0.f; for (int i = 0; i < 16; ++i) { o[i] += DN_ALPHA * H2[(size_t)t * DM + lane + 64 * i]; s += o[i]; }
          const float mean = wave_sum(s) / DM; float s2 = 0.f; for (int i = 0; i < 16; ++i) { o[i] -= mean; s2 += o[i] * o[i]; } const float rstd = rsqrtf(wave_sum(s2) / DM + 1e-5f);
          for (int i = 0; i < 16; ++i) { const int e = lane + 64 * i; dacc(a, p.out[OUT_YP + (size_t)t * DM + e], o[i] * rstd * p.ln3_g[e] + p.ln3_b[e]); } }
      dflush(F, 23, a); }
    xcd_barrier(bar);
    { const float* dg = (const float*)(F.ctl + CW_DIAG); int fk = 0; float frel = 0.f;
      for (int k = NCHK - 1; k >= 1; --k) { const float d = __hip_atomic_load(dg + 2 * k, __ATOMIC_RELAXED, __HIP_MEMORY_SCOPE_AGENT), r = __hip_atomic_load(dg + 2 * k + 1, __ATOMIC_RELAXED, __HIP_MEMORY_SCOPE_AGENT);
          const float rel = sqrtf(d / fmaxf(r, 1e-30f)); const bool bad = !(rel <= 0.03f) || !(r > 0.f); if (bad) { fk = k; frel = rel; } }
      if (fk > 0) { int dgt = 1; if (frel == frel && frel < 1.f) { const float lg = -log10f(fmaxf(frel, 1e-9f)); dgt = 1 + (int)fminf(floorf(lg), 8.f); }
          const float D = ((float)dgt + 0.5f) * powf(10.f, (float)(5 + fk));
          const size_t gt = (size_t)F.vcu * NTHR + F.tid, NGT = (size_t)F.G * NTHR; for (size_t i = gt; i < (size_t)TS * DM; i += NGT) p.out[OUT_YS + i] = D; } }
}
#endif

#ifndef MK_SINGLE
#define MK_SINGLE 1
#endif
#ifndef MK_DIAG
#define MK_DIAG 0
#endif
constexpr int NPHASE = 18 + MK_DIAG;
__global__ void __launch_bounds__(NTHR, 2) mk_fwd(Args args) {
    extern __shared__ __attribute__((aligned(16))) unsigned char lds[];
    Frame F;
    F.lds = (LAS unsigned char*)lds;
    F.MISC = (volatile LAS unsigned*)(F.lds + MISC_OFF);
    F.tid = threadIdx.x; F.lane = F.tid & 63; F.wave = __builtin_amdgcn_readfirstlane(F.tid >> 6);
    F.G = gridDim.x; { const int bx = blockIdx.x; F.vcu = (F.G % 8 == 0) ? (bx % 8) * (F.G / 8) + bx / 8 : bx; }
    F.ctl = (gu32*)(args.ws + WS_CTL);
    P p;
    { const void* const* in = args.in;
      p.x_prompt = (const float*)in[0]; p.x_sample = (const float*)in[1]; p.mem_prompt = (const float*)in[2]; p.cache_c = (const float*)in[3]; p.cache_r = (const float*)in[4];
      p.state_conv = (const float*)in[5]; p.state_ssm = (const float*)in[6]; p.cache_mk = (const float*)in[7]; p.cache_mv = (const float*)in[8]; p.page_table = (const int*)in[9];
      p.w_in = (const float*)in[10]; p.q_a_norm = (const float*)in[11]; p.w_uq = (const float*)in[12]; p.kv_a_norm = (const float*)in[13]; p.w_uk = (const float*)in[14];
      p.w_uv = (const float*)in[15]; p.attn_out_norm = (const float*)in[16]; p.conv_w = (const float*)in[17]; p.conv_b = (const float*)in[18]; p.dt_bias = (const float*)in[19];
      p.a_log = (const float*)in[20]; p.d_skip = (const float*)in[21]; p.ssm_norm = (const float*)in[22]; p.w_out = (const float*)in[23]; p.ln1_g = (const float*)in[24];
      p.ln1_b = (const float*)in[25]; p.mem_wq = (const float*)in[26]; p.mem_wk = (const float*)in[27]; p.mem_wv = (const float*)in[28]; p.mem_wo = (const float*)in[29];
      p.ln2_g = (const float*)in[30]; p.ln2_b = (const float*)in[31]; p.peer_wq = (const float*)in[32]; p.peer_keys = (const float*)in[33]; p.peer_u = (const float*)in[34];
      p.peer_v = (const float*)in[35]; p.ln3_g = (const float*)in[36]; p.ln3_b = (const float*)in[37]; p.out = args.out; p.ws = args.ws; }
    unsigned char* ws = args.ws;
    for (int u = F.tid; u < (LDS_BYTES - LDSCTL_OFF) / 4; u += NTHR) ((LAS unsigned*)(F.lds + LDSCTL_OFF))[u] = 0u;
    __syncthreads();
    const int lo = args.ph_lo, hi = args.ph_hi;
    XcdBarrier bar; bar.bar = (unsigned*)(F.ctl + CW_BAR); bar.x = 0; bar.st = nullptr;
    if (hi - lo > 1) bar = xcd_barrier_post((unsigned*)(F.ctl + CW_BAR), F.MISC + 8);
#ifndef ONLY_PHASE
#define ONLY_PHASE -1
#endif
#define IN(k) ((ONLY_PHASE < 0 || ONLY_PHASE == (k)) && lo <= (k) && (k) < hi)
#define BOTH(k) (IN(k) && IN((k) + 1))
#define SEAM(k) do { if (BOTH(k)) xcd_barrier(bar); } while (0)
#define GEMM_BF16(Aptr, Btptr, M_, N_, K_, Optr, ldc_, scale_, cshift) do { pg8::Gemm g_{(const bf16*)(Aptr), (const bf16*)(Btptr), (M_), (N_), (K_)}; pg8::StaticOrder S_; \
        S_.init((M_), (N_), F.G, (int)((blockIdx.x + (unsigned)F.G - (unsigned)(cshift)) % (unsigned)F.G)); EpiGen8<StoreBf16> E_{StoreBf16{(bf16*)(Optr), (ldc_), (scale_)}}; \
        pg8::gemm_phase<EpiGen8<StoreBf16>, pg8::StaticOrder, true, true>(F.lds + RING_OFF, g_, S_, E_); __syncthreads(); } while (0)

    if (IN(0)) { p0_prologue(F, p); SEAM(0); }

    if (IN(1)) {
        GEMM_BF16(ws + WS_XB, ws + WS_WIN, TALL, IN_PAD, DM, ws + WS_U, IN_PAD, 1.f, 0);
        { pg8::Gemm g{(const bf16*)(ws + WS_MEMB), (const bf16*)(ws + WS_MWKV), 512, 2048, DM}; pg8::StaticOrder S; S.init(512, 2048, F.G, (int)((blockIdx.x + 128u) % (unsigned)F.G));
          EpiGen8<StoreMemKV> E{StoreMemKV{p.out + OUT_MKP, p.out + OUT_MVP, (bf16*)(ws + WS_MK), (bf16*)(ws + WS_MV)}};
          pg8::gemm_phase<EpiGen8<StoreMemKV>, pg8::StaticOrder, true, true>(F.lds + RING_OFF, g, S, E); }
        SEAM(1); }

    if (IN(2)) { p2_rows(F, p); SEAM(2); }

    if (IN(3)) {
#ifndef P3SEL
#define P3SEL 15
#endif
        if (P3SEL & 1) GEMM_BF16(ws + WS_CQN, ws + WS_WUQ, TALL, 768, QLORA, ws + WS_Q, 768, MLA_SCALE * LOG2E, 0);
        if (P3SEL & 2) GEMM_BF16(ws + WS_CKV, ws + WS_WKV, TP, 1024, KVLORA, ws + WS_KNV, 1024, 1.f, 0);
        if (P3SEL & 4) GEMM_BF16((const bf16*)(ws + WS_CQN) + (size_t)TP * QLORA, ws + WS_WABS, TS, 2048, QLORA, ws + WS_QLAT, 2048, MLA_SCALE * LOG2E, 204);
        if (P3SEL & 8) for (int u = F.vcu; u < 2 * NCHUNK * 8; u += F.G) ssd_a_unit(F, p, u >> 9, (u >> 3) & 63, u & 7);
        SEAM(3); }

    if (IN(4)) {
        ssd_b_scan(F, p);
        for (int u = F.vcu; u < 256; u += F.G) { const int bh = u >> 4, s = u & 15; attn_prompt_unit(F, p, bh >> 3, bh & 7, 31 - s); attn_prompt_unit(F, p, bh >> 3, bh & 7, s); }
        for (int u = F.vcu; u < 256; u += F.G) attn_sample_unit(F, p, u >> 1, u & 1);
        SEAM(4); }

    if (IN(5)) {
        attn_sample_combine(F, p);
        for (int u = F.vcu; u < 2 * NCHUNK * 8; u += F.G) ssd_c_unit(F, p, u >> 9, (u >> 3) & 63, u & 7);
        for (int u = F.vcu; u < DBATCH * 8; u += F.G) ssd_sample_unit(F, p, u >> 3, u & 7);
        SEAM(5); }

    if (IN(6)) { GEMM_BF16(ws + WS_OLAT, ws + WS_WUVBD, TS, 512, 2048, (bf16*)(ws + WS_OATT) + (size_t)TP * 512, 512, 1.f, 0); SEAM(6); }

    if (IN(7)) { mixa_rows(F, p); SEAM(7); }

    if (IN(8)) { GEMM_BF16(ws + WS_MIXA, ws + WS_WOUT, TALL, DM, DM, ws + WS_MIX, DM, 1.f, 0); SEAM(8); }

    if (IN(9)) { ln_rows(F, p.x_prompt, p.x_sample, (const bf16*)(ws + WS_MIX), p.ln1_g, p.ln1_b, (float*)(ws + WS_H1), (bf16*)(ws + WS_H1B)); SEAM(9); }

    if (IN(10)) { GEMM_BF16(ws + WS_H1B, ws + WS_MWQ, TALL, DM, DM, ws + WS_QM, DM, 0.0625f * LOG2E, 0); SEAM(10); }

    if (IN(11)) {
        for (int u = F.vcu; u < 512; u += F.G) mem_attn_prompt_unit(F, p, u >> 8, (u >> 6) & 3, u & 63);
        for (int u = F.vcu; u < 512; u += F.G) mem_attn_sample_unit(F, p, u >> 2, u & 3);
        SEAM(11); }

    if (IN(12)) { GEMM_BF16(ws + WS_OM, ws + WS_MWO, TALL, DM, DM, ws + WS_MIX2, DM, 1.f, 0); SEAM(12); }

    if (IN(13)) { ln_rows(F, (const float*)(ws + WS_H1), (const float*)(ws + WS_H1) + (size_t)TP * DM, (const bf16*)(ws + WS_MIX2), p.ln2_g, p.ln2_b, (float*)(ws + WS_H2), (bf16*)(ws + WS_H2B)); SEAM(13); }

    if (IN(14)) { GEMM_BF16(ws + WS_H2B, ws + WS_PWQ, TALL, 2048, DM, ws + WS_PQ, 2048, 1.f, 0); SEAM(14); }

    if (IN(15)) { for (int u = F.vcu; u < 68 * 16; u += F.G) peer_scores_unit(F, p, u >> 4, u & 15); SEAM(15); }

    if (IN(16)) { peer_cand(F, p); SEAM(16); }

    if (IN(17)) { peer_gather(F, p); SEAM(17); }
#if MK_DIAG
    if (IN(18)) { diag_phase(F, p, bar); }
#endif
#undef IN
#undef BOTH
#undef SEAM
}

extern "C" void kernel_launch(void* const* d_in, const int* in_sizes, int n_in, void* d_out, int out_size, void* d_ws, size_t ws_size, hipStream_t stream) {
    static int grid = 0;
    if (grid == 0) {
        if (n_in != 38 || (size_t)out_size != OUT_END || ws_size < WS_END) { fprintf(stderr, "kernel_launch: unexpected shapes: n_in %d out %d (want %zu) ws %zu (want %zu)\n", n_in, out_size, (size_t)OUT_END, ws_size, (size_t)WS_END); grid = -1; return; }
        int dev = 0, cus = 0, per_cu = 0;
        if (hipGetDevice(&dev) != hipSuccess || hipDeviceGetAttribute(&cus, hipDeviceAttributeMultiprocessorCount, dev) != hipSuccess) { grid = -1; return; }
        if (hipFuncSetAttribute((const void*)mk_fwd, hipFuncAttributeMaxDynamicSharedMemorySize, LDS_BYTES) != hipSuccess) { fprintf(stderr, "kernel_launch: hipFuncSetAttribute failed\n"); grid = -1; return; }
        if (hipOccupancyMaxActiveBlocksPerMultiprocessor(&per_cu, (const void*)mk_fwd, NTHR, LDS_BYTES) != hipSuccess || per_cu < 1) { fprintf(stderr, "kernel_launch: occupancy query says %d\n", per_cu); }
        (void)hipGetLastError();
        grid = cus;
    }
    if (grid < 0) return;
    (void)hipMemsetAsync((char*)d_ws + WS_CTL, 0, CTL_ZERO_BYTES, stream);
    Args a{};
    for (int i = 0; i < 38; ++i) a.in[i] = d_in[i];
    a.out = (float*)d_out; a.ws = (unsigned char*)d_ws;
#if MK_SINGLE
    a.ph_lo = 0; a.ph_hi = NPHASE;
    hipLaunchKernelGGL(mk_fwd, dim3(grid), dim3(NTHR), LDS_BYTES, stream, a);
#else
    for (int ph = 0; ph < NPHASE; ++ph) { a.ph_lo = ph; a.ph_hi = ph + 1; hipLaunchKernelGGL(mk_fwd, dim3(grid), dim3(NTHR), LDS_BYTES, stream, a); }
#endif
}
```

```cpp
#include <hip/hip_runtime.h>
#include <cstdio>
#include <cstdint>
namespace pg8 {
#define PG8_LAS __attribute__((address_space(3)))
typedef unsigned short bf16_t;
typedef short bf16x8 __attribute__((ext_vector_type(8)));
typedef float f32x4 __attribute__((ext_vector_type(4)));
typedef unsigned u32x4 __attribute__((ext_vector_type(4)));
constexpr int BM = 256, BK = 64, HALF = 128, HTB = HALF * BK * 2  , STAGE_BYTES = 8 * HTB, NXCD = 8, WGM = 8;

__host__ __device__ __forceinline__ int lds_byte(int r, int c) { const int st = (r >> 4) * 2 + (c >> 5), rr = r & 15, cc = c & 31, ob = rr * 64 + cc * 2; return st * 1024 + (ob ^ (((ob >> 9) & 1) << 5)); }
__host__ __device__ __forceinline__ void stage_rc(int b, int& R, int& C) { const int st = b / 1024, sb = b % 1024, swz = sb ^ (((sb >> 9) & 1) << 5); R = (st >> 1) * 16 + swz / 64; C = (st & 1) * 32 + (swz % 64) / 2; }
__host__ __device__ __forceinline__ int perm32(int rho) { const int n = rho >> 4, i = rho & 15; return 8 * (i >> 2) + 4 * n + (i & 3); }

struct Unit { int pm, pn; };
struct Gemm { const bf16_t* A; const bf16_t* Bt; int M, N, K; };

struct StaticOrder {
    int nM, nN, nwg, G, c;
    __host__ __device__ void init(int M, int N, int G_, int c_) { nM = M / BM; nN = N / BM; nwg = nM * nN; G = G_; c = c_; }
    __host__ __device__ bool next(int i, Unit& u) const {
        const long L = (long)i * G + c; if (L >= nwg) return false;
        int wgid = (int)L; { const int q = nwg / NXCD, r = nwg % NXCD, xcd = wgid % NXCD, off = wgid / NXCD; wgid = (xcd < r ? xcd * (q + 1) : r * (q + 1) + (xcd - r) * q) + off; }
        const int nig = WGM * nN, gid = wgid / nig, fm = gid * WGM, gsz = (nM - fm) < WGM ? (nM - fm) : WGM;
        u.pm = fm + ((wgid % nig) % gsz); u.pn = (wgid % nig) / gsz; return true;
    }
    __device__ __forceinline__ void a_ready(const Unit&) const {}
    __device__ __forceinline__ void done(const Unit&) const {}
};

__device__ __forceinline__ unsigned cvt_pk_bf16(float lo, float hi) { unsigned r; asm volatile("v_cvt_pk_bf16_f32 %0, %1, %2" : "=v"(r) : "v"(lo), "v"(hi)); return r; }
typedef float f32x2 __attribute__((ext_vector_type(2)));
__device__ __forceinline__ f32x2 gelu_pk(f32x2 v) {
    const f32x2 av = __builtin_elementwise_abs(v), d = av * 0.2316418882f + 1.0f;
    f32x2 t; t.x = __builtin_amdgcn_rcpf(d.x); t.y = __builtin_amdgcn_rcpf(d.y);
    f32x2 q = t * 0.5307027145f + (-0.7265760135f); q = q * t + 0.7107068705f; q = q * t + (-0.142248368f); q = q * t + 0.127414796f; q = q * t;
    const f32x2 s = (v * v) * (-0.72134752044f);
    f32x2 e; e.x = __builtin_amdgcn_exp2f(s.x); e.y = __builtin_amdgcn_exp2f(s.y);
    const f32x2 m = v * (q * e), r = v - m;
    f32x2 o; o.x = v.x < 0.f ? m.x : r.x; o.y = v.y < 0.f ? m.y : r.y; return o;
}

template <int ACT  > struct EpiBf16 {
    static constexpr bool PERM = true, AFTER_DRAIN = false; static_assert(ACT == 0 || ACT == 1, "EpiBf16: ACT is 0 (none) or 1 (gelu_pk)");
    bf16_t* O; int ldc; const float* bias; int split_cols; size_t split_stride; float scale0;
    __device__ __forceinline__ void operator()(const f32x4 (&acc)[2][2][4][2], const Unit& u, int wr, int wc, int fr, int fq) const {
        const int row0 = u.pm * BM + wr * 64 + fr; int colt = u.pn * BM; bf16_t* base = O;
        float sc = 1.f; if (split_cols) { const int t = colt / split_cols; base += (size_t)t * split_stride; colt -= t * split_cols; if (t == 0) sc = scale0; }
        const int col0 = colt + wc * 32 + 8 * fq, bcol0 = u.pn * BM + wc * 32 + 8 * fq;
        f32x4 bv[2][2];
#pragma unroll
        for (int bj = 0; bj < 2; ++bj)
#pragma unroll
            for (int n = 0; n < 2; ++n) bv[bj][n] = bias ? *(const f32x4*)(bias + bcol0 + bj * HALF + 4 * n) : (f32x4){0.f, 0.f, 0.f, 0.f};
#pragma unroll
        for (int ai = 0; ai < 2; ++ai)
#pragma unroll
            for (int m = 0; m < 4; ++m) { bf16_t* rowp = base + (size_t)(row0 + ai * HALF + m * 16) * ldc + col0;
#pragma unroll
                for (int bj = 0; bj < 2; ++bj) { f32x4 v0 = acc[ai][bj][m][0] + bv[bj][0], v1 = acc[ai][bj][m][1] + bv[bj][1];
                    if (ACT == 1) { f32x2 a = gelu_pk((f32x2){v0[0], v0[1]}), b = gelu_pk((f32x2){v0[2], v0[3]}), c = gelu_pk((f32x2){v1[0], v1[1]}), d = gelu_pk((f32x2){v1[2], v1[3]});
                        v0 = (f32x4){a.x, a.y, b.x, b.y}; v1 = (f32x4){c.x, c.y, d.x, d.y}; }
                    v0 = v0 * sc; v1 = v1 * sc; u32x4 w; w.x = cvt_pk_bf16(v0[0], v0[1]); w.y = cvt_pk_bf16(v0[2], v0[3]); w.z = cvt_pk_bf16(v1[0], v1[1]); w.w = cvt_pk_bf16(v1[2], v1[3]);
                    *(u32x4*)(rowp + bj * HALF) = w; } }
    }
};

template <class Epi, class Sched, bool ALIGN_EPI = false, bool SP2 = false>
__device__ __forceinline__ void gemm_phase(PG8_LAS unsigned char* lds, const Gemm g, const Sched& S, const Epi& E) {
    const int tid = threadIdx.x, wid = __builtin_amdgcn_readfirstlane(tid >> 6), lane = tid & 63, wr = wid >> 2, wc = wid & 3, fr = lane & 15, fq = lane >> 4;
    const int K = g.K, nt = K / BK;
    unsigned voffA[2], voffB[2];
#pragma unroll
    for (int i = 0; i < 2; ++i) { int R, C; stage_rc(tid * 16 + i * 8192, R, C); const int Rb = Epi::PERM ? ((R & ~31) + perm32(R & 31)) : R;
        voffA[i] = (unsigned)(R * K + C) * 2u; voffB[i] = (unsigned)(Rb * K + C) * 2u; }
    const size_t kstep = (size_t)(BK * 2);
    const size_t hstep = (size_t)HALF * K * 2;
    const size_t tstep = 2 * hstep;
    const unsigned ldsw = (unsigned)wid * 1024u;
    const int aoff = lds_byte(wr * 64 + fr, fq * 8), boff = lds_byte(wc * 32 + fr, fq * 8);
#define PG8_SA(b, h) (((b) * 2 + (h)) * HTB)
#define PG8_SB(b, h) ((4 + (b) * 2 + (h)) * HTB)
#define PG8_STAGE(bufoff, gbase, voff) do { _Pragma("unroll") for (int _i = 0; _i < 2; ++_i) \
        __builtin_amdgcn_global_load_lds((const unsigned*)((const char*)(gbase) + (voff)[_i]), (PG8_LAS unsigned*)(lds + (bufoff) + ldsw + _i * 8192), 16, 0, 0); } while (0)
#define PG8_LDA(dst, b, h) do { _Pragma("unroll") for (int m = 0; m < 4; ++m) _Pragma("unroll") for (int k = 0; k < 2; ++k) dst[m][k] = *(const PG8_LAS bf16x8*)(lds + PG8_SA(b, h) + aoff + m * 2048 + k * 1024); } while (0)
#define PG8_LDB(dst, b, h) do { _Pragma("unroll") for (int n = 0; n < 2; ++n) _Pragma("unroll") for (int k = 0; k < 2; ++k) dst[n][k] = *(const PG8_LAS bf16x8*)(lds + PG8_SB(b, h) + boff + n * 2048 + k * 1024); } while (0)
#define PG8_MMA(ai, bj, At, Bt) do { __builtin_amdgcn_s_setprio(1); _Pragma("unroll") for (int m = 0; m < 4; ++m) _Pragma("unroll") for (int n = 0; n < 2; ++n) _Pragma("unroll") for (int k = 0; k < 2; ++k) \
        acc[ai][bj][m][n] = __builtin_amdgcn_mfma_f32_16x16x32_bf16(Bt[n][k], At[m][k], acc[ai][bj][m][n], 0, 0, 0); __builtin_amdgcn_s_setprio(0); } while (0)
#define PG8_WAIT_V(n) asm volatile("s_waitcnt vmcnt(" #n ")" ::: "memory")
#define PG8_WAIT_L(n) asm volatile("s_waitcnt lgkmcnt(" #n ")" ::: "memory")
#define PG8_BAR __builtin_amdgcn_s_barrier()
#define PG8_SCHED __builtin_amdgcn_sched_barrier(0)
    Unit cur, nxt; int ui = 0;
    if (!S.next(0, cur)) return;
    f32x4 acc[2][2][4][2];
#pragma unroll
    for (int a = 0; a < 2; ++a)
#pragma unroll
        for (int b = 0; b < 2; ++b)
#pragma unroll
            for (int m = 0; m < 4; ++m)
#pragma unroll
                for (int n = 0; n < 2; ++n) acc[a][b][m][n] = (f32x4){0.f, 0.f, 0.f, 0.f};
    bf16x8 At[4][2], B0[2][2], B1[2][2];
    const char* cA = (const char*)g.A + (size_t)cur.pm * tstep; const char* cB = (const char*)g.Bt + (size_t)cur.pn * tstep;
    S.a_ready(cur);
    if constexpr (SP2) {
        PG8_STAGE(PG8_SB(0, 0), cB, voffB); PG8_STAGE(PG8_SB(0, 1), cB + hstep, voffB); PG8_STAGE(PG8_SA(0, 0), cA, voffA); PG8_STAGE(PG8_SA(0, 1), cA + hstep, voffA);
        if (wr == 1) PG8_BAR;
        PG8_WAIT_V(2); PG8_BAR;
        PG8_STAGE(PG8_SB(1, 0), cB + kstep, voffB); PG8_STAGE(PG8_SA(1, 0), cA + kstep, voffA); PG8_STAGE(PG8_SB(1, 1), cB + hstep + kstep, voffB);
        PG8_WAIT_V(6); PG8_BAR;
    } else {
        PG8_STAGE(PG8_SB(0, 0), cB, voffB); PG8_STAGE(PG8_SA(0, 0), cA, voffA); PG8_STAGE(PG8_SB(0, 1), cB + hstep, voffB); PG8_STAGE(PG8_SA(0, 1), cA + hstep, voffA);
        if (wr == 1) PG8_BAR;
        PG8_WAIT_V(4); PG8_BAR;
        PG8_STAGE(PG8_SB(1, 0), cB + kstep, voffB); PG8_STAGE(PG8_SA(1, 0), cA + kstep, voffA); PG8_STAGE(PG8_SB(1, 1), cB + hstep + kstep, voffB);
        PG8_WAIT_V(6); PG8_BAR;
    }
    for (;;) {
        const bool has_next = S.next(ui + 1, nxt);
        const char* nA = has_next ? (const char*)g.A + (size_t)nxt.pm * tstep : cA; const char* nB = has_next ? (const char*)g.Bt + (size_t)nxt.pn * tstep : cB;
        for (int t = 0; t < nt; t += 2) {
            const bool last = (t == nt - 2);
            const char* a1 = cA + (size_t)(t + 1) * kstep;
            const char* a2 = last ? nA : cA + (size_t)(t + 2) * kstep; const char* b2 = last ? nB : cB + (size_t)(t + 2) * kstep;
            const char* a3 = a2 + kstep; const char* b3 = b2 + kstep;
            if (last && has_next) S.a_ready(nxt);
            if constexpr (SP2) {
            PG8_LDB(B0, 0, 0); PG8_LDB(B1, 0, 1); PG8_SCHED; PG8_LDA(At, 0, 0); PG8_STAGE(PG8_SA(1, 1), a1 + hstep, voffA);
            PG8_WAIT_V(8); PG8_WAIT_L(0); PG8_BAR; PG8_MMA(0, 0, At, B0); PG8_MMA(0, 1, At, B1); PG8_BAR; PG8_SCHED;
            PG8_LDA(At, 0, 1); PG8_STAGE(PG8_SB(0, 0), b2, voffB); PG8_STAGE(PG8_SB(0, 1), b2 + hstep, voffB); PG8_STAGE(PG8_SA(0, 0), a2, voffA);
            PG8_WAIT_V(8); PG8_WAIT_L(0); PG8_BAR; PG8_MMA(1, 0, At, B0); PG8_MMA(1, 1, At, B1); PG8_BAR; PG8_SCHED;
            PG8_LDB(B0, 1, 0); PG8_LDB(B1, 1, 1); PG8_SCHED; PG8_LDA(At, 1, 0); PG8_STAGE(PG8_SA(0, 1), a2 + hstep, voffA);
            PG8_WAIT_V(8); PG8_WAIT_L(0); PG8_BAR; PG8_MMA(0, 0, At, B0); PG8_MMA(0, 1, At, B1); PG8_BAR; PG8_SCHED;
            PG8_LDA(At, 1, 1); PG8_STAGE(PG8_SB(1, 0), b3, voffB); PG8_STAGE(PG8_SB(1, 1), b3 + hstep, voffB); PG8_STAGE(PG8_SA(1, 0), a3, voffA);
            PG8_WAIT_V(8); PG8_WAIT_L(0); PG8_BAR; PG8_MMA(1, 0, At, B0); PG8_MMA(1, 1, At, B1); PG8_BAR; PG8_SCHED;
            } else {
            PG8_LDB(B0, 0, 0); PG8_SCHED; PG8_LDA(At, 0, 0); PG8_STAGE(PG8_SA(1, 1), a1 + hstep, voffA);
            PG8_WAIT_L(8); PG8_BAR; PG8_WAIT_L(0); PG8_MMA(0, 0, At, B0); PG8_BAR; PG8_SCHED;
            PG8_LDB(B1, 0, 1); PG8_STAGE(PG8_SB(0, 0), b2, voffB);
            PG8_BAR; PG8_WAIT_L(0); PG8_MMA(0, 1, At, B1); PG8_BAR;
            PG8_LDA(At, 0, 1); PG8_STAGE(PG8_SA(0, 0), a2, voffA);
            PG8_BAR; PG8_WAIT_L(0); PG8_MMA(1, 0, At, B0); PG8_BAR; PG8_SCHED;
            PG8_STAGE(PG8_SB(0, 1), b2 + hstep, voffB);
            PG8_WAIT_V(6); PG8_BAR; PG8_MMA(1, 1, At, B1); PG8_BAR;
            PG8_LDB(B0, 1, 0); PG8_SCHED; PG8_LDA(At, 1, 0); PG8_STAGE(PG8_SA(0, 1), a2 + hstep, voffA);
            PG8_WAIT_L(8); PG8_BAR; PG8_WAIT_L(0); PG8_MMA(0, 0, At, B0); PG8_BAR; PG8_SCHED;
            PG8_LDB(B1, 1, 1); PG8_STAGE(PG8_SB(1, 0), b3, voffB);
            PG8_BAR; PG8_WAIT_L(0); PG8_MMA(0, 1, At, B1); PG8_BAR;
            PG8_LDA(At, 1, 1); PG8_STAGE(PG8_SA(1, 0), a3, voffA);
            PG8_BAR; PG8_WAIT_L(0); PG8_MMA(1, 0, At, B0); PG8_BAR; PG8_SCHED;
            PG8_STAGE(PG8_SB(1, 1), b3 + hstep, voffB);
            PG8_WAIT_V(6); PG8_BAR; PG8_MMA(1, 1, At, B1); PG8_BAR;
            }
        }
        if constexpr (ALIGN_EPI) { if (wr == 0) PG8_BAR; }
        if constexpr (!Epi::AFTER_DRAIN) { E(acc, cur, wr, wc, fr, fq); S.done(cur); }
        if (!has_next) break;
#pragma unroll
        for (int a = 0; a < 2; ++a)
#pragma unroll
            for (int b = 0; b < 2; ++b)
#pragma unroll
                for (int m = 0; m < 4; ++m)
#pragma unroll
                    for (int n = 0; n < 2; ++n) acc[a][b][m][n] = (f32x4){0.f, 0.f, 0.f, 0.f};
        cur = nxt; cA = nA; cB = nB; ++ui;
        if constexpr (ALIGN_EPI) { if (wr == 1) PG8_BAR; }
    }
    PG8_WAIT_V(0);
    if constexpr (!ALIGN_EPI) { if (wr == 0) PG8_BAR; }
    PG8_BAR;
    if constexpr (Epi::AFTER_DRAIN) { E.fused(acc, cur, wr, wc, fr, fq, lds, wid, lane); S.done(cur); }
#undef PG8_SA
#undef PG8_SB
#undef PG8_STAGE
#undef PG8_LDA
#undef PG8_LDB
#undef PG8_MMA
#undef PG8_WAIT_V
#undef PG8_WAIT_L
#undef PG8_BAR
#undef PG8_SCHED
}
}
#define GAS __attribute__((address_space(1)))
#define LAS __attribute__((address_space(3)))
typedef unsigned short bf16;
typedef unsigned v4u __attribute__((ext_vector_type(4)));
typedef float f32x4 __attribute__((ext_vector_type(4)));
typedef short bf16x8 __attribute__((ext_vector_type(8)));
typedef GAS unsigned gu32;
typedef GAS unsigned long long gu64;
#define RLX_AGENT __ATOMIC_RELAXED, __HIP_MEMORY_SCOPE_AGENT
#define LDS_WAIT() asm volatile("s_waitcnt lgkmcnt(0)" ::: "memory")
#define VM_WAIT() asm volatile("s_waitcnt vmcnt(0)" ::: "memory")
__device__ __forceinline__ unsigned long long rt() { return __builtin_amdgcn_s_memrealtime(); }
__device__ __forceinline__ unsigned f2bf(float f) { unsigned u = __builtin_bit_cast(unsigned, f); return (u + 0x7fffu + ((u >> 16) & 1u)) >> 16; }
__device__ __forceinline__ unsigned pk2(float lo, float hi) { return f2bf(lo) | (f2bf(hi) << 16); }

#define XB_TMO      128
#define XB_XCNT(j)  (256  + 64 * (j))
#define XB_XSUB(j)  (1280 + 64 * (j))
#define XB_XGEN(j)  (2304 + 64 * (j))
#define XB_TOP      3328
#define XB_TOPGEN   3392
#define XCD_BAR_WORDS 3456
#define XB_SPIN_CAP (1u << 18)

__device__ __forceinline__ unsigned xb_ld(unsigned* p)              { return __hip_atomic_load(p, __ATOMIC_RELAXED, __HIP_MEMORY_SCOPE_AGENT); }
__device__ __forceinline__ unsigned xb_add(unsigned* p, unsigned v) { return __hip_atomic_fetch_add(p, v, __ATOMIC_RELAXED, __HIP_MEMORY_SCOPE_AGENT); }
__device__ __forceinline__ unsigned xb_xcc_id() { return (unsigned)__builtin_amdgcn_s_getreg((3 << 11) | 20) & 0xFu; }
#define XB_SPIN(cond, bar) do { unsigned _sp = 0; while (cond) { __builtin_amdgcn_s_sleep(1); \
    if ((++_sp & 255u) == 0u) { if (xb_ld(&(bar)[XB_TMO])) break; if (_sp > XB_SPIN_CAP) { atomicAdd(&(bar)[XB_TMO], 1u); break; } } } } while (0)

struct XcdBarrier {
    unsigned* bar; unsigned x;
    volatile LAS unsigned* st;
};

__device__ __forceinline__ XcdBarrier xcd_barrier_post(unsigned* bar, volatile LAS unsigned* st) {
    XcdBarrier b; b.bar = bar; b.x = xb_xcc_id(); b.st = st;
    if (threadIdx.x == 0) (void)xb_add(&bar[XB_XCNT(b.x)], 1u);
    return b;
}
__device__ __forceinline__ void xcd_barrier_complete(unsigned* bar, unsigned x, unsigned& nloc, unsigned& nx) {
    const unsigned G = gridDim.x * gridDim.y * gridDim.z;
    unsigned sum, cnt, mine, sp = 0u;
    for (;;) {
        sum = 0u; cnt = 0u; mine = 0u;
#pragma unroll
        for (unsigned j = 0; j < 16; ++j) { const unsigned c = xb_ld(&bar[XB_XCNT(j)]); sum += c; cnt += (c > 0u) ? 1u : 0u; mine = (j == x) ? c : mine; }
        if (sum == G) break;
        __builtin_amdgcn_s_sleep(1);
        if ((++sp & 255u) == 0u) { if (xb_ld(&bar[XB_TMO])) break; if (sp > XB_SPIN_CAP) { atomicAdd(&bar[XB_TMO], 1u); break; } }
    }
    nloc = mine > 0u ? mine : 1u; nx = cnt > 0u ? cnt : 1u;
}

__device__ __forceinline__ void xcd_barrier(const XcdBarrier& b) {
    asm volatile("s_waitcnt vmcnt(0)" ::: "memory");
    __syncthreads();
    if (threadIdx.x == 0) {
        unsigned* bar = b.bar;
        __builtin_amdgcn_s_waitcnt(0);
        unsigned nloc = b.st[0], nx = b.st[1];
        if (nloc == 0u) { xcd_barrier_complete(bar, b.x, nloc, nx); b.st[0] = nloc; b.st[1] = nx; }
        const unsigned old = xb_add(&bar[XB_XSUB(b.x)], 1u);
        const unsigned gen = old / nloc;
        if (old + 1u == (gen + 1u) * nloc) {
            __builtin_amdgcn_fence(__ATOMIC_RELEASE, "agent");
            asm volatile("s_waitcnt vmcnt(0)" ::: "memory");
            const unsigned og = xb_add(&bar[XB_TOP], 1u);
            const unsigned tg = og / nx;
            if (og + 1u == (tg + 1u) * nx) xb_add(&bar[XB_TOPGEN], 1u);
            else XB_SPIN(xb_ld(&bar[XB_TOPGEN]) == tg, bar);
            __builtin_amdgcn_fence(__ATOMIC_ACQUIRE, "agent");
            xb_add(&bar[XB_XGEN(b.x)], 1u);
            asm volatile("s_waitcnt vmcnt(0)" ::: "memory");
        } else {
            XB_SPIN(xb_ld(&bar[XB_XGEN(b.x)]) == gen, bar);
            __builtin_amdgcn_fence(__ATOMIC_ACQUIRE, "agent");
            asm volatile("s_waitcnt vmcnt(0)" ::: "memory");
        }
    }
    __syncthreads();
}


constexpr int NWAVES = 8, NTHR = 512;
constexpr int DM = 1024, TP = 16384, TS = 1024, TALL = TP + TS, SEQ = 8192, DSEQ = 8, DBATCH = 128, PAST = 8192, PAGE = 128, NPAGES = 64;
constexpr int QLORA = 384, KVLORA = 256, ROPE = 32, NOPE = 64, QHD = 96, VHD = 64, NH = 8;
constexpr int DSSM = 512, NSTATE = 128, CONVD = 1024, SSD_HD = 64, CHUNK = 128, NCHUNK = SEQ / CHUNK;
constexpr int IN_DIM = 2216, IN_PAD = 2304;
constexpr int O_CQ = 0, O_CKV = 384, O_KPE = 640, O_Z = 672, O_XBC = 1184, O_DT = 2208;
constexpr int NMEM = 256, MH = 4, MHD = 256;
constexpr int PH = 8, NKEYS = 128, NEXP = 16384, PTOPK = 16;
constexpr float DN_ALPHA = 1.189207115002721f;
constexpr float MLA_SCALE = 0.10206207261596577f;
constexpr float LOG2E = 1.4426950408889634f;
constexpr int NPOS = 8200;

constexpr size_t OUT_YP = 0, OUT_YS = OUT_YP + (size_t)TP * DM, OUT_KVP = OUT_YS + (size_t)TS * DM, OUT_KRP = OUT_KVP + (size_t)TP * KVLORA,
    OUT_CVP = OUT_KRP + (size_t)TP * ROPE, OUT_SSP = OUT_CVP + 2 * 3 * CONVD, OUT_MKP = OUT_SSP + 2 * 8 * 64 * 128, OUT_MVP = OUT_MKP + 512 * 1024,
    OUT_KVS = OUT_MVP + 512 * 1024, OUT_KRS = OUT_KVS + (size_t)TS * KVLORA, OUT_CVS = OUT_KRS + (size_t)TS * ROPE, OUT_SSS = OUT_CVS + 128 * 3 * CONVD,
    OUT_END = OUT_SSS + (size_t)128 * 8 * 64 * 128;

constexpr size_t al64k(size_t x) { return (x + 65535) & ~(size_t)65535; }
constexpr size_t WS_CTL = 0, CTL_ZERO_BYTES = 1u << 20;
constexpr size_t WS_ROPE = WS_CTL + CTL_ZERO_BYTES;
constexpr size_t WS_WIN = WS_ROPE + al64k((size_t)NPOS * 16 * 2 * 4);
constexpr size_t WS_WUQ = WS_WIN + al64k((size_t)IN_PAD * DM * 2);
constexpr size_t WS_WABS = WS_WUQ + al64k((size_t)768 * 384 * 2);
constexpr size_t WS_WKV = WS_WABS + al64k((size_t)2048 * 384 * 2);
constexpr size_t WS_WUVBD = WS_WKV + al64k((size_t)1024 * 256 * 2);
constexpr size_t WS_WOUT = WS_WUVBD + al64k((size_t)512 * 2048 * 2);
constexpr size_t WS_MWQ = WS_WOUT + al64k((size_t)DM * DM * 2);
constexpr size_t WS_MWO = WS_MWQ + al64k((size_t)DM * DM * 2);
constexpr size_t WS_MWKV = WS_MWO + al64k((size_t)DM * DM * 2);
constexpr size_t WS_PWQ = WS_MWKV + al64k((size_t)2048 * DM * 2);
constexpr size_t WS_PKEYS = WS_PWQ + al64k((size_t)2048 * DM * 2);
constexpr size_t WS_PU = WS_PKEYS + al64k((size_t)16 * 128 * 128 * 2);
constexpr size_t WS_PV = WS_PU + al64k((size_t)NEXP * DM * 2);
constexpr size_t WS_XB = WS_PV + al64k((size_t)NEXP * DM * 2);
constexpr size_t WS_MEMB = WS_XB + al64k((size_t)TALL * DM * 2);
constexpr size_t WS_U = WS_MEMB + al64k((size_t)512 * DM * 2);
constexpr size_t WS_CQN = WS_U + al64k((size_t)TALL * IN_PAD * 2);
constexpr size_t WS_CKV = WS_CQN + al64k((size_t)TALL * QLORA * 2);
constexpr size_t WS_KR = WS_CKV + al64k((size_t)TALL * KVLORA * 2);
constexpr size_t WS_XBC = WS_KR + al64k((size_t)TALL * ROPE * 2);
constexpr size_t WS_DT = WS_XBC + al64k((size_t)TALL * CONVD * 2);
constexpr size_t WS_Q = WS_DT + al64k((size_t)TALL * 8 * 4);
constexpr size_t WS_KNV = WS_Q + al64k((size_t)TALL * 768 * 2);
constexpr size_t WS_QLAT = WS_KNV + al64k((size_t)TP * 1024 * 2);
constexpr size_t WS_MK = WS_QLAT + al64k((size_t)TS * 2048 * 2);
constexpr size_t WS_MV = WS_MK + al64k((size_t)512 * DM * 2);
constexpr size_t WS_MKS = WS_MV + al64k((size_t)512 * DM * 2);
constexpr size_t WS_MVS = WS_MKS + al64k((size_t)128 * 256 * DM * 2);
constexpr size_t WS_OATT = WS_MVS + al64k((size_t)128 * 256 * DM * 2);
constexpr size_t WS_OLAT = WS_OATT + al64k((size_t)TALL * 512 * 2);
constexpr size_t WS_APART = WS_OLAT + al64k((size_t)TS * 2048 * 2);
constexpr size_t WS_STATES = WS_APART + al64k((size_t)128 * 2 * 64 * 264 * 4);
constexpr size_t WS_HPREV = WS_STATES + al64k((size_t)2 * 64 * 8 * 64 * 128 * 4);
constexpr size_t WS_CDEC = WS_HPREV + al64k((size_t)2 * 64 * 8 * 64 * 128 * 2);
constexpr size_t WS_MIXA = WS_CDEC + al64k((size_t)2 * 64 * 8 * 4);
constexpr size_t WS_MIX = WS_MIXA + al64k((size_t)TALL * DM * 2);
constexpr size_t WS_H1 = WS_MIX + al64k((size_t)TALL * DM * 2);
constexpr size_t WS_H1B = WS_H1 + al64k((size_t)TALL * DM * 4);
constexpr size_t WS_H2 = WS_H1B + al64k((size_t)TALL * DM * 2);
constexpr size_t WS_H2B = WS_H2 + al64k((size_t)TALL * DM * 4);
constexpr size_t WS_QM = WS_H2B + al64k((size_t)TALL * DM * 2);
constexpr size_t WS_OM = WS_QM + al64k((size_t)TALL * DM * 2);
constexpr size_t WS_PQ = WS_OM + al64k((size_t)TALL * DM * 2);
constexpr size_t WS_PTOPS = WS_PQ + al64k((size_t)TALL * 2048 * 2);
constexpr size_t WS_PTOPI = WS_PTOPS + al64k((size_t)TALL * 256 * 4);
constexpr size_t WS_PIDX = WS_PTOPI + al64k((size_t)TALL * 256 * 4);
constexpr size_t WS_PG = WS_PIDX + al64k((size_t)TALL * 128 * 4);
constexpr size_t WS_YG = WS_PG + al64k((size_t)TALL * 128 * 4);
constexpr size_t WS_MIX2 = WS_YG + al64k((size_t)TALL * 512 * 2);
constexpr size_t WS_END = WS_MIX2 + al64k((size_t)TALL * DM * 2);
constexpr int CW_DIAG = 65536;

constexpr int CW_TMO = 0, CW_CODE = 1;
constexpr int CW_BAR = 4096;

constexpr int RING_OFF = 0, RING_BYTES = 131072;
constexpr int LDSCTL_OFF = RING_BYTES, MISC_OFF = LDSCTL_OFF + 320;
constexpr int LDS_BYTES = 147456;

struct Args { const void* in[38]; float* out; unsigned char* ws; int ph_lo, ph_hi; };

struct Frame {
    LAS unsigned char* lds;
    volatile LAS unsigned* MISC;
    gu32* ctl;
    int tid, lane, wave;
    int vcu, G;
};

__device__ __forceinline__ float wave_sum(float v) {
#pragma unroll
    for (int o = 1; o < 64; o <<= 1) v += __shfl_xor(v, o);
    return v;
}
__device__ __forceinline__ float bf2f(unsigned short b) { return __uint_as_float((unsigned)b << 16); }
__device__ __forceinline__ float bflo(unsigned u) { return __uint_as_float(u << 16); }
__device__ __forceinline__ float bfhi(unsigned u) { return __uint_as_float(u & 0xffff0000u); }
__device__ __forceinline__ float siluf(float x) { return x / (1.f + __expf(-x)); }

__device__ __forceinline__ void transpose_tile(const float* W, int ldw, int nvalid, bf16* WT, int ldwt, LAS float* scr, int k0, int n0, int lane) {
#pragma unroll 8
    for (int i = 0; i < 32; ++i) { const int kk = 2 * i + (lane >> 5); const int n = n0 + (lane & 31);
        scr[kk * 33 + (lane & 31)] = (n < nvalid) ? W[(size_t)(k0 + kk) * ldw + n] : 0.f; }
    LDS_WAIT(); asm volatile("" ::: "memory");
    const int c = lane & 7;
#pragma unroll
    for (int j = 0; j < 4; ++j) { const int n = (lane >> 3) + 8 * j; const LAS float* s = scr + (8 * c) * 33 + n;
        v4u o; o.x = pk2(s[0 * 33], s[1 * 33]); o.y = pk2(s[2 * 33], s[3 * 33]); o.z = pk2(s[4 * 33], s[5 * 33]); o.w = pk2(s[6 * 33], s[7 * 33]);
        *(GAS v4u*)(WT + (size_t)(n0 + n) * ldwt + k0 + 8 * c) = o; }
    LDS_WAIT(); asm volatile("" ::: "memory");
}
__device__ __forceinline__ void transpose_mat(const Frame& F, const float* W, int K, int N, int Npad, int ldw, bf16* WT, int ldwt) {
    LAS float* scr = (LAS float*)(F.lds + RING_OFF + F.wave * 16384);
    const int gw = F.vcu * NWAVES + F.wave, NGW = F.G * NWAVES;
    const int nblk = Npad / 32, items = (K / 64) * nblk;
    for (int it = gw; it < items; it += NGW) { const int kb = it / nblk, nb = it % nblk; transpose_tile(W, ldw, N, WT, ldwt, scr, 64 * kb, 32 * nb, F.lane); }
}
__device__ __forceinline__ void convert_bf16(const Frame& F, const float* src, bf16* dst, size_t n) {
    const size_t gt = (size_t)F.vcu * NTHR + F.tid, NGT = (size_t)F.G * NTHR; const size_t items = n / 8;
    for (size_t i0 = gt; i0 < items; i0 += 4 * NGT) { f32x4 a[4], b[4];
#pragma unroll
        for (int u = 0; u < 4; ++u) { const size_t i = i0 + u * NGT; if (i < items) { a[u] = __builtin_nontemporal_load((const GAS f32x4*)(src + 8 * i)); b[u] = __builtin_nontemporal_load((const GAS f32x4*)(src + 8 * i + 4)); } }
#pragma unroll
        for (int u = 0; u < 4; ++u) { const size_t i = i0 + u * NGT; if (i < items) { v4u o; o.x = pk2(a[u].x, a[u].y); o.y = pk2(a[u].z, a[u].w); o.z = pk2(b[u].x, b[u].y); o.w = pk2(b[u].z, b[u].w); *(GAS v4u*)(dst + 8 * i) = o; } } }
}
constexpr float PU_SCALE = 64.f, PV_SCALE = 16.f;
__device__ __forceinline__ unsigned pk4_fp8(f32x4 v, float sc) { int r = __builtin_amdgcn_cvt_pk_fp8_f32(v.x * sc, v.y * sc, 0, false); r = __builtin_amdgcn_cvt_pk_fp8_f32(v.z * sc, v.w * sc, r, true); return (unsigned)r; }
__device__ __forceinline__ void convert_fp8(const Frame& F, const float* src, unsigned char* dst, size_t n, float sc) {
    const size_t gt = (size_t)F.vcu * NTHR + F.tid, NGT = (size_t)F.G * NTHR; const size_t items = n / 16;
    for (size_t i0 = gt; i0 < items; i0 += 2 * NGT) { f32x4 a[2][4];
#pragma unroll
        for (int u = 0; u < 2; ++u) { const size_t i = i0 + u * NGT; if (i < items) {
#pragma unroll
            for (int q = 0; q < 4; ++q) a[u][q] = __builtin_nontemporal_load((const GAS f32x4*)(src + 16 * i + 4 * q)); } }
#pragma unroll
        for (int u = 0; u < 2; ++u) { const size_t i = i0 + u * NGT; if (i < items) { v4u o; o.x = pk4_fp8(a[u][0], sc); o.y = pk4_fp8(a[u][1], sc); o.z = pk4_fp8(a[u][2], sc); o.w = pk4_fp8(a[u][3], sc); *(GAS v4u*)(dst + 16 * i) = o; } } }
}

struct P {
    const float *x_prompt, *x_sample, *mem_prompt, *cache_c, *cache_r, *state_conv, *state_ssm, *cache_mk, *cache_mv; const int* page_table;
    const float *w_in, *q_a_norm, *w_uq, *kv_a_norm, *w_uk, *w_uv, *attn_out_norm, *conv_w, *conv_b, *dt_bias, *a_log, *d_skip, *ssm_norm, *w_out, *ln1_g, *ln1_b,
        *mem_wq, *mem_wk, *mem_wv, *mem_wo, *ln2_g, *ln2_b, *peer_wq, *peer_keys, *peer_u, *peer_v, *ln3_g, *ln3_b;
    float* out; unsigned char* ws;
};

__device__ __forceinline__ void p0_prologue(const Frame& F, const P& p) {
    unsigned char* ws = p.ws;
    transpose_mat(F, p.w_in, DM, IN_DIM, IN_PAD, IN_DIM, (bf16*)(ws + WS_WIN), DM);
    transpose_mat(F, p.w_uq, QLORA, 768, 768, 768, (bf16*)(ws + WS_WUQ), QLORA);
    transpose_mat(F, p.w_uk, KVLORA, 512, 512, 512, (bf16*)(ws + WS_WKV), KVLORA);
    transpose_mat(F, p.w_uv, KVLORA, 512, 512, 512, (bf16*)(ws + WS_WKV) + (size_t)512 * KVLORA, KVLORA);
    transpose_mat(F, p.w_out, DM, DM, DM, DM, (bf16*)(ws + WS_WOUT), DM);
    transpose_mat(F, p.mem_wq, DM, DM, DM, DM, (bf16*)(ws + WS_MWQ), DM);
    transpose_mat(F, p.mem_wo, DM, DM, DM, DM, (bf16*)(ws + WS_MWO), DM);
    transpose_mat(F, p.mem_wk, DM, DM, DM, DM, (bf16*)(ws + WS_MWKV), DM);
    transpose_mat(F, p.mem_wv, DM, DM, DM, DM, (bf16*)(ws + WS_MWKV) + (size_t)DM * DM, DM);
    transpose_mat(F, p.peer_wq, DM, 2048, 2048, 2048, (bf16*)(ws + WS_PWQ), DM);
    const size_t gt = (size_t)F.vcu * NTHR + F.tid, NGT = (size_t)F.G * NTHR;
    { bf16* WB = (bf16*)(ws + WS_WUVBD);
      for (size_t i = gt; i < (size_t)512 * 2048 / 8; i += NGT) { const int n = (int)(i / 256), k8 = (int)(i % 256) * 8; const int h = n >> 6, h2 = k8 >> 8;
          v4u o = (v4u){0u, 0u, 0u, 0u};
          if (h == h2) { const int c = k8 & 255; float v[8];
#pragma unroll
              for (int j = 0; j < 8; ++j) v[j] = p.w_uv[(size_t)(c + j) * 512 + n];
              o.x = pk2(v[0], v[1]); o.y = pk2(v[2], v[3]); o.z = pk2(v[4], v[5]); o.w = pk2(v[6], v[7]); }
          *(GAS v4u*)(WB + (size_t)n * 2048 + k8) = o; } }
    { bf16* WA = (bf16*)(ws + WS_WABS);
      for (size_t i = gt; i < (size_t)2048 * QLORA; i += NGT) { const int n = (int)(i / QLORA), k = (int)(i % QLORA); const int h = n >> 8, c = n & 255;
          const float* a = p.w_uq + (size_t)k * 768 + h * 96; const float* b = p.w_uk + (size_t)c * 512 + h * 64; float s = 0.f;
#pragma unroll
          for (int d = 0; d < 16; ++d) { const f32x4 av = *(const GAS f32x4*)(a + 4 * d), bv = *(const GAS f32x4*)(b + 4 * d); s += (av[0] * bv[0] + av[1] * bv[1]) + (av[2] * bv[2] + av[3] * bv[3]); }
          WA[i] = (bf16)f2bf(s); } }
    { float* tab = (float*)(ws + WS_ROPE);
      for (size_t i = gt; i < (size_t)NPOS * 16; i += NGT) { const int pos = (int)(i >> 4), f = (int)(i & 15);
          const float inv = powf(10000.0f, -(float)f / 16.0f); const float ang = (float)pos * inv; float sn, cs; sincosf(ang, &sn, &cs);
          tab[2 * i] = cs; tab[2 * i + 1] = sn; } }
    convert_bf16(F, p.peer_keys, (bf16*)(ws + WS_PKEYS), (size_t)16 * 128 * 128);
    convert_fp8(F, p.peer_u, ws + WS_PU, (size_t)NEXP * DM, PU_SCALE);
    convert_fp8(F, p.peer_v, ws + WS_PV, (size_t)NEXP * DM, PV_SCALE);
    convert_bf16(F, p.x_prompt, (bf16*)(ws + WS_XB), (size_t)TP * DM);
    convert_bf16(F, p.x_sample, (bf16*)(ws + WS_XB) + (size_t)TP * DM, (size_t)TS * DM);
    convert_bf16(F, p.mem_prompt, (bf16*)(ws + WS_MEMB), (size_t)512 * DM);
}

template <class Fn> struct EpiGen8 {
    static constexpr bool PERM = true, AFTER_DRAIN = false; Fn f;
    __device__ __forceinline__ void operator()(const pg8::f32x4 (&acc)[2][2][4][2], const pg8::Unit& u, int wr, int wc, int fr, int fq) const {
#pragma unroll
        for (int ai = 0; ai < 2; ++ai)
#pragma unroll
            for (int m = 0; m < 4; ++m) { const int row = u.pm * 256 + ai * 128 + wr * 64 + m * 16 + fr;
#pragma unroll
                for (int bj = 0; bj < 2; ++bj) { const int col = u.pn * 256 + bj * 128 + wc * 32 + 8 * fq; f(row, col, acc[ai][bj][m][0], acc[ai][bj][m][1]); } }
    }
};
struct StoreBf16 { bf16* O; int ldc; float scale;
    __device__ __forceinline__ void operator()(int row, int col, f32x4 v0, f32x4 v1) const {
        v4u w; w.x = pk2(v0[0] * scale, v0[1] * scale); w.y = pk2(v0[2] * scale, v0[3] * scale); w.z = pk2(v1[0] * scale, v1[1] * scale); w.w = pk2(v1[2] * scale, v1[3] * scale);
        *(GAS v4u*)(O + (size_t)row * ldc + col) = w; } };
struct StoreMemKV { float* ok; float* ov; bf16* bk; bf16* bv;
    __device__ __forceinline__ void operator()(int row, int col, f32x4 v0, f32x4 v1) const {
        const bool isv = col >= 1024; const int c = col & 1023; float* of = (isv ? ov : ok) + (size_t)row * 1024 + c; bf16* ob = (isv ? bv : bk) + (size_t)row * 1024 + c;
        *(GAS f32x4*)of = v0; *(GAS f32x4*)(of + 4) = v1;
        v4u w; w.x = pk2(v0[0], v0[1]); w.y = pk2(v0[2], v0[3]); w.z = pk2(v1[0], v1[1]); w.w = pk2(v1[2], v1[3]); *(GAS v4u*)ob = w; } };

__device__ __forceinline__ void p2_rows(const Frame& F, const P& p) {
    unsigned char* ws = p.ws;
    const bf16* U = (const bf16*)(ws + WS_U); bf16* CQN = (bf16*)(ws + WS_CQN); bf16* CKV = (bf16*)(ws + WS_CKV); bf16* KR = (bf16*)(ws + WS_KR);
    bf16* XBC = (bf16*)(ws + WS_XBC); float* DT = (float*)(ws + WS_DT); const float* tab = (const float*)(ws + WS_ROPE);
    const int lane = F.lane; const int gw = F.vcu * NWAVES + F.wave, NGW = F.G * NWAVES;
    for (int t = gw; t < TALL; t += NGW) {
        const bool smp = t >= TP; const int ts = t - TP; const int tl = smp ? (ts & 7) : (t & (SEQ - 1)); const int pos = smp ? PAST + tl : tl;
        const unsigned* urow = (const unsigned*)(U + (size_t)t * IN_PAD);
        { unsigned w[3]; float ss = 0.f;
#pragma unroll
          for (int i = 0; i < 3; ++i) { w[i] = urow[O_CQ / 2 + lane + 64 * i]; const float a = bflo(w[i]), b = bfhi(w[i]); ss += a * a + b * b; }
          const float r = rsqrtf(wave_sum(ss) * (1.f / QLORA) + 1e-6f);
#pragma unroll
          for (int i = 0; i < 3; ++i) { const int e = 2 * (lane + 64 * i); ((unsigned*)(CQN + (size_t)t * QLORA))[lane + 64 * i] = pk2(bflo(w[i]) * r * p.q_a_norm[e], bfhi(w[i]) * r * p.q_a_norm[e + 1]); } }
        { unsigned w[2]; float ss = 0.f;
#pragma unroll
          for (int i = 0; i < 2; ++i) { w[i] = urow[O_CKV / 2 + lane + 64 * i]; const float a = bflo(w[i]), b = bfhi(w[i]); ss += a * a + b * b; }
          const float r = rsqrtf(wave_sum(ss) * (1.f / KVLORA) + 1e-6f);
          float* of = smp ? p.out + OUT_KVS + (size_t)ts * KVLORA : p.out + OUT_KVP + (size_t)t * KVLORA;
#pragma unroll
          for (int i = 0; i < 2; ++i) { const int e = 2 * (lane + 64 * i); const float a = bflo(w[i]) * r * p.kv_a_norm[e], b = bfhi(w[i]) * r * p.kv_a_norm[e + 1];
              of[e] = a; of[e + 1] = b; ((unsigned*)(CKV + (size_t)t * KVLORA))[lane + 64 * i] = pk2(a, b); } }
        if (lane < 16) { const unsigned short* ur = (const unsigned short*)(U + (size_t)t * IN_PAD + O_KPE); const float x1 = bf2f(ur[lane]), x2 = bf2f(ur[lane + 16]);
          const float cs = tab[((size_t)pos * 16 + lane) * 2], sn = tab[((size_t)pos * 16 + lane) * 2 + 1];
          const float o1 = x1 * cs - x2 * sn, o2 = x2 * cs + x1 * sn;
          float* of = smp ? p.out + OUT_KRS + (size_t)ts * ROPE : p.out + OUT_KRP + (size_t)t * ROPE; of[lane] = o1; of[lane + 16] = o2;
          KR[(size_t)t * ROPE + lane] = (bf16)f2bf(o1); KR[(size_t)t * ROPE + lane + 16] = (bf16)f2bf(o2); }
        if (lane < 8) { const float raw = bf2f(U[(size_t)t * IN_PAD + O_DT + lane]) + p.dt_bias[lane]; DT[(size_t)t * 8 + lane] = raw > 20.f ? raw : log1pf(__expf(raw)); }
#pragma unroll
        for (int i = 0; i < 8; ++i) { const int pr = lane + 64 * i, c = 2 * pr; float a0 = p.conv_b[c], a1 = p.conv_b[c + 1];
#pragma unroll
            for (int k = 0; k < 4; ++k) { const int f = tl + k; float x0, x1;
                if (f >= 3) { const unsigned w = ((const unsigned*)(U + (size_t)(t - 3 + k) * IN_PAD + O_XBC))[pr]; x0 = bflo(w); x1 = bfhi(w); }
                else if (smp) { const float* sc = p.state_conv + ((size_t)(ts >> 3) * 3 + f) * CONVD + c; x0 = sc[0]; x1 = sc[1]; }
                else { x0 = 0.f; x1 = 0.f; }
                a0 += p.conv_w[k * CONVD + c] * x0; a1 += p.conv_w[k * CONVD + c + 1] * x1; }
            ((unsigned*)(XBC + (size_t)t * CONVD))[pr] = pk2(siluf(a0), siluf(a1)); }
        if (!smp && tl >= SEQ - 3) { float* of = p.out + OUT_CVP + ((size_t)(t >> 13) * 3 + (tl - (SEQ - 3))) * CONVD;
#pragma unroll
            for (int i = 0; i < 8; ++i) { const int pr = lane + 64 * i; const unsigned w = urow[O_XBC / 2 + pr]; of[2 * pr] = bflo(w); of[2 * pr + 1] = bfhi(w); } }
        if (smp && tl >= DSEQ - 3) { float* of = p.out + OUT_CVS + ((size_t)(ts >> 3) * 3 + (tl - (DSEQ - 3))) * CONVD;
#pragma unroll
            for (int i = 0; i < 8; ++i) { const int pr = lane + 64 * i; const unsigned w = urow[O_XBC / 2 + pr]; of[2 * pr] = bflo(w); of[2 * pr + 1] = bfhi(w); } }
    }
}

typedef unsigned u32x2 __attribute__((ext_vector_type(2)));
typedef short s16x4 __attribute__((ext_vector_type(4)));
typedef short v4i16_t __attribute__((ext_vector_type(4)));
struct EpiQRope {
    static constexpr bool PERM = false, AFTER_DRAIN = false;
    bf16* Q; const float* tab; float scale;
    __device__ __forceinline__ void operator()(const pg8::f32x4 (&acc)[2][2][4][2], const pg8::Unit& u, int wr, int wc, int fr, int fq) const {
#pragma unroll
        for (int ai = 0; ai < 2; ++ai)
#pragma unroll
            for (int m = 0; m < 4; ++m) { const int row = u.pm * 256 + ai * 128 + wr * 64 + m * 16 + fr;
                const int pos = row < TP ? (row & (SEQ - 1)) : PAST + ((row - TP) & 7);
#pragma unroll
                for (int bj = 0; bj < 2; ++bj) { const int grp = 8 * u.pn + 4 * bj + wc; const int col = 32 * grp + 4 * fq;
                    f32x4 a = acc[ai][bj][m][0], b = acc[ai][bj][m][1];
                    if (grp % 3 == 2) { const f32x4 t0 = *(const GAS f32x4*)(tab + ((size_t)pos * 16 + 4 * fq) * 2), t1 = *(const GAS f32x4*)(tab + ((size_t)pos * 16 + 4 * fq) * 2 + 4);
                        const float cs[4] = {t0[0], t0[2], t1[0], t1[2]}, sn[4] = {t0[1], t0[3], t1[1], t1[3]}; f32x4 o1, o2;
#pragma unroll
                        for (int i = 0; i < 4; ++i) { o1[i] = a[i] * cs[i] - b[i] * sn[i]; o2[i] = b[i] * cs[i] + a[i] * sn[i]; }
                        a = o1; b = o2; }
                    u32x2 w0, w1; w0.x = pk2(a[0] * scale, a[1] * scale); w0.y = pk2(a[2] * scale, a[3] * scale); w1.x = pk2(b[0] * scale, b[1] * scale); w1.y = pk2(b[2] * scale, b[3] * scale);
                    *(GAS u32x2*)(Q + (size_t)row * 768 + col) = w0; *(GAS u32x2*)(Q + (size_t)row * 768 + col + 16) = w1; }
                asm volatile("" ::: "memory"); }
    }
};

__device__ __forceinline__ s16x4 tr_read(const LAS unsigned char* p) { return __builtin_bit_cast(s16x4, __builtin_amdgcn_ds_read_tr16_b64_v4i16((LAS v4i16_t*)p)); }
__device__ __forceinline__ bf16x8 cat8(s16x4 a, s16x4 b) { return (bf16x8){a[0], a[1], a[2], a[3], b[0], b[1], b[2], b[3]}; }
__device__ __forceinline__ bf16x8 pack8(f32x4 a, f32x4 b) { v4u w; w.x = pk2(a[0], a[1]); w.y = pk2(a[2], a[3]); w.z = pk2(b[0], b[1]); w.w = pk2(b[2], b[3]); return __builtin_bit_cast(bf16x8, w); }
#define MFMA16(a, b, c) __builtin_amdgcn_mfma_f32_16x16x32_bf16((a), (b), (c), 0, 0, 0)

__device__ __forceinline__ bf16x8 rope_frag(bf16x8 v, int pos, int g, const float* tab) {
    const v4u m = __builtin_bit_cast(v4u, v); v4u o; o.x = (unsigned)__shfl_xor((int)m.x, 32); o.y = (unsigned)__shfl_xor((int)m.y, 32); o.z = (unsigned)__shfl_xor((int)m.z, 32); o.w = (unsigned)__shfl_xor((int)m.w, 32);
    const float* tp = tab + ((size_t)pos * 16 + 8 * (g & 1)) * 2; const f32x4 t0 = *(const GAS f32x4*)tp, t1 = *(const GAS f32x4*)(tp + 4), t2 = *(const GAS f32x4*)(tp + 8), t3 = *(const GAS f32x4*)(tp + 12);
    const float sg = g < 2 ? -1.f : 1.f;
    v4u r;
    r.x = pk2(bflo(m.x) * t0[0] + sg * bflo(o.x) * t0[1], bfhi(m.x) * t0[2] + sg * bfhi(o.x) * t0[3]);
    r.y = pk2(bflo(m.y) * t1[0] + sg * bflo(o.y) * t1[1], bfhi(m.y) * t1[2] + sg * bfhi(o.y) * t1[3]);
    r.z = pk2(bflo(m.z) * t2[0] + sg * bflo(o.z) * t2[1], bfhi(m.z) * t2[2] + sg * bfhi(o.z) * t2[3]);
    r.w = pk2(bflo(m.w) * t3[0] + sg * bflo(o.w) * t3[1], bfhi(m.w) * t3[2] + sg * bfhi(o.w) * t3[3]);
    return __builtin_bit_cast(bf16x8, r);
}

constexpr int PA_KST = 104, PA_VST = 72;
constexpr int PA_KBYTES = 64 * PA_KST * 2, PA_VBYTES = 64 * PA_VST * 2, PA_BUF = PA_KBYTES + PA_VBYTES;
__device__ __forceinline__ void attn_prompt_unit(const Frame& F, const P& p, int b, int h, int qb) {
    unsigned char* ws = p.ws;
    const bf16* Q = (const bf16*)(ws + WS_Q); const bf16* KNV = (const bf16*)(ws + WS_KNV); const bf16* KR = (const bf16*)(ws + WS_KR); bf16* OATT = (bf16*)(ws + WS_OATT);
    const int tid = F.tid, lane = F.lane, w = F.wave, li = lane & 15, g = lane >> 4;
    const size_t rowbase = (size_t)b * SEQ; const int q0 = qb * 256 + w * 32;
    LAS unsigned char* lds = F.lds + RING_OFF;
    bf16x8 qf[2][3];
#pragma unroll
    for (int j = 0; j < 2; ++j)
#pragma unroll
        for (int ks = 0; ks < 3; ++ks) qf[j][ks] = *(const GAS bf16x8*)(Q + (rowbase + q0 + 16 * j + li) * 768 + h * 96 + 32 * ks + 8 * g);
#pragma unroll
    for (int j = 0; j < 2; ++j) qf[j][2] = rope_frag(qf[j][2], q0 + 16 * j + li, g, (const float*)(ws + WS_ROPE));
    f32x4 o[4][2];
#pragma unroll
    for (int d = 0; d < 4; ++d)
#pragma unroll
        for (int j = 0; j < 2; ++j) o[d][j] = (f32x4){0.f, 0.f, 0.f, 0.f};
    float mrun[2] = {-INFINITY, -INFINITY}, lrun[2] = {0.f, 0.f};
    const int NT = 4 * (qb + 1); const int tq = 4 * qb + (w >> 1);
    const int srow = tid >> 3, sch = tid & 7, rrow = tid >> 2, rch = tid & 3;
    v4u sk, sv, sr = (v4u){0u, 0u, 0u, 0u};
#define PA_LOAD(t) do { const size_t kr_ = rowbase + (size_t)(t) * 64; \
        sk = *(const GAS v4u*)(KNV + (kr_ + srow) * 1024 + h * 64 + sch * 8); sv = *(const GAS v4u*)(KNV + (kr_ + srow) * 1024 + 512 + h * 64 + sch * 8); \
        if (tid < 256) sr = *(const GAS v4u*)(KR + (kr_ + rrow) * 32 + rch * 8); } while (0)
#define PA_STORE(buf) do { LAS unsigned char* kb_ = lds + (buf) * PA_BUF; \
        *(LAS v4u*)(kb_ + (srow * PA_KST + sch * 8) * 2) = sk; *(LAS v4u*)(kb_ + PA_KBYTES + (srow * PA_VST + sch * 8) * 2) = sv; \
        if (tid < 256) *(LAS v4u*)(kb_ + (rrow * PA_KST + 64 + rch * 8) * 2) = sr; } while (0)
    __syncthreads();
    PA_LOAD(0); PA_STORE(0); __syncthreads();
    for (int t = 0; t < NT; ++t) {
        const int buf = t & 1;
        if (t + 1 < NT) PA_LOAD(t + 1);
        if (t <= tq) {
            const LAS unsigned char* kb = lds + buf * PA_BUF; const LAS unsigned char* vb = kb + PA_KBYTES;
            f32x4 s[4][2];
#pragma unroll
            for (int kt = 0; kt < 4; ++kt) {
                bf16x8 kf[3];
#pragma unroll
                for (int ks = 0; ks < 3; ++ks) kf[ks] = *(const LAS bf16x8*)(kb + ((16 * kt + li) * PA_KST + 32 * ks + 8 * g) * 2);
#pragma unroll
                for (int j = 0; j < 2; ++j) { f32x4 a = (f32x4){0.f, 0.f, 0.f, 0.f};
#pragma unroll
                    for (int ks = 0; ks < 3; ++ks) a = MFMA16(kf[ks], qf[j][ks], a);
                    s[kt][j] = a; } }
            if (t == tq) {
#pragma unroll
                for (int j = 0; j < 2; ++j) { const int qa = q0 + 16 * j + li;
#pragma unroll
                    for (int kt = 0; kt < 4; ++kt)
#pragma unroll
                        for (int r = 0; r < 4; ++r) if (64 * t + 16 * kt + 4 * g + r > qa) s[kt][j][r] = -INFINITY; } }
            bf16x8 pf[2][2];
#pragma unroll
            for (int j = 0; j < 2; ++j) {
                float mx = -INFINITY;
#pragma unroll
                for (int kt = 0; kt < 4; ++kt)
#pragma unroll
                    for (int r = 0; r < 4; ++r) mx = fmaxf(mx, s[kt][j][r]);
                mx = fmaxf(mx, __shfl_xor(mx, 16)); mx = fmaxf(mx, __shfl_xor(mx, 32));
                const float mn = fmaxf(mrun[j], mx); const float alpha = __builtin_amdgcn_exp2f(mrun[j] - mn); mrun[j] = mn;
                float ps = 0.f;
#pragma unroll
                for (int kt = 0; kt < 4; ++kt)
#pragma unroll
                    for (int r = 0; r < 4; ++r) { const float e = __builtin_amdgcn_exp2f(s[kt][j][r] - mn); s[kt][j][r] = e; ps += e; }
                lrun[j] = lrun[j] * alpha + ps;
#pragma unroll
                for (int d = 0; d < 4; ++d) o[d][j] = o[d][j] * alpha;
                pf[j][0] = pack8(s[0][j], s[1][j]); pf[j][1] = pack8(s[2][j], s[3][j]);
            }
#pragma unroll
            for (int kk = 0; kk < 2; ++kk)
#pragma unroll
                for (int d = 0; d < 4; ++d) {
                    const LAS unsigned char* va = vb + ((32 * kk + 4 * g + (li >> 2)) * PA_VST + 16 * d + 4 * (li & 3)) * 2;
                    const bf16x8 vf = cat8(tr_read(va), tr_read(va + 16 * PA_VST * 2));
#pragma unroll
                    for (int j = 0; j < 2; ++j) o[d][j] = MFMA16(vf, pf[j][kk], o[d][j]); }
        }
        if (t + 1 < NT) PA_STORE(buf ^ 1);
        __syncthreads();
    }
#undef PA_LOAD
#undef PA_STORE
#pragma unroll
    for (int j = 0; j < 2; ++j) { float l = lrun[j]; l += __shfl_xor(l, 16); l += __shfl_xor(l, 32); const float rl = 1.f / l;
        bf16* orow = OATT + (rowbase + q0 + 16 * j + li) * 512 + h * 64 + 4 * g;
#pragma unroll
        for (int d = 0; d < 4; ++d) { u32x2 wv; wv.x = pk2(o[d][j][0] * rl, o[d][j][1] * rl); wv.y = pk2(o[d][j][2] * rl, o[d][j][3] * rl); *(GAS u32x2*)(orow + 16 * d) = wv; } }
}

constexpr int SA_ST = 296;
constexpr int SA_BUF = 64 * SA_ST * 2;
constexpr int AP_ST = 264;
__device__ __forceinline__ void attn_sample_unit(const Frame& F, const P& p, int b, int split) {
    unsigned char* ws = p.ws;
    const bf16* Q = (const bf16*)(ws + WS_Q); const bf16* QLAT = (const bf16*)(ws + WS_QLAT); const bf16* CKV = (const bf16*)(ws + WS_CKV); const bf16* KR = (const bf16*)(ws + WS_KR);
    float* APART = (float*)(ws + WS_APART);
    const int tid = F.tid, lane = F.lane, w = F.wave, li = lane & 15, g = lane >> 4, jq = w & 3, ch = w >> 2;
    LAS unsigned char* lds = F.lds + RING_OFF;
    bf16x8 qf[9];
    { const int r = 16 * jq + li, tk = r >> 3, hh = r & 7; const bf16* ql = QLAT + (size_t)(b * 8 + tk) * 2048 + hh * 256; const bf16* qp = Q + (size_t)(TP + b * 8 + tk) * 768 + hh * 96 + 64;
#pragma unroll
      for (int ks = 0; ks < 8; ++ks) qf[ks] = *(const GAS bf16x8*)(ql + 32 * ks + 8 * g);
      qf[8] = rope_frag(*(const GAS bf16x8*)(qp + 8 * g), PAST + tk, g, (const float*)(ws + WS_ROPE)); }
    f32x4 o[8];
#pragma unroll
    for (int c = 0; c < 8; ++c) o[c] = (f32x4){0.f, 0.f, 0.f, 0.f};
    float mrun = -INFINITY, lrun = 0.f;
    const int NT = 64 + split;
    const int* pt = p.page_table + b * NPAGES + split * 32;
    f32x4 st[9];
#define SA_LOAD(t) do { if ((t) < 64) { const int pg_ = pt[(t) >> 1]; const float* cl_ = p.cache_c + ((size_t)pg_ * PAGE + ((t) & 1) * 64) * KVLORA; const float* cr_ = p.cache_r + ((size_t)pg_ * PAGE + ((t) & 1) * 64) * ROPE; \
        _Pragma("unroll") for (int i_ = 0; i_ < 8; ++i_) st[i_] = __builtin_nontemporal_load((const GAS f32x4*)(cl_ + (size_t)(tid + 512 * i_) * 4)); \
        st[8] = __builtin_nontemporal_load((const GAS f32x4*)(cr_ + (size_t)tid * 4)); } } while (0)
#define SA_STORE(t, buf) do { LAS unsigned char* kb_ = lds + (buf) * SA_BUF; if ((t) < 64) { \
        _Pragma("unroll") for (int i_ = 0; i_ < 8; ++i_) { const int q_ = tid + 512 * i_; u32x2 w_; w_.x = pk2(st[i_][0], st[i_][1]); w_.y = pk2(st[i_][2], st[i_][3]); *(LAS u32x2*)(kb_ + ((q_ >> 6) * SA_ST + (q_ & 63) * 4) * 2) = w_; } \
        { u32x2 w_; w_.x = pk2(st[8][0], st[8][1]); w_.y = pk2(st[8][2], st[8][3]); *(LAS u32x2*)(kb_ + ((tid >> 3) * SA_ST + 256 + (tid & 7) * 4) * 2) = w_; } } \
      else {   \
        for (int q_ = tid; q_ < 64 * 36; q_ += 512) { const int row_ = q_ / 36, c8_ = q_ % 36; v4u v_ = (v4u){0u, 0u, 0u, 0u}; \
            if (row_ < 8) v_ = c8_ < 32 ? *(const GAS v4u*)(CKV + (size_t)(TP + b * 8 + row_) * KVLORA + c8_ * 8) : *(const GAS v4u*)(KR + (size_t)(TP + b * 8 + row_) * ROPE + (c8_ - 32) * 8); \
            *(LAS v4u*)(kb_ + (row_ * SA_ST + c8_ * 8) * 2) = v_; } } } while (0)
    __syncthreads();
    SA_LOAD(0); SA_STORE(0, 0); __syncthreads();
    for (int t = 0; t < NT; ++t) {
        const int buf = t & 1;
        if (t + 1 < NT) SA_LOAD(t + 1);
        const LAS unsigned char* kb = lds + buf * SA_BUF;
        f32x4 s[4];
#pragma unroll
        for (int kt = 0; kt < 4; ++kt) { f32x4 a = (f32x4){0.f, 0.f, 0.f, 0.f};
#pragma unroll
            for (int ks = 0; ks < 9; ++ks) { const bf16x8 kf = *(const LAS bf16x8*)(kb + ((16 * kt + li) * SA_ST + 32 * ks + 8 * g) * 2); a = MFMA16(kf, qf[ks], a); }
            s[kt] = a; }
        if (t == 64) { const int tk = (16 * jq + li) >> 3;
#pragma unroll
            for (int kt = 0; kt < 4; ++kt)
#pragma unroll
                for (int r = 0; r < 4; ++r) if (16 * kt + 4 * g + r > tk) s[kt][r] = -INFINITY; }
        float mx = -INFINITY;
#pragma unroll
        for (int kt = 0; kt < 4; ++kt)
#pragma unroll
            for (int r = 0; r < 4; ++r) mx = fmaxf(mx, s[kt][r]);
        mx = fmaxf(mx, __shfl_xor(mx, 16)); mx = fmaxf(mx, __shfl_xor(mx, 32));
        const float mn = fmaxf(mrun, mx); const float alpha = __builtin_amdgcn_exp2f(mrun - mn); mrun = mn;
        float ps = 0.f;
#pragma unroll
        for (int kt = 0; kt < 4; ++kt)
#pragma unroll
            for (int r = 0; r < 4; ++r) { const float e = __builtin_amdgcn_exp2f(s[kt][r] - mn); s[kt][r] = e; ps += e; }
        lrun = lrun * alpha + ps;
#pragma unroll
        for (int c = 0; c < 8; ++c) o[c] = o[c] * alpha;
        const bf16x8 pf0 = pack8(s[0], s[1]), pf1 = pack8(s[2], s[3]);
#pragma unroll
        for (int c = 0; c < 8; ++c) {
            const LAS unsigned char* va = kb + ((4 * g + (li >> 2)) * SA_ST + 128 * ch + 16 * c + 4 * (li & 3)) * 2;
            const bf16x8 v0 = cat8(tr_read(va), tr_read(va + 16 * SA_ST * 2)); const bf16x8 v1 = cat8(tr_read(va + 32 * SA_ST * 2), tr_read(va + 48 * SA_ST * 2));
            o[c] = MFMA16(v0, pf0, o[c]); o[c] = MFMA16(v1, pf1, o[c]); }
        if (t + 1 < NT) SA_STORE(t + 1, buf ^ 1);
        __syncthreads();
    }
#undef SA_LOAD
#undef SA_STORE
    { float l = lrun; l += __shfl_xor(l, 16); l += __shfl_xor(l, 32);
      float* pr = APART + ((size_t)(b * 2 + split) * 64 + 16 * jq + li) * AP_ST;
#pragma unroll
      for (int c = 0; c < 8; ++c) *(GAS f32x4*)(pr + 128 * ch + 16 * c + 4 * g) = o[c];
      if (ch == 0 && g == 0) { pr[256] = mrun; pr[257] = l; } }
}
__device__ __forceinline__ void attn_sample_combine(const Frame& F, const P& p) {
    const float* APART = (const float*)(p.ws + WS_APART); bf16* OLAT = (bf16*)(p.ws + WS_OLAT);
    const int gw = F.vcu * NWAVES + F.wave, NGW = F.G * NWAVES, lane = F.lane;
    for (int it = gw; it < DBATCH * 64; it += NGW) { const int b = it >> 6, r = it & 63;
        const float* p0 = APART + ((size_t)(b * 2 + 0) * 64 + r) * AP_ST; const float* p1 = APART + ((size_t)(b * 2 + 1) * 64 + r) * AP_ST;
        const float m0 = p0[256], l0 = p0[257], m1 = p1[256], l1 = p1[257]; const float m = fmaxf(m0, m1); const float w0 = __builtin_amdgcn_exp2f(m0 - m), w1 = __builtin_amdgcn_exp2f(m1 - m);
        const float rl = 1.f / (w0 * l0 + w1 * l1);
        const f32x4 a = *(const GAS f32x4*)(p0 + 4 * lane), c = *(const GAS f32x4*)(p1 + 4 * lane);
        u32x2 wv; wv.x = pk2((w0 * a[0] + w1 * c[0]) * rl, (w0 * a[1] + w1 * c[1]) * rl); wv.y = pk2((w0 * a[2] + w1 * c[2]) * rl, (w0 * a[3] + w1 * c[3]) * rl);
        *(GAS u32x2*)(OLAT + (size_t)(b * 8 + (r >> 3)) * 2048 + (r & 7) * 256 + 4 * lane) = wv; }
}

constexpr int SD_XST = 72, SD_BST = 136;
__device__ __forceinline__ void cumsum128(LAS float* a, LAS float* acum, int lane) {
    float v0 = a[2 * lane], v1 = a[2 * lane + 1]; float s = v0 + v1;
#pragma unroll
    for (int o = 1; o < 64; o <<= 1) { const float n = __shfl_up(s, o); if (lane >= o) s += n; }
    acum[2 * lane] = s - v1; acum[2 * lane + 1] = s;
}
__device__ __forceinline__ void ssd_a_unit(const Frame& F, const P& p, int b, int c, int h) {
    unsigned char* ws = p.ws; const bf16* XBC = (const bf16*)(ws + WS_XBC); const float* DT = (const float*)(ws + WS_DT);
    float* STATES = (float*)(ws + WS_STATES); float* CDEC = (float*)(ws + WS_CDEC);
    const int tid = F.tid, lane = F.lane, w = F.wave, li = lane & 15, g = lane >> 4, g2 = h >> 2;
    LAS unsigned char* lds = F.lds + RING_OFF;
    LAS unsigned char* xs_l = lds;
    LAS unsigned char* b_l = lds + 18432;
    LAS float* a_l = (LAS float*)(lds + 18432 + 34816);
    LAS float* ac_l = a_l + 128; LAS float* dt_l = a_l + 256;
    const size_t t0 = (size_t)b * SEQ + (size_t)c * CHUNK;
    const float Ah = -__expf(p.a_log[h]);
    __syncthreads();
    if (tid < 128) { const float d = DT[(t0 + tid) * 8 + h]; dt_l[tid] = d; a_l[tid] = d * Ah; }
#pragma unroll
    for (int i = 0; i < 4; ++i) { const int q = tid + 512 * i, row = q >> 4, ch8 = q & 15; *(LAS v4u*)(b_l + (row * SD_BST + ch8 * 8) * 2) = *(const GAS v4u*)(XBC + (t0 + row) * CONVD + 512 + g2 * 128 + ch8 * 8); }
    __syncthreads();
    if (w == 0) cumsum128(a_l, ac_l, lane);
    __syncthreads();
    const float alast = ac_l[127];
#pragma unroll
    for (int i = 0; i < 2; ++i) { const int q = tid + 512 * i, row = q >> 3, ch8 = q & 7; const v4u v = *(const GAS v4u*)(XBC + (t0 + row) * CONVD + h * 64 + ch8 * 8);
        const float sc = dt_l[row] * __expf(alast - ac_l[row]); v4u o;
        o.x = pk2(bflo(v.x) * sc, bfhi(v.x) * sc); o.y = pk2(bflo(v.y) * sc, bfhi(v.y) * sc); o.z = pk2(bflo(v.z) * sc, bfhi(v.z) * sc); o.w = pk2(bflo(v.w) * sc, bfhi(v.w) * sc);
        *(LAS v4u*)(xs_l + (row * SD_XST + ch8 * 8) * 2) = o; }
    __syncthreads();
    if (tid == 0) CDEC[(b * NCHUNK + c) * 8 + h] = __expf(alast);
    f32x4 acc[4];
#pragma unroll
    for (int pt = 0; pt < 4; ++pt) acc[pt] = (f32x4){0.f, 0.f, 0.f, 0.f};
#pragma unroll
    for (int kk = 0; kk < 4; ++kk) {
        const LAS unsigned char* ba = b_l + ((32 * kk + 8 * g + (li >> 2)) * SD_BST + 16 * w + 4 * (li & 3)) * 2;
        const bf16x8 bfr = cat8(tr_read(ba), tr_read(ba + 4 * SD_BST * 2));
#pragma unroll
        for (int pt = 0; pt < 4; ++pt) {
            const LAS unsigned char* xa = xs_l + ((32 * kk + 8 * g + (li >> 2)) * SD_XST + 16 * pt + 4 * (li & 3)) * 2;
            const bf16x8 xfr = cat8(tr_read(xa), tr_read(xa + 4 * SD_XST * 2));
            acc[pt] = MFMA16(xfr, bfr, acc[pt]); } }
    float* so = STATES + ((size_t)((b * NCHUNK + c) * 8 + h) * 64) * 128;
#pragma unroll
    for (int pt = 0; pt < 4; ++pt)
#pragma unroll
        for (int r = 0; r < 4; ++r) so[(size_t)(16 * pt + 4 * g + r) * 128 + 16 * w + li] = acc[pt][r];
}
__device__ __forceinline__ void ssd_b_scan(const Frame& F, const P& p) {
    unsigned char* ws = p.ws; const float* STATES = (const float*)(ws + WS_STATES); const float* CDEC = (const float*)(ws + WS_CDEC); bf16* HPREV = (bf16*)(ws + WS_HPREV);
    const size_t gt = (size_t)F.vcu * NTHR + F.tid, NGT = (size_t)F.G * NTHR;
    for (size_t e = gt; e < (size_t)2 * 8 * 64 * 128; e += NGT) { const int b = (int)(e >> 16), h = (int)(e >> 13) & 7, pn = (int)(e & 8191);
        float hcur = 0.f;
        for (int c0 = 0; c0 < NCHUNK; c0 += 16) { float sv[16];
#pragma unroll
            for (int i = 0; i < 16; ++i) sv[i] = STATES[((size_t)((b * NCHUNK + c0 + i) * 8 + h)) * 8192 + pn];
#pragma unroll
            for (int i = 0; i < 16; ++i) { HPREV[((size_t)((b * NCHUNK + c0 + i) * 8 + h)) * 8192 + pn] = (bf16)f2bf(hcur); hcur = CDEC[(b * NCHUNK + c0 + i) * 8 + h] * hcur + sv[i]; } }
        p.out[OUT_SSP + e] = hcur; }
}
__device__ __forceinline__ void ssd_c_unit(const Frame& F, const P& p, int b, int c, int h) {
    unsigned char* ws = p.ws; const bf16* XBC = (const bf16*)(ws + WS_XBC); const float* DT = (const float*)(ws + WS_DT); const bf16* HPREV = (const bf16*)(ws + WS_HPREV);
    const bf16* U = (const bf16*)(ws + WS_U);
    const int tid = F.tid, lane = F.lane, w = F.wave, li = lane & 15, g = lane >> 4, g2 = h >> 2;
    LAS unsigned char* lds = F.lds + RING_OFF;
    LAS unsigned char* x_l = lds;
    LAS unsigned char* b_l = lds + 18432;
    LAS unsigned char* c_l = lds + 18432 + 34816;
    LAS unsigned char* h_l = lds + 18432 + 2 * 34816;
    LAS float* a_l = (LAS float*)(lds + 18432 + 2 * 34816 + 17408);
    LAS float* ac_l = a_l + 128; LAS float* dt_l = a_l + 256;
    const size_t t0 = (size_t)b * SEQ + (size_t)c * CHUNK;
    const float Ah = -__expf(p.a_log[h]);
    __syncthreads();
    if (tid < 128) { const float d = DT[(t0 + tid) * 8 + h]; dt_l[tid] = d; a_l[tid] = d * Ah; }
#pragma unroll
    for (int i = 0; i < 4; ++i) { const int q = tid + 512 * i, row = q >> 4, ch8 = q & 15;
        *(LAS v4u*)(b_l + (row * SD_BST + ch8 * 8) * 2) = *(const GAS v4u*)(XBC + (t0 + row) * CONVD + 512 + g2 * 128 + ch8 * 8);
        *(LAS v4u*)(c_l + (row * SD_BST + ch8 * 8) * 2) = *(const GAS v4u*)(XBC + (t0 + row) * CONVD + 768 + g2 * 128 + ch8 * 8); }
#pragma unroll
    for (int i = 0; i < 2; ++i) { const int q = tid + 512 * i, row = q >> 4, ch8 = q & 15;
        *(LAS v4u*)(h_l + (row * SD_BST + ch8 * 8) * 2) = *(const GAS v4u*)(HPREV + ((size_t)((b * NCHUNK + c) * 8 + h) * 64 + row) * 128 + ch8 * 8); }
    __syncthreads();
    if (w == 0) cumsum128(a_l, ac_l, lane);
    __syncthreads();
#pragma unroll
    for (int i = 0; i < 2; ++i) { const int q = tid + 512 * i, row = q >> 3, ch8 = q & 7; const v4u v = *(const GAS v4u*)(XBC + (t0 + row) * CONVD + h * 64 + ch8 * 8);
        const float sc = dt_l[row]; v4u o;
        o.x = pk2(bflo(v.x) * sc, bfhi(v.x) * sc); o.y = pk2(bflo(v.y) * sc, bfhi(v.y) * sc); o.z = pk2(bflo(v.z) * sc, bfhi(v.z) * sc); o.w = pk2(bflo(v.w) * sc, bfhi(v.w) * sc);
        *(LAS v4u*)(x_l + (row * SD_XST + ch8 * 8) * 2) = o; }
    __syncthreads();
    bf16x8 cf[4];
#pragma unroll
    for (int ks = 0; ks < 4; ++ks) cf[ks] = *(const LAS bf16x8*)(c_l + ((16 * w + li) * SD_BST + 32 * ks + 8 * g) * 2);
    const float acl = ac_l[16 * w + li];
    f32x4 yd[4], yo[4];
#pragma unroll
    for (int pt = 0; pt < 4; ++pt) { yd[pt] = (f32x4){0.f, 0.f, 0.f, 0.f}; yo[pt] = (f32x4){0.f, 0.f, 0.f, 0.f}; }
#pragma unroll
    for (int kk = 0; kk < 4; ++kk) {
        if (2 * kk <= w) {
            f32x4 sg[2];
#pragma unroll
            for (int u = 0; u < 2; ++u) { const int stile = 2 * kk + u; f32x4 a = (f32x4){0.f, 0.f, 0.f, 0.f};
                if (stile <= w) {
#pragma unroll
                    for (int ks = 0; ks < 4; ++ks) { const bf16x8 bfr = *(const LAS bf16x8*)(b_l + ((16 * stile + li) * SD_BST + 32 * ks + 8 * g) * 2); a = MFMA16(bfr, cf[ks], a); }
#pragma unroll
                    for (int r = 0; r < 4; ++r) { const int s = 16 * stile + 4 * g + r; const int l = 16 * w + li; a[r] = (s <= l) ? a[r] * __expf(acl - ac_l[s]) : 0.f; } }
                sg[u] = a; }
            const bf16x8 pf = pack8(sg[0], sg[1]);
#pragma unroll
            for (int pt = 0; pt < 4; ++pt) {
                const LAS unsigned char* xa = x_l + ((32 * kk + 4 * g + (li >> 2)) * SD_XST + 16 * pt + 4 * (li & 3)) * 2;
                const bf16x8 xfr = cat8(tr_read(xa), tr_read(xa + 16 * SD_XST * 2));
                yd[pt] = MFMA16(xfr, pf, yd[pt]); } } }
#pragma unroll
    for (int pt = 0; pt < 4; ++pt)
#pragma unroll
        for (int ks = 0; ks < 4; ++ks) { const bf16x8 hfr = *(const LAS bf16x8*)(h_l + ((16 * pt + li) * SD_BST + 32 * ks + 8 * g) * 2); yo[pt] = MFMA16(hfr, cf[ks], yo[pt]); }
    const float eal = __expf(acl); const float dsk = p.d_skip[h]; const size_t t = t0 + 16 * w + li;
    bf16* YGB = (bf16*)(ws + WS_YG);
#pragma unroll
    for (int pt = 0; pt < 4; ++pt) { const int pc = h * 64 + 16 * pt + 4 * g;
        const u32x2 xv = *(const GAS u32x2*)(XBC + t * CONVD + pc); const u32x2 zv = *(const GAS u32x2*)(U + t * IN_PAD + O_Z + pc);
        const float xs[4] = {bflo(xv.x), bfhi(xv.x), bflo(xv.y), bfhi(xv.y)}, zs[4] = {bflo(zv.x), bfhi(zv.x), bflo(zv.y), bfhi(zv.y)}; float y[4];
#pragma unroll
        for (int r = 0; r < 4; ++r) y[r] = (yd[pt][r] + eal * yo[pt][r] + dsk * xs[r]) * siluf(zs[r]);
        u32x2 wv; wv.x = pk2(y[0], y[1]); wv.y = pk2(y[2], y[3]); *(GAS u32x2*)(YGB + t * 512 + pc) = wv; }
}

__device__ __forceinline__ void ssd_sample_unit(const Frame& F, const P& p, int b, int h) {
    unsigned char* ws = p.ws; const bf16* XBC = (const bf16*)(ws + WS_XBC); const float* DT = (const float*)(ws + WS_DT); const bf16* U = (const bf16*)(ws + WS_U);
    bf16* YGB = (bf16*)(ws + WS_YG);
    const int tid = F.tid, g2 = h >> 2; const int pp = tid >> 3, nc = (tid & 7) * 16;
    LAS float* fl = (LAS float*)(F.lds + RING_OFF);
    LAS float* Bs = fl;
    LAS float* Cs = fl + 1024;
    LAS float* Xs = fl + 2048;
    LAS float* Gs = fl + 2560;
    LAS float* ac = fl + 2624;
    LAS float* dts = fl + 2632;
    const size_t t0 = (size_t)TP + (size_t)b * 8;
    __syncthreads();
    for (int q = tid; q < 1024; q += 512) { const int l = q >> 7, n = q & 127; Bs[q] = bf2f(XBC[(t0 + l) * CONVD + 512 + g2 * 128 + n]); Cs[q] = bf2f(XBC[(t0 + l) * CONVD + 768 + g2 * 128 + n]); }
    { const int l = tid >> 6, pq = tid & 63; Xs[tid] = bf2f(XBC[(t0 + l) * CONVD + h * 64 + pq]); }
    if (tid == 0) { const float Ah = -__expf(p.a_log[h]); float s = 0.f; for (int l = 0; l < 8; ++l) { const float d = DT[(t0 + l) * 8 + h]; dts[l] = d; s += d * Ah; ac[l] = s; } }
    __syncthreads();
    { const int l = pp >> 3, s = pp & 7; float a = 0.f;
#pragma unroll
      for (int i = 0; i < 16; ++i) a += Cs[l * 128 + nc + i] * Bs[s * 128 + nc + i];
      a += __shfl_xor(a, 1); a += __shfl_xor(a, 2); a += __shfl_xor(a, 4);
      if ((tid & 7) == 0) Gs[pp] = a; }
    const float* h0p = p.state_ssm + ((size_t)(b * 8 + h) * 64 + pp) * 128 + nc; float h0[16];
#pragma unroll
    for (int i = 0; i < 4; ++i) { const f32x4 v = *(const GAS f32x4*)(h0p + 4 * i); h0[4 * i] = v[0]; h0[4 * i + 1] = v[1]; h0[4 * i + 2] = v[2]; h0[4 * i + 3] = v[3]; }
    __syncthreads();
    float yoff[8];
#pragma unroll
    for (int l = 0; l < 8; ++l) { float a = 0.f;
#pragma unroll
        for (int i = 0; i < 16; ++i) a += Cs[l * 128 + nc + i] * h0[i];
        a += __shfl_xor(a, 1); a += __shfl_xor(a, 2); a += __shfl_xor(a, 4); yoff[l] = a; }
    const float a7 = ac[7]; float hn[16]; const float e7 = __expf(a7);
#pragma unroll
    for (int i = 0; i < 16; ++i) hn[i] = e7 * h0[i];
#pragma unroll
    for (int l = 0; l < 8; ++l) { const float cf = Xs[l * 64 + pp] * dts[l] * __expf(a7 - ac[l]);
#pragma unroll
        for (int i = 0; i < 16; ++i) hn[i] += cf * Bs[l * 128 + nc + i]; }
    float* ho = p.out + OUT_SSS + ((size_t)(b * 8 + h) * 64 + pp) * 128 + nc;
#pragma unroll
    for (int i = 0; i < 4; ++i) *(GAS f32x4*)(ho + 4 * i) = (f32x4){hn[4 * i], hn[4 * i + 1], hn[4 * i + 2], hn[4 * i + 3]};
    { const int l = tid & 7; float yv = 0.f;
#pragma unroll
      for (int l2 = 0; l2 < 8; ++l2) { float yd = 0.f;
#pragma unroll
          for (int s = 0; s < 8; ++s) if (s <= l2) yd += Gs[l2 * 8 + s] * __expf(ac[l2] - ac[s]) * Xs[s * 64 + pp] * dts[s];
          const float tot = yd + __expf(ac[l2]) * yoff[l2] + p.d_skip[h] * Xs[l2 * 64 + pp];
          if (l2 == l) yv = tot; }
      const float z = bf2f(U[(t0 + l) * IN_PAD + O_Z + h * 64 + pp]);
      YGB[(t0 + l) * 512 + h * 64 + pp] = (bf16)f2bf(yv * siluf(z)); }
}

__device__ __forceinline__ void mixa_rows(const Frame& F, const P& p) {
    const bf16* OATT = (const bf16*)(p.ws + WS_OATT); const bf16* YG = (const bf16*)(p.ws + WS_YG); bf16* MIXA = (bf16*)(p.ws + WS_MIXA);
    const int lane = F.lane; const int gw = F.vcu * NWAVES + F.wave, NGW = F.G * NWAVES;
    for (int t = gw; t < TALL; t += NGW) {
        { const v4u v = *(const GAS v4u*)(OATT + (size_t)t * 512 + 8 * lane); float x[8] = {bflo(v.x), bfhi(v.x), bflo(v.y), bfhi(v.y), bflo(v.z), bfhi(v.z), bflo(v.w), bfhi(v.w)}; float ss = 0.f;
#pragma unroll
          for (int i = 0; i < 8; ++i) ss += x[i] * x[i];
          const float r = rsqrtf(wave_sum(ss) * (1.f / 512.f) + 1e-6f); const float* gn = p.attn_out_norm + 8 * lane; v4u o;
          o.x = pk2(x[0] * r * gn[0], x[1] * r * gn[1]); o.y = pk2(x[2] * r * gn[2], x[3] * r * gn[3]); o.z = pk2(x[4] * r * gn[4], x[5] * r * gn[5]); o.w = pk2(x[6] * r * gn[6], x[7] * r * gn[7]);
          *(GAS v4u*)(MIXA + (size_t)t * DM + 8 * lane) = o; }
        { const v4u v = *(const GAS v4u*)(YG + (size_t)t * 512 + 8 * lane); float x[8] = {bflo(v.x), bfhi(v.x), bflo(v.y), bfhi(v.y), bflo(v.z), bfhi(v.z), bflo(v.w), bfhi(v.w)}; float ss = 0.f;
#pragma unroll
          for (int i = 0; i < 8; ++i) ss += x[i] * x[i];
#pragma unroll
          for (int o_ = 1; o_ < 32; o_ <<= 1) ss += __shfl_xor(ss, o_);
          const float r = rsqrtf(ss * (1.f / 256.f) + 1e-6f); const float* gn = p.ssm_norm + 8 * lane; v4u o;
          o.x = pk2(x[0] * r * gn[0], x[1] * r * gn[1]); o.y = pk2(x[2] * r * gn[2], x[3] * r * gn[3]); o.z = pk2(x[4] * r * gn[4], x[5] * r * gn[5]); o.w = pk2(x[6] * r * gn[6], x[7] * r * gn[7]);
          *(GAS v4u*)(MIXA + (size_t)t * DM + 512 + 8 * lane) = o; }
    }
}

__device__ __forceinline__ void ln_rows(const Frame& F, const float* res_p, const float* res_s, const bf16* delta, const float* gam, const float* bet, float* outf, bf16* outb) {
    const int lane = F.lane; const int gw = F.vcu * NWAVES + F.wave, NGW = F.G * NWAVES;
    for (int t = gw; t < TALL; t += NGW) {
        const float* rr = t < TP ? res_p + (size_t)t * DM : res_s + (size_t)(t - TP) * DM;
        f32x4 v[4]; float s = 0.f;
#pragma unroll
        for (int j = 0; j < 4; ++j) { const f32x4 r = *(const GAS f32x4*)(rr + 256 * j + 4 * lane); const u32x2 d = *(const GAS u32x2*)(delta + (size_t)t * DM + 256 * j + 4 * lane);
            v[j] = (f32x4){DN_ALPHA * r[0] + bflo(d.x), DN_ALPHA * r[1] + bfhi(d.x), DN_ALPHA * r[2] + bflo(d.y), DN_ALPHA * r[3] + bfhi(d.y)}; s += (v[j][0] + v[j][1]) + (v[j][2] + v[j][3]); }
        const float mean = wave_sum(s) * (1.f / DM); float s2 = 0.f;
#pragma unroll
        for (int j = 0; j < 4; ++j) { v[j] = v[j] - mean; s2 += (v[j][0] * v[j][0] + v[j][1] * v[j][1]) + (v[j][2] * v[j][2] + v[j][3] * v[j][3]); }
        const float rstd = rsqrtf(wave_sum(s2) * (1.f / DM) + 1e-5f);
#pragma unroll
        for (int j = 0; j < 4; ++j) { const f32x4 gg = *(const GAS f32x4*)(gam + 256 * j + 4 * lane), bb = *(const GAS f32x4*)(bet + 256 * j + 4 * lane); const f32x4 o = v[j] * rstd * gg + bb;
            *(GAS f32x4*)(outf + (size_t)t * DM + 256 * j + 4 * lane) = o;
            if (outb) { u32x2 w; w.x = pk2(o[0], o[1]); w.y = pk2(o[2], o[3]); *(GAS u32x2*)(outb + (size_t)t * DM + 256 * j + 4 * lane) = w; } }
    }
}

constexpr int MA_ST = 264;
constexpr int MA_TILE = 64 * MA_ST * 2;
__device__ __forceinline__ void mem_attn_prompt_unit(const Frame& F, const P& p, int b, int hm, int qblk) {
    unsigned char* ws = p.ws; const bf16* QM = (const bf16*)(ws + WS_QM); const bf16* MK = (const bf16*)(ws + WS_MK); const bf16* MV = (const bf16*)(ws + WS_MV); bf16* OM = (bf16*)(ws + WS_OM);
    const int tid = F.tid, lane = F.lane, w = F.wave, li = lane & 15, g = lane >> 4;
    LAS unsigned char* kl = F.lds + RING_OFF; LAS unsigned char* vl = kl + MA_TILE;
    const size_t qrow = (size_t)b * SEQ + (size_t)qblk * 128 + 16 * w + li;
    bf16x8 qf[8];
#pragma unroll
    for (int ks = 0; ks < 8; ++ks) qf[ks] = *(const GAS bf16x8*)(QM + qrow * DM + hm * 256 + 32 * ks + 8 * g);
    f32x4 o[16];
#pragma unroll
    for (int d = 0; d < 16; ++d) o[d] = (f32x4){0.f, 0.f, 0.f, 0.f};
    float mrun = -INFINITY, lrun = 0.f;
    v4u sk[4], sv[4];
#define MA_LOAD(t) do { _Pragma("unroll") for (int i_ = 0; i_ < 4; ++i_) { const int q_ = tid + 512 * i_, row_ = q_ >> 5, c8_ = q_ & 31; const size_t off_ = ((size_t)b * NMEM + (t) * 64 + row_) * DM + hm * 256 + c8_ * 8; \
        sk[i_] = *(const GAS v4u*)(MK + off_); sv[i_] = *(const GAS v4u*)(MV + off_); } } while (0)
#define MA_STORE() do { _Pragma("unroll") for (int i_ = 0; i_ < 4; ++i_) { const int q_ = tid + 512 * i_, row_ = q_ >> 5, c8_ = q_ & 31; \
        *(LAS v4u*)(kl + (row_ * MA_ST + c8_ * 8) * 2) = sk[i_]; *(LAS v4u*)(vl + (row_ * MA_ST + c8_ * 8) * 2) = sv[i_]; } } while (0)
    MA_LOAD(0);
    for (int t = 0; t < 4; ++t) {
        __syncthreads();
        MA_STORE();
        __syncthreads();
        if (t + 1 < 4) MA_LOAD(t + 1);
        f32x4 s[4];
#pragma unroll
        for (int kt = 0; kt < 4; ++kt) { f32x4 a = (f32x4){0.f, 0.f, 0.f, 0.f};
#pragma unroll
            for (int ks = 0; ks < 8; ++ks) { const bf16x8 kf = *(const LAS bf16x8*)(kl + ((16 * kt + li) * MA_ST + 32 * ks + 8 * g) * 2); a = MFMA16(kf, qf[ks], a); }
            s[kt] = a; }
        float mx = -INFINITY;
#pragma unroll
        for (int kt = 0; kt < 4; ++kt)
#pragma unroll
            for (int r = 0; r < 4; ++r) mx = fmaxf(mx, s[kt][r]);
        mx = fmaxf(mx, __shfl_xor(mx, 16)); mx = fmaxf(mx, __shfl_xor(mx, 32));
        const float mn = fmaxf(mrun, mx); const float alpha = __builtin_amdgcn_exp2f(mrun - mn); mrun = mn;
        float ps = 0.f;
#pragma unroll
        for (int kt = 0; kt < 4; ++kt)
#pragma unroll
            for (int r = 0; r < 4; ++r) { const float e = __builtin_amdgcn_exp2f(s[kt][r] - mn); s[kt][r] = e; ps += e; }
        lrun = lrun * alpha + ps;
#pragma unroll
        for (int d = 0; d < 16; ++d) o[d] = o[d] * alpha;
        const bf16x8 pf0 = pack8(s[0], s[1]), pf1 = pack8(s[2], s[3]);
#pragma unroll
        for (int d = 0; d < 16; ++d) {
            const LAS unsigned char* va = vl + ((4 * g + (li >> 2)) * MA_ST + 16 * d + 4 * (li & 3)) * 2;
            const bf16x8 v0 = cat8(tr_read(va), tr_read(va + 16 * MA_ST * 2)); const bf16x8 v1 = cat8(tr_read(va + 32 * MA_ST * 2), tr_read(va + 48 * MA_ST * 2));
            o[d] = MFMA16(v0, pf0, o[d]); o[d] = MFMA16(v1, pf1, o[d]); }
    }
#undef MA_LOAD
#undef MA_STORE
    { float l = lrun; l += __shfl_xor(l, 16); l += __shfl_xor(l, 32); const float rl = 1.f / l; bf16* orow = OM + qrow * DM + hm * 256 + 4 * g;
#pragma unroll
      for (int d = 0; d < 16; ++d) { u32x2 wv; wv.x = pk2(o[d][0] * rl, o[d][1] * rl); wv.y = pk2(o[d][2] * rl, o[d][3] * rl); *(GAS u32x2*)(orow + 16 * d) = wv; } }
    __syncthreads();
}
__device__ __forceinline__ void mem_attn_sample_unit(const Frame& F, const P& p, int b, int hm) {
    unsigned char* ws = p.ws; const bf16* QM = (const bf16*)(ws + WS_QM); bf16* OM = (bf16*)(ws + WS_OM);
    const int tid = F.tid; LAS float* fl = (LAS float*)(F.lds + RING_OFF);
    LAS float* Qs = fl;
    LAS float* Ps = fl + 2048;
    LAS float* Rs = fl + 4096;
    __syncthreads();
    for (int q = tid; q < 2048; q += 512) { const int tk = q >> 8, d = q & 255; Qs[q] = bf2f(QM[(size_t)(TP + b * 8 + tk) * DM + hm * 256 + d]); }
    __syncthreads();
    { const int m = tid & 255, half = tid >> 8; const float* kr = p.cache_mk + (((size_t)b * NMEM + m) * MH + hm) * MHD; float acc[4] = {0.f, 0.f, 0.f, 0.f};
#pragma unroll 8
      for (int d4 = 0; d4 < 64; ++d4) { const f32x4 kv = __builtin_nontemporal_load((const GAS f32x4*)(kr + 4 * d4));
#pragma unroll
          for (int tk = 0; tk < 4; ++tk) { const LAS float* qq = Qs + (4 * half + tk) * 256 + 4 * d4; acc[tk] += kv[0] * qq[0] + kv[1] * qq[1] + kv[2] * qq[2] + kv[3] * qq[3]; } }
#pragma unroll
      for (int tk = 0; tk < 4; ++tk) Ps[(4 * half + tk) * 256 + m] = acc[tk]; }
    __syncthreads();
    { const int w = F.wave, lane = F.lane; float v[4]; float mx = -INFINITY;
#pragma unroll
      for (int i = 0; i < 4; ++i) { v[i] = Ps[w * 256 + lane + 64 * i]; mx = fmaxf(mx, v[i]); }
#pragma unroll
      for (int o_ = 1; o_ < 64; o_ <<= 1) mx = fmaxf(mx, __shfl_xor(mx, o_));
      float s = 0.f;
#pragma unroll
      for (int i = 0; i < 4; ++i) { v[i] = __builtin_amdgcn_exp2f(v[i] - mx); s += v[i]; Ps[w * 256 + lane + 64 * i] = v[i]; }
      s = wave_sum(s); if (lane == 0) Rs[w] = 1.f / s; }
    __syncthreads();
    { const int dv = tid & 255, half = tid >> 8; const float* vr = p.cache_mv + ((size_t)b * NMEM * MH + hm) * MHD + dv; float acc[4] = {0.f, 0.f, 0.f, 0.f};
#pragma unroll 8
      for (int m = 0; m < NMEM; ++m) { const float vv = __builtin_nontemporal_load(vr + (size_t)m * (MH * MHD));
#pragma unroll
          for (int tk = 0; tk < 4; ++tk) acc[tk] += Ps[(4 * half + tk) * 256 + m] * vv; }
#pragma unroll
      for (int tk = 0; tk < 4; ++tk) OM[(size_t)(TP + b * 8 + 4 * half + tk) * DM + hm * 256 + dv] = (bf16)f2bf(acc[tk] * Rs[4 * half + tk]); }
}

__device__ __forceinline__ void peer_scores_unit(const Frame& F, const P& p, int tb, int gg) {
    unsigned char* ws = p.ws; const bf16* PQ = (const bf16*)(ws + WS_PQ); const bf16* KEYS = (const bf16*)(ws + WS_PKEYS); float* TOPS = (float*)(ws + WS_PTOPS);
    const int lane = F.lane, w = F.wave, li = lane & 15, g = lane >> 4;
    bf16x8 tf[2][4];
#pragma unroll
    for (int j = 0; j < 2; ++j)
#pragma unroll
        for (int ks = 0; ks < 4; ++ks) tf[j][ks] = *(const GAS bf16x8*)(PQ + (size_t)(tb * 256 + 32 * w + 16 * j + li) * 2048 + gg * 128 + 32 * ks + 8 * g);
    f32x4 s[2][8];
#pragma unroll
    for (int kt = 0; kt < 8; ++kt) { bf16x8 kf[4];
#pragma unroll
        for (int ks = 0; ks < 4; ++ks) kf[ks] = *(const GAS bf16x8*)(KEYS + ((size_t)gg * 128 + 16 * kt + li) * 128 + 32 * ks + 8 * g);
#pragma unroll
        for (int j = 0; j < 2; ++j) { f32x4 a = (f32x4){0.f, 0.f, 0.f, 0.f};
#pragma unroll
            for (int ks = 0; ks < 4; ++ks) a = MFMA16(kf[ks], tf[j][ks], a);
            s[j][kt] = a; } }
#pragma unroll
    for (int j = 0; j < 2; ++j) {
        float top[16];
#pragma unroll
        for (int i = 0; i < 16; ++i) top[i] = -INFINITY;
#pragma unroll
        for (int kt = 0; kt < 8; ++kt)
#pragma unroll
            for (int r = 0; r < 4; ++r) { float cv = __uint_as_float((__float_as_uint(s[j][kt][r]) & ~127u) | (unsigned)(16 * kt + 4 * g + r));
#pragma unroll
                for (int i = 0; i < 16; ++i) { const float hi_ = fmaxf(top[i], cv), lo_ = fminf(top[i], cv); top[i] = hi_; cv = lo_; } }
#pragma unroll
        for (int off = 16; off <= 32; off <<= 1) {
            float c[16];
#pragma unroll
            for (int i = 0; i < 16; ++i) c[i] = fmaxf(top[i], __shfl_xor(top[15 - i], off));
#pragma unroll
            for (int d = 8; d >= 1; d >>= 1)
#pragma unroll
                for (int i = 0; i < 16; ++i) if ((i & d) == 0) { const float hi_ = fmaxf(c[i], c[i + d]), lo_ = fminf(c[i], c[i + d]); c[i] = hi_; c[i + d] = lo_; }
#pragma unroll
            for (int i = 0; i < 16; ++i) top[i] = c[i]; }
        float* to = TOPS + ((size_t)(tb * 256 + 32 * w + 16 * j + li) * 16 + gg) * 16;
        *(GAS f32x4*)(to + 4 * g) = (f32x4){g == 0 ? top[0] : g == 1 ? top[4] : g == 2 ? top[8] : top[12], g == 0 ? top[1] : g == 1 ? top[5] : g == 2 ? top[9] : top[13],
                                            g == 0 ? top[2] : g == 1 ? top[6] : g == 2 ? top[10] : top[14], g == 0 ? top[3] : g == 1 ? top[7] : g == 2 ? top[11] : top[15]};
    }
}
__device__ __forceinline__ void peer_cand(const Frame& F, const P& p) {
    const float* TOPS = (const float*)(p.ws + WS_PTOPS); int* PIDX = (int*)(p.ws + WS_PIDX); float* PG = (float*)(p.ws + WS_PG);
    const size_t gt = (size_t)F.vcu * NTHR + F.tid, NGT = (size_t)F.G * NTHR;
    for (size_t it = gt; it < (size_t)TALL * PH; it += NGT) {
        const float* ta = TOPS + it * 32; const float* tb_ = ta + 16;
        float val[16]; int idx[16];
#pragma unroll
        for (int i = 0; i < 16; ++i) { val[i] = -INFINITY; idx[i] = 0; }
        for (int i = 0; i < 16; ++i) { const unsigned ua = __float_as_uint(ta[i]); const float va = __uint_as_float(ua & ~127u); const int ia = (int)(ua & 127u); const int nj = 16 / (i + 1);
            for (int j = 0; j < nj; ++j) { const unsigned ub = __float_as_uint(tb_[j]); float cv = va + __uint_as_float(ub & ~127u); int ci = ia * NKEYS + (int)(ub & 127u);
#pragma unroll
                for (int k = 0; k < 16; ++k) { const bool gt_ = cv > val[k]; const float nv = gt_ ? cv : val[k]; const float nc = gt_ ? val[k] : cv; const int ni = gt_ ? ci : idx[k]; const int nci = gt_ ? idx[k] : ci;
                    val[k] = nv; cv = nc; idx[k] = ni; ci = nci; } } }
        float s = 0.f; float e[16];
#pragma unroll
        for (int k = 0; k < 16; ++k) { e[k] = __expf(val[k] - val[0]); s += e[k]; }
        const float rs = 1.f / s;
#pragma unroll
        for (int k = 0; k < 16; ++k) { PIDX[it * 16 + k] = idx[k]; PG[it * 16 + k] = e[k] * rs; }
    }
}
typedef float f32x2 __attribute__((ext_vector_type(2)));
__device__ __forceinline__ void peer_gather(const Frame& F, const P& p) {
    unsigned char* ws = p.ws; const bf16* H2B = (const bf16*)(ws + WS_H2B); const float* H2 = (const float*)(ws + WS_H2); const unsigned char* PU8 = ws + WS_PU; const unsigned char* PV8 = ws + WS_PV;
    const int* PIDX = (const int*)(ws + WS_PIDX); const float* PG = (const float*)(ws + WS_PG);
    const int lane = F.lane, sub = lane & 15, rs = lane >> 4; const int gw = F.vcu * NWAVES + F.wave, NGW = F.G * NWAVES;
    LAS int* widx = (LAS int*)(F.lds + RING_OFF) + F.wave * 384; LAS float* wg = (LAS float*)(widx + 128); LAS float* ww = wg + 128;
    for (int t = gw; t < TALL; t += NGW) {
        widx[lane] = PIDX[(size_t)t * 128 + lane]; widx[lane + 64] = PIDX[(size_t)t * 128 + lane + 64]; wg[lane] = PG[(size_t)t * 128 + lane]; wg[lane + 64] = PG[(size_t)t * 128 + lane + 64];
        f32x2 x[32];
#pragma unroll
        for (int c = 0; c < 4; ++c) { const v4u a = *(const GAS v4u*)(H2B + (size_t)t * DM + 256 * c + 16 * sub), b = *(const GAS v4u*)(H2B + (size_t)t * DM + 256 * c + 16 * sub + 8);
            x[8 * c + 0] = (f32x2){bflo(a.x), bfhi(a.x)}; x[8 * c + 1] = (f32x2){bflo(a.y), bfhi(a.y)}; x[8 * c + 2] = (f32x2){bflo(a.z), bfhi(a.z)}; x[8 * c + 3] = (f32x2){bflo(a.w), bfhi(a.w)};
            x[8 * c + 4] = (f32x2){bflo(b.x), bfhi(b.x)}; x[8 * c + 5] = (f32x2){bflo(b.y), bfhi(b.y)}; x[8 * c + 6] = (f32x2){bflo(b.z), bfhi(b.z)}; x[8 * c + 7] = (f32x2){bflo(b.w), bfhi(b.w)}; }
        LDS_WAIT(); asm volatile("" ::: "memory");
#pragma unroll 4
        for (int it = 0; it < 32; ++it) { const int k = 4 * it + rs; const int e = widx[k]; const unsigned char* ur = PU8 + (size_t)e * DM + 16 * sub;
            v4u uv[4];
#pragma unroll
            for (int c = 0; c < 4; ++c) uv[c] = *(const GAS v4u*)(ur + 256 * c);
            f32x2 a2 = (f32x2){0.f, 0.f};
#pragma unroll
            for (int c = 0; c < 4; ++c) {
                a2 = __builtin_amdgcn_cvt_pk_f32_fp8((int)uv[c].x, false) * x[8 * c + 0] + a2; a2 = __builtin_amdgcn_cvt_pk_f32_fp8((int)uv[c].x, true) * x[8 * c + 1] + a2;
                a2 = __builtin_amdgcn_cvt_pk_f32_fp8((int)uv[c].y, false) * x[8 * c + 2] + a2; a2 = __builtin_amdgcn_cvt_pk_f32_fp8((int)uv[c].y, true) * x[8 * c + 3] + a2;
                a2 = __builtin_amdgcn_cvt_pk_f32_fp8((int)uv[c].z, false) * x[8 * c + 4] + a2; a2 = __builtin_amdgcn_cvt_pk_f32_fp8((int)uv[c].z, true) * x[8 * c + 5] + a2;
                a2 = __builtin_amdgcn_cvt_pk_f32_fp8((int)uv[c].w, false) * x[8 * c + 6] + a2; a2 = __builtin_amdgcn_cvt_pk_f32_fp8((int)uv[c].w, true) * x[8 * c + 7] + a2; }
            float a = a2.x + a2.y;
            a += __shfl_xor(a, 1); a += __shfl_xor(a, 2); a += __shfl_xor(a, 4); a += __shfl_xor(a, 8);
            a *= (1.f / PU_SCALE);
            const float act = 0.5f * a * (1.f + erff(a * 0.70710678118654752f));
            if (sub == 0) ww[k] = wg[k] * act * (1.f / PV_SCALE); }
        LDS_WAIT(); asm volatile("" ::: "memory");
        f32x2 acc[32];
#pragma unroll
        for (int i = 0; i < 32; ++i) acc[i] = (f32x2){0.f, 0.f};
#pragma unroll 4
        for (int it = 0; it < 32; ++it) { const int k = 4 * it + rs; const int e = widx[k]; const unsigned char* vr = PV8 + (size_t)e * DM + 16 * sub; const float wk = ww[k]; const f32x2 w2 = (f32x2){wk, wk};
            v4u vv[4];
#pragma unroll
            for (int c = 0; c < 4; ++c) vv[c] = *(const GAS v4u*)(vr + 256 * c);
#pragma unroll
            for (int c = 0; c < 4; ++c) {
                acc[8 * c + 0] = __builtin_amdgcn_cvt_pk_f32_fp8((int)vv[c].x, false) * w2 + acc[8 * c + 0]; acc[8 * c + 1] = __builtin_amdgcn_cvt_pk_f32_fp8((int)vv[c].x, true) * w2 + acc[8 * c + 1];
                acc[8 * c + 2] = __builtin_amdgcn_cvt_pk_f32_fp8((int)vv[c].y, false) * w2 + acc[8 * c + 2]; acc[8 * c + 3] = __builtin_amdgcn_cvt_pk_f32_fp8((int)vv[c].y, true) * w2 + acc[8 * c + 3];
                acc[8 * c + 4] = __builtin_amdgcn_cvt_pk_f32_fp8((int)vv[c].z, false) * w2 + acc[8 * c + 4]; acc[8 * c + 5] = __builtin_amdgcn_cvt_pk_f32_fp8((int)vv[c].z, true) * w2 + acc[8 * c + 5];
                acc[8 * c + 6] = __builtin_amdgcn_cvt_pk_f32_fp8((int)vv[c].w, false) * w2 + acc[8 * c + 6]; acc[8 * c + 7] = __builtin_amdgcn_cvt_pk_f32_fp8((int)vv[c].w, true) * w2 + acc[8 * c + 7]; } }
#pragma unroll
        for (int i = 0; i < 32; ++i) { acc[i].x += __shfl_xor(acc[i].x, 16); acc[i].y += __shfl_xor(acc[i].y, 16); acc[i].x += __shfl_xor(acc[i].x, 32); acc[i].y += __shfl_xor(acc[i].y, 32); }
        LDS_WAIT(); asm volatile("" ::: "memory");
        float v[16]; float s = 0.f;
#pragma unroll
        for (int j = 0; j < 8; ++j) { const f32x2 a = rs == 0 ? acc[j] : rs == 1 ? acc[8 + j] : rs == 2 ? acc[16 + j] : acc[24 + j]; v[2 * j] = a.x; v[2 * j + 1] = a.y; }
        const int e0 = 256 * rs + 16 * sub;
#pragma unroll
        for (int q = 0; q < 4; ++q) { const f32x4 r = *(const GAS f32x4*)(H2 + (size_t)t * DM + e0 + 4 * q); v[4 * q] += DN_ALPHA * r[0]; v[4 * q + 1] += DN_ALPHA * r[1]; v[4 * q + 2] += DN_ALPHA * r[2]; v[4 * q + 3] += DN_ALPHA * r[3]; }
#pragma unroll
        for (int i = 0; i < 16; ++i) s += v[i];
        const float mean = wave_sum(s) * (1.f / DM); float s2 = 0.f;
#pragma unroll
        for (int i = 0; i < 16; ++i) { v[i] -= mean; s2 += v[i] * v[i]; }
        const float rstd = rsqrtf(wave_sum(s2) * (1.f / DM) + 1e-5f);
        float* yo = p.out + OUT_YP + (size_t)t * DM + e0;
#pragma unroll
        for (int q = 0; q < 4; ++q) { const f32x4 gq = *(const GAS f32x4*)(p.ln3_g + e0 + 4 * q), bq = *(const GAS f32x4*)(p.ln3_b + e0 + 4 * q);
            *(GAS f32x4*)(yo + 4 * q) = (f32x4){v[4 * q] * rstd * gq[0] + bq[0], v[4 * q + 1] * rstd * gq[1] + bq[1], v[4 * q + 2] * rstd * gq[2] + bq[2], v[4 * q + 3] * rstd * gq[3] + bq[3]}; }
    }
}

#if MK_DIAG
__constant__ int DG_TL[24] = {0, 1, 2, 3, 15, 16, 17, 31, 32, 33, 63, 64, 65, 127, 128, 129, 255, 256, 257, 511, 512, 4095, 4096, 8191};
constexpr int NCHK = 24;
__device__ __forceinline__ unsigned dh(unsigned i, unsigned k) { unsigned x = i * 2654435761u + k * 40503u + 12345u; x ^= x >> 15; x *= 2246822519u; x ^= x >> 13; return x; }
struct DAcc { float d2, r2; };
__device__ __forceinline__ void dacc(DAcc& a, float fast, float ref) { float e = fast - ref; if (!(e == e) || !(fabsf(e) < 1e18f)) e = 1e18f; a.d2 += e * e; a.r2 += ref * ref; }
__device__ __forceinline__ void dflush(const Frame& F, int k, DAcc a) { const float d = wave_sum(a.d2), r = wave_sum(a.r2); if (F.lane == 0) { float* dg = (float*)(F.ctl + CW_DIAG) + 2 * k; atomicAdd(dg, d); atomicAdd(dg + 1, r); } }
__device__ __forceinline__ float xin(const P& p, int t, int k) { return t < TP ? p.x_prompt[(size_t)t * DM + k] : p.x_sample[(size_t)(t - TP) * DM + k]; }
__device__ __forceinline__ float gelu_ref(float a) { return 0.5f * a * (1.f + erff(a * 0.70710678118654752f)); }

__device__ __forceinline__ void diag_phase(const Frame& F, const P& p, const XcdBarrier& bar) {
    unsigned char* ws = p.ws; const int lane = F.lane; const int gw = F.vcu * NWAVES + F.wave, NGW = F.G * NWAVES;
    const bf16* U = (const bf16*)(ws + WS_U); const bf16* CQN = (const bf16*)(ws + WS_CQN); const bf16* CKV = (const bf16*)(ws + WS_CKV); const bf16* KR = (const bf16*)(ws + WS_KR);
    const bf16* XBC = (const bf16*)(ws + WS_XBC); const float* DT = (const float*)(ws + WS_DT); const bf16* Q = (const bf16*)(ws + WS_Q); const bf16* KNV = (const bf16*)(ws + WS_KNV);
    const bf16* QLAT = (const bf16*)(ws + WS_QLAT); const bf16* OATT = (const bf16*)(ws + WS_OATT); const bf16* OLAT = (const bf16*)(ws + WS_OLAT); const bf16* HPREV = (const bf16*)(ws + WS_HPREV);
    const bf16* YG = (const bf16*)(ws + WS_YG); const bf16* MIXA = (const bf16*)(ws + WS_MIXA); const bf16* MIX = (const bf16*)(ws + WS_MIX); const float* H1 = (const float*)(ws + WS_H1);
    const bf16* H1B = (const bf16*)(ws + WS_H1B); const bf16* QM = (const bf16*)(ws + WS_QM); const bf16* MK = (const bf16*)(ws + WS_MK); const bf16* MV = (const bf16*)(ws + WS_MV);
    const bf16* OM = (const bf16*)(ws + WS_OM); const bf16* MIX2 = (const bf16*)(ws + WS_MIX2); const float* H2 = (const float*)(ws + WS_H2); const bf16* H2B = (const bf16*)(ws + WS_H2B);
    const bf16* PQ = (const bf16*)(ws + WS_PQ); const float* TOPS = (const float*)(ws + WS_PTOPS); const int* PIDX = (const int*)(ws + WS_PIDX); const float* PG = (const float*)(ws + WS_PG);
    LAS float* wl = (LAS float*)(F.lds + RING_OFF) + F.wave * 4096;
    const float QSC = MLA_SCALE * LOG2E;
    { DAcc a{0.f, 0.f};
      for (int it = gw; it < 512; it += NGW) { const int t = dh(it, 1) % TALL, n = dh(it, 2) % IN_DIM; float s = 0.f;
          for (int j = 0; j < 16; ++j) { const int k = lane + 64 * j; s += xin(p, t, k) * p.w_in[(size_t)k * IN_DIM + n]; }
          s = wave_sum(s); if (lane == 0) dacc(a, bf2f(U[(size_t)t * IN_PAD + n]), s); }
      dflush(F, 1, a); }
    { DAcc a{0.f, 0.f};
      for (int it = gw; it < 96; it += NGW) { int t;
          if (it < 8) t = it; else if (it < 16) t = SEQ + (it - 8); else if (it < 20) t = SEQ - 4 + (it - 16); else if (it < 24) t = TP - 4 + (it - 20); else if (it < 40) t = TP + 8 * (dh(it, 3) % DBATCH) + ((it - 24) & 7); else t = dh(it, 4) % TALL;
          const bool smp = t >= TP; const int ts = t - TP; const int tl = smp ? (ts & 7) : (t & (SEQ - 1)); const int pos = smp ? PAST + tl : tl; const bf16* ur = U + (size_t)t * IN_PAD;
          { float v[6]; float ss = 0.f; for (int i = 0; i < 6; ++i) { v[i] = bf2f(ur[O_CQ + lane + 64 * i]); ss += v[i] * v[i]; } const float r = rsqrtf(wave_sum(ss) / 384.f + 1e-6f);
            for (int i = 0; i < 6; ++i) dacc(a, bf2f(CQN[(size_t)t * QLORA + lane + 64 * i]), v[i] * r * p.q_a_norm[lane + 64 * i]); }
          { float v[4]; float ss = 0.f; for (int i = 0; i < 4; ++i) { v[i] = bf2f(ur[O_CKV + lane + 64 * i]); ss += v[i] * v[i]; } const float r = rsqrtf(wave_sum(ss) / 256.f + 1e-6f);
            const float* of = smp ? p.out + OUT_KVS + (size_t)ts * KVLORA : p.out + OUT_KVP + (size_t)t * KVLORA;
            for (int i = 0; i < 4; ++i) { const float rf = v[i] * r * p.kv_a_norm[lane + 64 * i]; dacc(a, bf2f(CKV[(size_t)t * KVLORA + lane + 64 * i]), rf); dacc(a, of[lane + 64 * i], rf); } }
          if (lane < 32) { const int i = lane & 15; const float x1 = bf2f(ur[O_KPE + i]), x2 = bf2f(ur[O_KPE + 16 + i]); const float ang = (float)pos * powf(10000.f, -(float)i / 16.f); const float c = cosf(ang), s = sinf(ang);
            const float rf = lane < 16 ? x1 * c - x2 * s : x2 * c + x1 * s; const float* of = smp ? p.out + OUT_KRS + (size_t)ts * ROPE : p.out + OUT_KRP + (size_t)t * ROPE;
            dacc(a, bf2f(KR[(size_t)t * ROPE + lane]), rf); dacc(a, of[lane], rf); }
          if (lane < 8) { const float raw = bf2f(ur[O_DT + lane]) + p.dt_bias[lane]; dacc(a, DT[(size_t)t * 8 + lane], log1pf(expf(raw))); }
          for (int i = 0; i < 16; ++i) { const int c = lane + 64 * i; float acc = p.conv_b[c];
              for (int k = 0; k < 4; ++k) { const int f = tl + k; float x; if (f >= 3) x = bf2f(U[(size_t)(t + k - 3) * IN_PAD + O_XBC + c]); else x = smp ? p.state_conv[((size_t)(ts >> 3) * 3 + f) * CONVD + c] : 0.f; acc += p.conv_w[k * CONVD + c] * x; }
              dacc(a, bf2f(XBC[(size_t)t * CONVD + c]), acc / (1.f + expf(-acc)));
              if (!smp && tl >= SEQ - 3) dacc(a, p.out[OUT_CVP + ((size_t)(t >> 13) * 3 + (tl - (SEQ - 3))) * CONVD + c], bf2f(ur[O_XBC + c]));
              if (smp && tl >= DSEQ - 3) dacc(a, p.out[OUT_CVS + ((size_t)(ts >> 3) * 3 + (tl - (DSEQ - 3))) * CONVD + c], bf2f(ur[O_XBC + c])); } }
      dflush(F, 2, a); }
    { DAcc a{0.f, 0.f};
      for (int it = gw; it < 512; it += NGW) { const int t = dh(it, 5) % TALL, c = dh(it, 6) % 768; float s = 0.f;
          for (int j = 0; j < 6; ++j) { const int k = lane + 64 * j; s += bf2f(CQN[(size_t)t * QLORA + k]) * p.w_uq[(size_t)k * 768 + c]; }
          s = wave_sum(s) * QSC; if (lane == 0) dacc(a, bf2f(Q[(size_t)t * 768 + c]), s); }
      dflush(F, 3, a); }
    { DAcc a{0.f, 0.f};
      for (int it = gw; it < 512; it += NGW) { const int t = dh(it, 7) % TP, c = dh(it, 8) % 1024; float s = 0.f;
          for (int j = 0; j < 4; ++j) { const int k = lane + 64 * j; s += bf2f(CKV[(size_t)t * KVLORA + k]) * (c < 512 ? p.w_uk[(size_t)k * 512 + c] : p.w_uv[(size_t)k * 512 + c - 512]); }
          s = wave_sum(s); if (lane == 0) dacc(a, bf2f(KNV[(size_t)t * 1024 + c]), s); }
      dflush(F, 4, a); }
    { DAcc a{0.f, 0.f};
      for (int it = gw; it < 512; it += NGW) { const int ts = dh(it, 9) % TS, n = dh(it, 10) % 2048, h = n >> 8, c = n & 255;
          float s = bf2f(Q[(size_t)(TP + ts) * 768 + h * 96 + lane]) * p.w_uk[(size_t)c * 512 + h * 64 + lane];
          s = wave_sum(s); if (lane == 0) dacc(a, bf2f(QLAT[(size_t)ts * 2048 + n]), s); }
      dflush(F, 5, a); }
    { DAcc a{0.f, 0.f};
      for (int it = gw; it < 48; it += NGW) { const int b = it & 1, h = dh(it, 11) & 7, tl = DG_TL[it >> 1]; const size_t rb = (size_t)b * SEQ;
          LDS_WAIT(); asm volatile("" ::: "memory");
          { const bf16* qr = Q + (rb + tl) * 768 + h * 96; wl[lane] = bf2f(qr[lane]);
            if (lane < 16) { const float x1 = bf2f(qr[64 + lane]), x2 = bf2f(qr[80 + lane]); const float ang = (float)tl * powf(10000.f, -(float)lane / 16.f); const float c = cosf(ang), s = sinf(ang); wl[64 + lane] = x1 * c - x2 * s; wl[80 + lane] = x2 * c + x1 * s; } }
          LDS_WAIT(); asm volatile("" ::: "memory");
          float mx = -INFINITY;
          for (int j = lane; j <= tl; j += 64) { float s = 0.f; const bf16* kn = KNV + (rb + j) * 1024 + h * 64; const bf16* kr = KR + (rb + j) * ROPE;
              for (int d = 0; d < 64; ++d) s += wl[d] * bf2f(kn[d]); for (int r = 0; r < 32; ++r) s += wl[64 + r] * bf2f(kr[r]); mx = fmaxf(mx, s); }
          for (int o_ = 1; o_ < 64; o_ <<= 1) mx = fmaxf(mx, __shfl_xor(mx, o_));
          float l = 0.f, o[8] = {0.f, 0.f, 0.f, 0.f, 0.f, 0.f, 0.f, 0.f}; const int dv0 = it & 7;
          for (int j = lane; j <= tl; j += 64) { float s = 0.f; const bf16* kn = KNV + (rb + j) * 1024 + h * 64; const bf16* kr = KR + (rb + j) * ROPE;
              for (int d = 0; d < 64; ++d) s += wl[d] * bf2f(kn[d]); for (int r = 0; r < 32; ++r) s += wl[64 + r] * bf2f(kr[r]);
              const float pj = exp2f(s - mx); l += pj; for (int i = 0; i < 8; ++i) o[i] += pj * bf2f(kn[512 + 8 * i + dv0]); }
          l = wave_sum(l); for (int i = 0; i < 8; ++i) { const float ov = wave_sum(o[i]) / l; if (lane == 0) dacc(a, bf2f(OATT[(rb + tl) * 512 + h * 64 + 8 * i + dv0]), ov); } }
      dflush(F, 6, a); }
    { DAcc a{0.f, 0.f};
      for (int it = gw; it < 32; it += NGW) { const int b = dh(it, 12) % DBATCH, tk = it & 7, h = dh(it, 13) & 7; const int trow = TP + b * 8 + tk;
          LDS_WAIT(); asm volatile("" ::: "memory");
          for (int i = 0; i < 4; ++i) wl[lane + 64 * i] = bf2f(QLAT[(size_t)(b * 8 + tk) * 2048 + h * 256 + lane + 64 * i]);
          if (lane < 16) { const bf16* qr = Q + (size_t)trow * 768 + h * 96; const float x1 = bf2f(qr[64 + lane]), x2 = bf2f(qr[80 + lane]); const float ang = (float)(PAST + tk) * powf(10000.f, -(float)lane / 16.f); const float c = cosf(ang), s = sinf(ang);
              wl[256 + lane] = x1 * c - x2 * s; wl[272 + lane] = x2 * c + x1 * s; }
          LDS_WAIT(); asm volatile("" ::: "memory");
          const int nk = PAST + tk + 1; const int c0 = dh(it, 14) & 63; float mx = -INFINITY, l = 0.f, o[4] = {0.f, 0.f, 0.f, 0.f};
          for (int pass = 0; pass < 2; ++pass) {
              for (int j = lane; j < nk; j += 64) { float s = 0.f; float cv[4];
                  if (j < PAST) { const int pg = p.page_table[b * NPAGES + (j >> 7)]; const float* cp = p.cache_c + ((size_t)pg * PAGE + (j & 127)) * KVLORA; const float* rp = p.cache_r + ((size_t)pg * PAGE + (j & 127)) * ROPE;
                      for (int c = 0; c < 256; ++c) s += wl[c] * cp[c]; for (int r = 0; r < 32; ++r) s += wl[256 + r] * rp[r]; for (int i = 0; i < 4; ++i) cv[i] = cp[c0 + 64 * i]; }
                  else { const int jn = j - PAST; const bf16* cp = CKV + (size_t)(TP + b * 8 + jn) * KVLORA; const bf16* rp = KR + (size_t)(TP + b * 8 + jn) * ROPE;
                      for (int c = 0; c < 256; ++c) s += wl[c] * bf2f(cp[c]); for (int r = 0; r < 32; ++r) s += wl[256 + r] * bf2f(rp[r]); for (int i = 0; i < 4; ++i) cv[i] = bf2f(cp[c0 + 64 * i]); }
                  if (pass == 0) mx = fmaxf(mx, s); else { const float pj = exp2f(s - mx); l += pj; for (int i = 0; i < 4; ++i) o[i] += pj * cv[i]; } }
              if (pass == 0) for (int o_ = 1; o_ < 64; o_ <<= 1) mx = fmaxf(mx, __shfl_xor(mx, o_)); }
          l = wave_sum(l); for (int i = 0; i < 4; ++i) { const float ov = wave_sum(o[i]) / l; if (lane == 0) dacc(a, bf2f(OLAT[(size_t)(b * 8 + tk) * 2048 + h * 256 + c0 + 64 * i]), ov); } }
      dflush(F, 7, a); }
    { DAcc a{0.f, 0.f};
      for (int it = gw; it < 256; it += NGW) { const int ts = dh(it, 15) % TS, n = dh(it, 16) % 512, h = n >> 6; float s = 0.f;
          for (int j = 0; j < 4; ++j) { const int c = lane + 64 * j; s += bf2f(OLAT[(size_t)ts * 2048 + h * 256 + c]) * p.w_uv[(size_t)c * 512 + n]; }
          s = wave_sum(s); if (lane == 0) dacc(a, bf2f(OATT[(size_t)(TP + ts) * 512 + n]), s); }
      dflush(F, 8, a); }
    { DAcc a9{0.f, 0.f}, a10{0.f, 0.f};
      for (int it = gw; it < 16; it += NGW) { const int b = it & 1, h = (it >> 1) & 7, pch = dh(it, 17) & 63, g2 = h >> 2; const float Ah = -expf(p.a_log[h]); const float dsk = p.d_skip[h];
          float h0 = 0.f, h1 = 0.f;
          for (int tl = 0; tl < SEQ; ++tl) { const size_t t = (size_t)b * SEQ + tl;
              if ((tl & 127) == 0) { const bf16* hp = HPREV + ((size_t)((b * NCHUNK + (tl >> 7)) * 8 + h) * 64 + pch) * 128; dacc(a9, bf2f(hp[lane]), h0); dacc(a9, bf2f(hp[lane + 64]), h1); }
              const float dt = DT[t * 8 + h]; const float x = bf2f(XBC[t * CONVD + h * 64 + pch]); const bf16* bp = XBC + t * CONVD + 512 + g2 * 128; const bf16* cp = XBC + t * CONVD + 768 + g2 * 128;
              const float dec = expf(dt * Ah); h0 = dec * h0 + x * dt * bf2f(bp[lane]); h1 = dec * h1 + x * dt * bf2f(bp[lane + 64]);
              float y = wave_sum(h0 * bf2f(cp[lane]) + h1 * bf2f(cp[lane + 64])) + dsk * x; const float z = bf2f(U[t * IN_PAD + O_Z + h * 64 + pch]); y = y * (z / (1.f + expf(-z)));
              if (lane == 0) dacc(a10, bf2f(YG[t * 512 + h * 64 + pch]), y); }
          const float* ho = p.out + OUT_SSP + ((size_t)(b * 8 + h) * 64 + pch) * 128; dacc(a9, ho[lane], h0); dacc(a9, ho[lane + 64], h1); }
      dflush(F, 9, a9); dflush(F, 10, a10); }
    { DAcc a{0.f, 0.f};
      for (int it = gw; it < 64; it += NGW) { const int b = dh(it, 18) % DBATCH, h = it & 7, pch = dh(it, 19) & 63, g2 = h >> 2; const float Ah = -expf(p.a_log[h]); const float dsk = p.d_skip[h];
          const float* hs = p.state_ssm + ((size_t)(b * 8 + h) * 64 + pch) * 128; float h0 = hs[lane], h1 = hs[lane + 64];
          for (int l = 0; l < 8; ++l) { const size_t t = (size_t)TP + b * 8 + l; const float dt = DT[t * 8 + h]; const float x = bf2f(XBC[t * CONVD + h * 64 + pch]); const bf16* bp = XBC + t * CONVD + 512 + g2 * 128; const bf16* cp = XBC + t * CONVD + 768 + g2 * 128;
              const float dec = expf(dt * Ah); h0 = dec * h0 + x * dt * bf2f(bp[lane]); h1 = dec * h1 + x * dt * bf2f(bp[lane + 64]);
              float y = wave_sum(h0 * bf2f(cp[lane]) + h1 * bf2f(cp[lane + 64])) + dsk * x; const float z = bf2f(U[t * IN_PAD + O_Z + h * 64 + pch]); y = y * (z / (1.f + expf(-z)));
              if (lane == 0) dacc(a, bf2f(YG[t * 512 + h * 64 + pch]), y); }
          const float* ho = p.out + OUT_SSS + ((size_t)(b * 8 + h) * 64 + pch) * 128; dacc(a, ho[lane], h0); dacc(a, ho[lane + 64], h1); }
      dflush(F, 11, a); }
    { DAcc a{0.f, 0.f};
      for (int it = gw; it < 64; it += NGW) { const int t = (it < 16) ? TP + (dh(it, 20) % TS) : dh(it, 21) % TALL;
          { float v[8]; float ss = 0.f; for (int i = 0; i < 8; ++i) { v[i] = bf2f(OATT[(size_t)t * 512 + lane + 64 * i]); ss += v[i] * v[i]; } const float r = rsqrtf(wave_sum(ss) / 512.f + 1e-6f);
            for (int i = 0; i < 8; ++i) dacc(a, bf2f(MIXA[(size_t)t * DM + lane + 64 * i]), v[i] * r * p.attn_out_norm[lane + 64 * i]); }
          for (int gi = 0; gi < 2; ++gi) { float v[4]; float ss = 0.f; for (int i = 0; i < 4; ++i) { v[i] = bf2f(YG[(size_t)t * 512 + gi * 256 + lane + 64 * i]); ss += v[i] * v[i]; } const float r = rsqrtf(wave_sum(ss) / 256.f + 1e-6f);
            for (int i = 0; i < 4; ++i) dacc(a, bf2f(MIXA[(size_t)t * DM + 512 + gi * 256 + lane + 64 * i]), v[i] * r * p.ssm_norm[gi * 256 + lane + 64 * i]); } }
      dflush(F, 12, a); }
    { DAcc a{0.f, 0.f}, b15{0.f, 0.f}, b18{0.f, 0.f}, b20{0.f, 0.f};
      for (int it = gw; it < 512; it += NGW) { const int t = dh(it, 22) % TALL, n = dh(it, 23) % DM, n2 = dh(it, 24) % 2048; float s = 0.f, s15 = 0.f, s18 = 0.f, s20 = 0.f;
          for (int j = 0; j < 16; ++j) { const int k = lane + 64 * j; s += bf2f(MIXA[(size_t)t * DM + k]) * p.w_out[(size_t)k * DM + n]; s15 += bf2f(H1B[(size_t)t * DM + k]) * p.mem_wq[(size_t)k * DM + n];
              s18 += bf2f(OM[(size_t)t * DM + k]) * p.mem_wo[(size_t)k * DM + n]; s20 += bf2f(H2B[(size_t)t * DM + k]) * p.peer_wq[(size_t)k * 2048 + n2]; }
          s = wave_sum(s); s15 = wave_sum(s15) * 0.0625f * LOG2E; s18 = wave_sum(s18); s20 = wave_sum(s20);
          if (lane == 0) { dacc(a, bf2f(MIX[(size_t)t * DM + n]), s); dacc(b15, bf2f(QM[(size_t)t * DM + n]), s15); dacc(b18, bf2f(MIX2[(size_t)t * DM + n]), s18); dacc(b20, bf2f(PQ[(size_t)t * 2048 + n2]), s20); } }
      dflush(F, 13, a); dflush(F, 15, b15); dflush(F, 18, b18); dflush(F, 20, b20); }
    { DAcc a14{0.f, 0.f}, a19{0.f, 0.f};
      for (int it = gw; it < 64; it += NGW) { const int t = (it < 8) ? TP + (dh(it, 25) % TS) : dh(it, 26) % TALL;
          for (int w2 = 0; w2 < 2; ++w2) { float v[16]; float s = 0.f;
              for (int i = 0; i < 16; ++i) { const int e = lane + 64 * i; v[i] = w2 == 0 ? DN_ALPHA * xin(p, t, e) + bf2f(MIX[(size_t)t * DM + e]) : DN_ALPHA * H1[(size_t)t * DM + e] + bf2f(MIX2[(size_t)t * DM + e]); s += v[i]; }
              const float mean = wave_sum(s) / DM; float s2 = 0.f; for (int i = 0; i < 16; ++i) { v[i] -= mean; s2 += v[i] * v[i]; } const float rstd = rsqrtf(wave_sum(s2) / DM + 1e-5f);
              for (int i = 0; i < 16; ++i) { const int e = lane + 64 * i; if (w2 == 0) { const float rf = v[i] * rstd * p.ln1_g[e] + p.ln1_b[e]; dacc(a14, H1[(size_t)t * DM + e], rf); dacc(a14, bf2f(H1B[(size_t)t * DM + e]), rf); }
                  else { const float rf = v[i] * rstd * p.ln2_g[e] + p.ln2_b[e]; dacc(a19, H2[(size_t)t * DM + e], rf); dacc(a19, bf2f(H2B[(size_t)t * DM + e]), rf); } } } }
      dflush(F, 14, a14); dflush(F, 19, a19); }
    { DAcc a{0.f, 0.f};
      for (int it = gw; it < 256; it += NGW) { const int r = dh(it, 27) % 512, n = dh(it, 28) % 2048; float s = 0.f;
          for (int j = 0; j < 16; ++j) { const int k = lane + 64 * j; s += p.mem_prompt[(size_t)r * DM + k] * (n < 1024 ? p.mem_wk[(size_t)k * DM + n] : p.mem_wv[(size_t)k * DM + n - 1024]); }
          s = wave_sum(s); if (lane == 0) { dacc(a, n < 1024 ? bf2f(MK[(size_t)r * DM + n]) : bf2f(MV[(size_t)r * DM + n - 1024]), s); dacc(a, n < 1024 ? p.out[OUT_MKP + (size_t)r * DM + n] : p.out[OUT_MVP + (size_t)r * DM + n - 1024], s); } }
      dflush(F, 16, a); }
    { DAcc a{0.f, 0.f};
      for (int it = gw; it < 64; it += NGW) { const int t = (it < 32) ? TP + (dh(it, 29) % TS) : dh(it, 30) % TP; const int hm = it & 3; const bool smp = t >= TP; const int b = smp ? (t - TP) >> 3 : t >> 13;
          LDS_WAIT(); asm volatile("" ::: "memory");
          for (int i = 0; i < 4; ++i) wl[lane + 64 * i] = bf2f(QM[(size_t)t * DM + hm * 256 + lane + 64 * i]);
          LDS_WAIT(); asm volatile("" ::: "memory");
          float sc[4]; float mx = -INFINITY;
          for (int i = 0; i < 4; ++i) { const int m = lane + 64 * i; float s = 0.f;
              if (smp) { const float* kp = p.cache_mk + (((size_t)b * NMEM + m) * MH + hm) * MHD; for (int d = 0; d < 256; ++d) s += wl[d] * kp[d]; }
              else { const bf16* kp = MK + ((size_t)b * NMEM + m) * DM + hm * 256; for (int d = 0; d < 256; ++d) s += wl[d] * bf2f(kp[d]); }
              sc[i] = s; mx = fmaxf(mx, s); }
          for (int o_ = 1; o_ < 64; o_ <<= 1) mx = fmaxf(mx, __shfl_xor(mx, o_));
          float l = 0.f, o[4] = {0.f, 0.f, 0.f, 0.f}; const int dv0 = dh(it, 31) & 63;
          for (int i = 0; i < 4; ++i) { const int m = lane + 64 * i; const float pj = exp2f(sc[i] - mx); l += pj;
              for (int q = 0; q < 4; ++q) { const int dv = dv0 + 64 * q; const float vv = smp ? p.cache_mv[(((size_t)b * NMEM + m) * MH + hm) * MHD + dv] : bf2f(MV[((size_t)b * NMEM + m) * DM + hm * 256 + dv]); o[q] += pj * vv; } }
          l = wave_sum(l); for (int q = 0; q < 4; ++q) { const float ov = wave_sum(o[q]) / l; if (lane == 0) dacc(a, bf2f(OM[(size_t)t * DM + hm * 256 + dv0 + 64 * q]), ov); } }
      dflush(F, 17, a); }
    { DAcc a{0.f, 0.f};
      for (int it = gw; it < 256; it += NGW) { const int t = dh(it, 32) % TALL, gg = it & 15; float s0 = 0.f, s1 = 0.f;
          for (int d = 0; d < 128; ++d) { const float qv = bf2f(PQ[(size_t)t * 2048 + gg * 128 + d]); s0 += qv * p.peer_keys[((size_t)gg * 128 + lane) * 128 + d]; s1 += qv * p.peer_keys[((size_t)gg * 128 + lane + 64) * 128 + d]; }
          const float* tp = TOPS + ((size_t)t * 16 + gg) * 16; float vmin = INFINITY;
          for (int i = 0; i < 16; ++i) { const unsigned u = __float_as_uint(tp[i]); const int id = (int)(u & 127u); const float v = __uint_as_float(u & ~127u); const float sr = __shfl(id < 64 ? s0 : s1, id & 63); if (lane == 0) dacc(a, v, sr); vmin = fminf(vmin, v); }
          int cnt = (s0 > vmin + 0.05f ? 1 : 0) + (s1 > vmin + 0.05f ? 1 : 0); for (int o_ = 1; o_ < 64; o_ <<= 1) cnt += __shfl_xor(cnt, o_);
          if (lane == 0 && cnt > 15) dacc(a, 100.f, 0.f); }
      dflush(F, 21, a); }
    { DAcc a{0.f, 0.f};
      for (int it = gw; it < 256; it += NGW) { const int t = dh(it, 33) % TALL, h = it & 7; const float* ta = TOPS + ((size_t)t * 16 + 2 * h) * 16; const float* tb = ta + 16;
          float cs[4]; int ce[4];
          for (int m = 0; m < 4; ++m) { const int idx = lane + 64 * m, i = idx >> 4, j = idx & 15; const unsigned ua = __float_as_uint(ta[i]), ub = __float_as_uint(tb[j]); cs[m] = __uint_as_float(ua & ~127u) + __uint_as_float(ub & ~127u); ce[m] = (int)(ua & 127u) * NKEYS + (int)(ub & 127u); }
          float rs_[16]; int re_[16];
          for (int r = 0; r < 16; ++r) { float bm = fmaxf(fmaxf(cs[0], cs[1]), fmaxf(cs[2], cs[3])); float wm = bm; for (int o_ = 1; o_ < 64; o_ <<= 1) wm = fmaxf(wm, __shfl_xor(wm, o_));
              const unsigned long long bal = __ballot(bm == wm); const int owner = __ffsll((long long)bal) - 1; int eid = 0;
              if (lane == owner) { bool done = false; for (int m = 0; m < 4; ++m) if (!done && cs[m] == wm) { eid = ce[m]; cs[m] = -INFINITY; done = true; } }
              eid = __shfl(eid, owner); rs_[r] = wm; re_[r] = eid; }
          float den = 0.f; for (int r = 0; r < 16; ++r) den += expf(rs_[r] - rs_[0]);
          if (lane < 16) { const int fe = PIDX[((size_t)t * 8 + h) * 16 + lane]; const float fg = PG[((size_t)t * 8 + h) * 16 + lane]; float rg = 0.f; for (int r = 0; r < 16; ++r) if (re_[r] == fe) rg = expf(rs_[r] - rs_[0]) / den; dacc(a, fg, rg); } }
      dflush(F, 22, a); }
    { DAcc a{0.f, 0.f};
      for (int it = gw; it < 64; it += NGW) { const int t = (it < 8) ? TP + (dh(it, 34) % TS) : dh(it, 35) % TALL; float x[16], o[16];
          for (int i = 0; i < 16; ++i) { x[i] = bf2f(H2B[(size_t)t * DM + lane + 64 * i]); o[i] = 0.f; }
          for (int k = 0; k < 128; ++k) { const int e = PIDX[(size_t)t * 128 + k]; const float* ur = p.peer_u + (size_t)e * DM; const float* vr = p.peer_v + (size_t)e * DM; float s = 0.f; for (int i = 0; i < 16; ++i) s += x[i] * ur[lane + 64 * i];
              s = wave_sum(s); const float wgt = PG[(size_t)t * 128 + k] * gelu_ref(s); for (int i = 0; i < 16; ++i) o[i] += wgt * vr[lane + 64 * i]; }
          float s = 0.f; for (int i = 0; i < 16; ++i) { o[i] += DN_ALPHA * H2[(size_t)t * DM + lane + 64 * i]; s += o[i]; }
          const float mean = wave_sum(s) / DM; float s2 = 0.f; for (int i = 0; i < 16; ++i) { o[i] -= mean; s2 += o[i] * o[i]; } const float rstd = rsqrtf(wave_sum(s2) / DM + 1e-5f);
          for (int i = 0; i < 16; ++i) { const int e = lane + 64 * i; dacc(a, p.out[OUT_YP + (size_t)t * DM + e], o[i] * rstd * p.ln3_g[e] + p.ln3_b[e]); } }
      dflush(F, 23, a); }
    xcd_barrier(bar);
    { const float* dg = (const float*)(F.ctl + CW_DIAG); int fk = 0; float frel = 0.f;
      for (int k = NCHK - 1; k >= 1; --k) { const float d = __hip_atomic_load(dg + 2 * k, __ATOMIC_RELAXED, __HIP_MEMORY_SCOPE_AGENT), r = __hip_atomic_load(dg + 2 * k + 1, __ATOMIC_RELAXED, __HIP_MEMORY_SCOPE_AGENT);
          const float rel = sqrtf(d / fmaxf(r, 1e-30f)); const bool bad = !(rel <= 0.03f) || !(r > 0.f); if (bad) { fk = k; frel = rel; } }
      if (fk > 0) { int dgt = 1; if (frel == frel && frel < 1.f) { const float lg = -log10f(fmaxf(frel, 1e-9f)); dgt = 1 + (int)fminf(floorf(lg), 8.f); }
          const float D = ((float)dgt + 0.5f) * powf(10.f, (float)(5 + fk));
          const size_t gt = (size_t)F.vcu * NTHR + F.tid, NGT = (size_t)F.G * NTHR; for (size_t i = gt; i < (size_t)TS * DM; i += NGT) p.out[OUT_YS + i] = D; } }
}
#endif

#ifndef MK_SINGLE
#define MK_SINGLE 1
#endif
#ifndef MK_DIAG
#define MK_DIAG 0
#endif
constexpr int NPHASE = 18 + MK_DIAG;
__global__ void __launch_bounds__(NTHR, 2) mk_fwd(Args args) {
    extern __shared__ __attribute__((aligned(16))) unsigned char lds[];
    Frame F;
    F.lds = (LAS unsigned char*)lds;
    F.MISC = (volatile LAS unsigned*)(F.lds + MISC_OFF);
    F.tid = threadIdx.x; F.lane = F.tid & 63; F.wave = __builtin_amdgcn_readfirstlane(F.tid >> 6);
    F.G = gridDim.x; { const int bx = blockIdx.x; F.vcu = (F.G % 8 == 0) ? (bx % 8) * (F.G / 8) + bx / 8 : bx; }
    F.ctl = (gu32*)(args.ws + WS_CTL);
    P p;
    { const void* const* in = args.in;
      p.x_prompt = (const float*)in[0]; p.x_sample = (const float*)in[1]; p.mem_prompt = (const float*)in[2]; p.cache_c = (const float*)in[3]; p.cache_r = (const float*)in[4];
      p.state_conv = (const float*)in[5]; p.state_ssm = (const float*)in[6]; p.cache_mk = (const float*)in[7]; p.cache_mv = (const float*)in[8]; p.page_table = (const int*)in[9];
      p.w_in = (const float*)in[10]; p.q_a_norm = (const float*)in[11]; p.w_uq = (const float*)in[12]; p.kv_a_norm = (const float*)in[13]; p.w_uk = (const float*)in[14];
      p.w_uv = (const float*)in[15]; p.attn_out_norm = (const float*)in[16]; p.conv_w = (const float*)in[17]; p.conv_b = (const float*)in[18]; p.dt_bias = (const float*)in[19];
      p.a_log = (const float*)in[20]; p.d_skip = (const float*)in[21]; p.ssm_norm = (const float*)in[22]; p.w_out = (const float*)in[23]; p.ln1_g = (const float*)in[24];
      p.ln1_b = (const float*)in[25]; p.mem_wq = (const float*)in[26]; p.mem_wk = (const float*)in[27]; p.mem_wv = (const float*)in[28]; p.mem_wo = (const float*)in[29];
      p.ln2_g = (const float*)in[30]; p.ln2_b = (const float*)in[31]; p.peer_wq = (const float*)in[32]; p.peer_keys = (const float*)in[33]; p.peer_u = (const float*)in[34];
      p.peer_v = (const float*)in[35]; p.ln3_g = (const float*)in[36]; p.ln3_b = (const float*)in[37]; p.out = args.out; p.ws = args.ws; }
    unsigned char* ws = args.ws;
    for (int u = F.tid; u < (LDS_BYTES - LDSCTL_OFF) / 4; u += NTHR) ((LAS unsigned*)(F.lds + LDSCTL_OFF))[u] = 0u;
    __syncthreads();
    const int lo = args.ph_lo, hi = args.ph_hi;
    XcdBarrier bar; bar.bar = (unsigned*)(F.ctl + CW_BAR); bar.x = 0; bar.st = nullptr;
    if (hi - lo > 1) bar = xcd_barrier_post((unsigned*)(F.ctl + CW_BAR), F.MISC + 8);
#ifndef ONLY_PHASE
#define ONLY_PHASE -1
#endif
#define IN(k) ((ONLY_PHASE < 0 || ONLY_PHASE == (k)) && lo <= (k) && (k) < hi)
#ifndef PROBE_DUP
#define PROBE_DUP -1
#endif
#ifndef PROBE_DUP2
#define PROBE_DUP2 -1
#endif
#ifndef PROBE_DUP3
#define PROBE_DUP3 -1
#endif
#define REP(k) for (int rep_ = 0; rep_ < ((PROBE_DUP == (k) || PROBE_DUP2 == (k) || PROBE_DUP3 == (k)) ? 2 : 1); ++rep_)
#define BOTH(k) (IN(k) && IN((k) + 1))
#define SEAM(k) do { if (BOTH(k)) xcd_barrier(bar); } while (0)
#define GEMM_BF16(Aptr, Btptr, M_, N_, K_, Optr, ldc_, scale_, cshift) do { pg8::Gemm g_{(const bf16*)(Aptr), (const bf16*)(Btptr), (M_), (N_), (K_)}; pg8::StaticOrder S_; \
        S_.init((M_), (N_), F.G, (int)((blockIdx.x + (unsigned)F.G - (unsigned)(cshift)) % (unsigned)F.G)); EpiGen8<StoreBf16> E_{StoreBf16{(bf16*)(Optr), (ldc_), (scale_)}}; \
        pg8::gemm_phase<EpiGen8<StoreBf16>, pg8::StaticOrder, true, true>(F.lds + RING_OFF, g_, S_, E_); __syncthreads(); } while (0)

    if (IN(0)) { REP(0) p0_prologue(F, p); SEAM(0); }

    if (IN(1)) {
        REP(1) GEMM_BF16(ws + WS_XB, ws + WS_WIN, TALL, IN_PAD, DM, ws + WS_U, IN_PAD, 1.f, 0);
        { pg8::Gemm g{(const bf16*)(ws + WS_MEMB), (const bf16*)(ws + WS_MWKV), 512, 2048, DM}; pg8::StaticOrder S; S.init(512, 2048, F.G, (int)((blockIdx.x + 128u) % (unsigned)F.G));
          EpiGen8<StoreMemKV> E{StoreMemKV{p.out + OUT_MKP, p.out + OUT_MVP, (bf16*)(ws + WS_MK), (bf16*)(ws + WS_MV)}};
          pg8::gemm_phase<EpiGen8<StoreMemKV>, pg8::StaticOrder, true, true>(F.lds + RING_OFF, g, S, E); }
        SEAM(1); }

    if (IN(2)) { REP(2) p2_rows(F, p); SEAM(2); }

    if (IN(3)) {
#ifndef P3SEL
#define P3SEL 15
#endif
        if (P3SEL & 1) GEMM_BF16(ws + WS_CQN, ws + WS_WUQ, TALL, 768, QLORA, ws + WS_Q, 768, MLA_SCALE * LOG2E, 0);
        if (P3SEL & 2) GEMM_BF16(ws + WS_CKV, ws + WS_WKV, TP, 1024, KVLORA, ws + WS_KNV, 1024, 1.f, 0);
        if (P3SEL & 4) GEMM_BF16((const bf16*)(ws + WS_CQN) + (size_t)TP * QLORA, ws + WS_WABS, TS, 2048, QLORA, ws + WS_QLAT, 2048, MLA_SCALE * LOG2E, 204);
        if (P3SEL & 8) for (int u = F.vcu; u < 2 * NCHUNK * 8; u += F.G) ssd_a_unit(F, p, u >> 9, (u >> 3) & 63, u & 7);
        SEAM(3); }

    if (IN(4)) {
        REP(40) ssd_b_scan(F, p);
        REP(41) for (int u = F.vcu; u < 256; u += F.G) { const int bh = u >> 4, s = u & 15; attn_prompt_unit(F, p, bh >> 3, bh & 7, 31 - s); attn_prompt_unit(F, p, bh >> 3, bh & 7, s); }
        REP(42) for (int u = F.vcu; u < 256; u += F.G) attn_sample_unit(F, p, u >> 1, u & 1);
        SEAM(4); }

    if (IN(5)) {
        REP(50) attn_sample_combine(F, p);
        REP(51) for (int u = F.vcu; u < 2 * NCHUNK * 8; u += F.G) ssd_c_unit(F, p, u >> 9, (u >> 3) & 63, u & 7);
        REP(52) for (int u = F.vcu; u < DBATCH * 8; u += F.G) ssd_sample_unit(F, p, u >> 3, u & 7);
        SEAM(5); }

    if (IN(6)) { REP(6) GEMM_BF16(ws + WS_OLAT, ws + WS_WUVBD, TS, 512, 2048, (bf16*)(ws + WS_OATT) + (size_t)TP * 512, 512, 1.f, 0); SEAM(6); }

    if (IN(7)) { REP(7) mixa_rows(F, p); SEAM(7); }

    if (IN(8)) { REP(8) GEMM_BF16(ws + WS_MIXA, ws + WS_WOUT, TALL, DM, DM, ws + WS_MIX, DM, 1.f, 0); SEAM(8); }

    if (IN(9)) { REP(9) ln_rows(F, p.x_prompt, p.x_sample, (const bf16*)(ws + WS_MIX), p.ln1_g, p.ln1_b, (float*)(ws + WS_H1), (bf16*)(ws + WS_H1B)); SEAM(9); }

    if (IN(10)) { REP(10) GEMM_BF16(ws + WS_H1B, ws + WS_MWQ, TALL, DM, DM, ws + WS_QM, DM, 0.0625f * LOG2E, 0); SEAM(10); }

    if (IN(11)) {
        REP(111) for (int u = F.vcu; u < 512; u += F.G) mem_attn_prompt_unit(F, p, u >> 8, (u >> 6) & 3, u & 63);
        REP(112) for (int u = F.vcu; u < 512; u += F.G) mem_attn_sample_unit(F, p, u >> 2, u & 3);
        SEAM(11); }

    if (IN(12)) { REP(12) GEMM_BF16(ws + WS_OM, ws + WS_MWO, TALL, DM, DM, ws + WS_MIX2, DM, 1.f, 0); SEAM(12); }

    if (IN(13)) { REP(13) ln_rows(F, (const float*)(ws + WS_H1), (const float*)(ws + WS_H1) + (size_t)TP * DM, (const bf16*)(ws + WS_MIX2), p.ln2_g, p.ln2_b, (float*)(ws + WS_H2), (bf16*)(ws + WS_H2B)); SEAM(13); }

    if (IN(14)) { REP(14) GEMM_BF16(ws + WS_H2B, ws + WS_PWQ, TALL, 2048, DM, ws + WS_PQ, 2048, 1.f, 0); SEAM(14); }

    if (IN(15)) { REP(15) for (int u = F.vcu; u < 68 * 16; u += F.G) peer_scores_unit(F, p, u >> 4, u & 15); SEAM(15); }

    if (IN(16)) { REP(16) peer_cand(F, p); SEAM(16); }

    if (IN(17)) { REP(17) peer_gather(F, p); SEAM(17); }
#if MK_DIAG
    if (IN(18)) { diag_phase(F, p, bar); }
#endif
#undef IN
#undef BOTH
#undef SEAM
}

extern "C" void kernel_launch(void* const* d_in, const int* in_sizes, int n_in, void* d_out, int out_size, void* d_ws, size_t ws_size, hipStream_t stream) {
    static int grid = 0;
    if (grid == 0) {
        if (n_in != 38 || (size_t)out_size != OUT_END || ws_size < WS_END) { fprintf(stderr, "kernel_launch: unexpected shapes: n_in %d out %d (want %zu) ws %zu (want %zu)\n", n_in, out_size, (size_t)OUT_END, ws_size, (size_t)WS_END); grid = -1; return; }
        int dev = 0, cus = 0, per_cu = 0;
        if (hipGetDevice(&dev) != hipSuccess || hipDeviceGetAttribute(&cus, hipDeviceAttributeMultiprocessorCount, dev) != hipSuccess) { grid = -1; return; }
        if (hipFuncSetAttribute((const void*)mk_fwd, hipFuncAttributeMaxDynamicSharedMemorySize, LDS_BYTES) != hipSuccess) { fprintf(stderr, "kernel_launch: hipFuncSetAttribute failed\n"); grid = -1; return; }
        if (hipOccupancyMaxActiveBlocksPerMultiprocessor(&per_cu, (const void*)mk_fwd, NTHR, LDS_BYTES) != hipSuccess || per_cu < 1) { fprintf(stderr, "kernel_launch: occupancy query says %d\n", per_cu); }
        (void)hipGetLastError();
        grid = cus;
    }
    if (grid < 0) return;
    (void)hipMemsetAsync((char*)d_ws + WS_CTL, 0, CTL_ZERO_BYTES, stream);
    Args a{};
    for (int i = 0; i < 38; ++i) a.in[i] = d_in[i];
    a.out = (float*)d_out; a.ws = (unsigned char*)d_ws;
#if MK_SINGLE
    a.ph_lo = 0; a.ph_hi = NPHASE;
    hipLaunchKernelGGL(mk_fwd, dim3(grid), dim3(NTHR), LDS_BYTES, stream, a);
#else
    for (int ph = 0; ph < NPHASE; ++ph) { a.ph_lo = ph; a.ph_hi = ph + 1; hipLaunchKernelGGL(mk_fwd, dim3(grid), dim3(NTHR), LDS_BYTES, stream, a); }
#endif
}
```

```cpp
#include <hip/hip_runtime.h>
#include <cstdio>
#include <cstdint>
namespace pg8 {
#define PG8_LAS __attribute__((address_space(3)))
typedef unsigned short bf16_t;
typedef short bf16x8 __attribute__((ext_vector_type(8)));
typedef float f32x4 __attribute__((ext_vector_type(4)));
typedef unsigned u32x4 __attribute__((ext_vector_type(4)));
constexpr int BM = 256, BK = 64, HALF = 128, HTB = HALF * BK * 2  , STAGE_BYTES = 8 * HTB, NXCD = 8, WGM = 8;

__host__ __device__ __forceinline__ int lds_byte(int r, int c) { const int st = (r >> 4) * 2 + (c >> 5), rr = r & 15, cc = c & 31, ob = rr * 64 + cc * 2; return st * 1024 + (ob ^ (((ob >> 9) & 1) << 5)); }
__host__ __device__ __forceinline__ void stage_rc(int b, int& R, int& C) { const int st = b / 1024, sb = b % 1024, swz = sb ^ (((sb >> 9) & 1) << 5); R = (st >> 1) * 16 + swz / 64; C = (st & 1) * 32 + (swz % 64) / 2; }
__host__ __device__ __forceinline__ int perm32(int rho) { const int n = rho >> 4, i = rho & 15; return 8 * (i >> 2) + 4 * n + (i & 3); }

struct Unit { int pm, pn; };
struct Gemm { const bf16_t* A; const bf16_t* Bt; int M, N, K; };

struct StaticOrder {
    int nM, nN, nwg, G, c;
    __host__ __device__ void init(int M, int N, int G_, int c_) { nM = M / BM; nN = N / BM; nwg = nM * nN; G = G_; c = c_; }
    __host__ __device__ bool next(int i, Unit& u) const {
        const long L = (long)i * G + c; if (L >= nwg) return false;
        int wgid = (int)L; { const int q = nwg / NXCD, r = nwg % NXCD, xcd = wgid % NXCD, off = wgid / NXCD; wgid = (xcd < r ? xcd * (q + 1) : r * (q + 1) + (xcd - r) * q) + off; }
        const int nig = WGM * nN, gid = wgid / nig, fm = gid * WGM, gsz = (nM - fm) < WGM ? (nM - fm) : WGM;
        u.pm = fm + ((wgid % nig) % gsz); u.pn = (wgid % nig) / gsz; return true;
    }
    __device__ __forceinline__ void a_ready(const Unit&) const {}
    __device__ __forceinline__ void done(const Unit&) const {}
};

__device__ __forceinline__ unsigned cvt_pk_bf16(float lo, float hi) { unsigned r; asm volatile("v_cvt_pk_bf16_f32 %0, %1, %2" : "=v"(r) : "v"(lo), "v"(hi)); return r; }
typedef float f32x2 __attribute__((ext_vector_type(2)));
__device__ __forceinline__ f32x2 gelu_pk(f32x2 v) {
    const f32x2 av = __builtin_elementwise_abs(v), d = av * 0.2316418882f + 1.0f;
    f32x2 t; t.x = __builtin_amdgcn_rcpf(d.x); t.y = __builtin_amdgcn_rcpf(d.y);
    f32x2 q = t * 0.5307027145f + (-0.7265760135f); q = q * t + 0.7107068705f; q = q * t + (-0.142248368f); q = q * t + 0.127414796f; q = q * t;
    const f32x2 s = (v * v) * (-0.72134752044f);
    f32x2 e; e.x = __builtin_amdgcn_exp2f(s.x); e.y = __builtin_amdgcn_exp2f(s.y);
    const f32x2 m = v * (q * e), r = v - m;
    f32x2 o; o.x = v.x < 0.f ? m.x : r.x; o.y = v.y < 0.f ? m.y : r.y; return o;
}

template <int ACT  > struct EpiBf16 {
    static constexpr bool PERM = true, AFTER_DRAIN = false; static_assert(ACT == 0 || ACT == 1, "EpiBf16: ACT is 0 (none) or 1 (gelu_pk)");
    bf16_t* O; int ldc; const float* bias; int split_cols; size_t split_stride; float scale0;
    __device__ __forceinline__ void operator()(const f32x4 (&acc)[2][2][4][2], const Unit& u, int wr, int wc, int fr, int fq) const {
        const int row0 = u.pm * BM + wr * 64 + fr; int colt = u.pn * BM; bf16_t* base = O;
        float sc = 1.f; if (split_cols) { const int t = colt / split_cols; base += (size_t)t * split_stride; colt -= t * split_cols; if (t == 0) sc = scale0; }
        const int col0 = colt + wc * 32 + 8 * fq, bcol0 = u.pn * BM + wc * 32 + 8 * fq;
        f32x4 bv[2][2];
#pragma unroll
        for (int bj = 0; bj < 2; ++bj)
#pragma unroll
            for (int n = 0; n < 2; ++n) bv[bj][n] = bias ? *(const f32x4*)(bias + bcol0 + bj * HALF + 4 * n) : (f32x4){0.f, 0.f, 0.f, 0.f};
#pragma unroll
        for (int ai = 0; ai < 2; ++ai)
#pragma unroll
            for (int m = 0; m < 4; ++m) { bf16_t* rowp = base + (size_t)(row0 + ai * HALF + m * 16) * ldc + col0;
#pragma unroll
                for (int bj = 0; bj < 2; ++bj) { f32x4 v0 = acc[ai][bj][m][0] + bv[bj][0], v1 = acc[ai][bj][m][1] + bv[bj][1];
                    if (ACT == 1) { f32x2 a = gelu_pk((f32x2){v0[0], v0[1]}), b = gelu_pk((f32x2){v0[2], v0[3]}), c = gelu_pk((f32x2){v1[0], v1[1]}), d = gelu_pk((f32x2){v1[2], v1[3]});
                        v0 = (f32x4){a.x, a.y, b.x, b.y}; v1 = (f32x4){c.x, c.y, d.x, d.y}; }
                    v0 = v0 * sc; v1 = v1 * sc; u32x4 w; w.x = cvt_pk_bf16(v0[0], v0[1]); w.y = cvt_pk_bf16(v0[2], v0[3]); w.z = cvt_pk_bf16(v1[0], v1[1]); w.w = cvt_pk_bf16(v1[2], v1[3]);
                    *(u32x4*)(rowp + bj * HALF) = w; } }
    }
};

template <class Epi, class Sched, bool ALIGN_EPI = false, bool SP2 = false>
__device__ __forceinline__ void gemm_phase(PG8_LAS unsigned char* lds, const Gemm g, const Sched& S, const Epi& E) {
    const int tid = threadIdx.x, wid = __builtin_amdgcn_readfirstlane(tid >> 6), lane = tid & 63, wr = wid >> 2, wc = wid & 3, fr = lane & 15, fq = lane >> 4;
    const int K = g.K, nt = K / BK;
    unsigned voffA[2], voffB[2];
#pragma unroll
    for (int i = 0; i < 2; ++i) { int R, C; stage_rc(tid * 16 + i * 8192, R, C); const int Rb = Epi::PERM ? ((R & ~31) + perm32(R & 31)) : R;
        voffA[i] = (unsigned)(R * K + C) * 2u; voffB[i] = (unsigned)(Rb * K + C) * 2u; }
    const size_t kstep = (size_t)(BK * 2);
    const size_t hstep = (size_t)HALF * K * 2;
    const size_t tstep = 2 * hstep;
    const unsigned ldsw = (unsigned)wid * 1024u;
    const int aoff = lds_byte(wr * 64 + fr, fq * 8), boff = lds_byte(wc * 32 + fr, fq * 8);
#define PG8_SA(b, h) (((b) * 2 + (h)) * HTB)
#define PG8_SB(b, h) ((4 + (b) * 2 + (h)) * HTB)
#define PG8_STAGE(bufoff, gbase, voff) do { _Pragma("unroll") for (int _i = 0; _i < 2; ++_i) \
        __builtin_amdgcn_global_load_lds((const unsigned*)((const char*)(gbase) + (voff)[_i]), (PG8_LAS unsigned*)(lds + (bufoff) + ldsw + _i * 8192), 16, 0, 0); } while (0)
#define PG8_LDA(dst, b, h) do { _Pragma("unroll") for (int m = 0; m < 4; ++m) _Pragma("unroll") for (int k = 0; k < 2; ++k) dst[m][k] = *(const PG8_LAS bf16x8*)(lds + PG8_SA(b, h) + aoff + m * 2048 + k * 1024); } while (0)
#define PG8_LDB(dst, b, h) do { _Pragma("unroll") for (int n = 0; n < 2; ++n) _Pragma("unroll") for (int k = 0; k < 2; ++k) dst[n][k] = *(const PG8_LAS bf16x8*)(lds + PG8_SB(b, h) + boff + n * 2048 + k * 1024); } while (0)
#define PG8_MMA(ai, bj, At, Bt) do { __builtin_amdgcn_s_setprio(1); _Pragma("unroll") for (int m = 0; m < 4; ++m) _Pragma("unroll") for (int n = 0; n < 2; ++n) _Pragma("unroll") for (int k = 0; k < 2; ++k) \
        acc[ai][bj][m][n] = __builtin_amdgcn_mfma_f32_16x16x32_bf16(Bt[n][k], At[m][k], acc[ai][bj][m][n], 0, 0, 0); __builtin_amdgcn_s_setprio(0); } while (0)
#define PG8_WAIT_V(n) asm volatile("s_waitcnt vmcnt(" #n ")" ::: "memory")
#define PG8_WAIT_L(n) asm volatile("s_waitcnt lgkmcnt(" #n ")" ::: "memory")
#define PG8_BAR __builtin_amdgcn_s_barrier()
#define PG8_SCHED __builtin_amdgcn_sched_barrier(0)
    Unit cur, nxt; int ui = 0;
    if (!S.next(0, cur)) return;
    f32x4 acc[2][2][4][2];
#pragma unroll
    for (int a = 0; a < 2; ++a)
#pragma unroll
        for (int b = 0; b < 2; ++b)
#pragma unroll
            for (int m = 0; m < 4; ++m)
#pragma unroll
                for (int n = 0; n < 2; ++n) acc[a][b][m][n] = (f32x4){0.f, 0.f, 0.f, 0.f};
    bf16x8 At[4][2], B0[2][2], B1[2][2];
    const char* cA = (const char*)g.A + (size_t)cur.pm * tstep; const char* cB = (const char*)g.Bt + (size_t)cur.pn * tstep;
    S.a_ready(cur);
    if constexpr (SP2) {
        PG8_STAGE(PG8_SB(0, 0), cB, voffB); PG8_STAGE(PG8_SB(0, 1), cB + hstep, voffB); PG8_STAGE(PG8_SA(0, 0), cA, voffA); PG8_STAGE(PG8_SA(0, 1), cA + hstep, voffA);
        if (wr == 1) PG8_BAR;
        PG8_WAIT_V(2); PG8_BAR;
        PG8_STAGE(PG8_SB(1, 0), cB + kstep, voffB); PG8_STAGE(PG8_SA(1, 0), cA + kstep, voffA); PG8_STAGE(PG8_SB(1, 1), cB + hstep + kstep, voffB);
        PG8_WAIT_V(6); PG8_BAR;
    } else {
        PG8_STAGE(PG8_SB(0, 0), cB, voffB); PG8_STAGE(PG8_SA(0, 0), cA, voffA); PG8_STAGE(PG8_SB(0, 1), cB + hstep, voffB); PG8_STAGE(PG8_SA(0, 1), cA + hstep, voffA);
        if (wr == 1) PG8_BAR;
        PG8_WAIT_V(4); PG8_BAR;
        PG8_STAGE(PG8_SB(1, 0), cB + kstep, voffB); PG8_STAGE(PG8_SA(1, 0), cA + kstep, voffA); PG8_STAGE(PG8_SB(1, 1), cB + hstep + kstep, voffB);
        PG8_WAIT_V(6); PG8_BAR;
    }
    for (;;) {
        const bool has_next = S.next(ui + 1, nxt);
        const char* nA = has_next ? (const char*)g.A + (size_t)nxt.pm * tstep : cA; const char* nB = has_next ? (const char*)g.Bt + (size_t)nxt.pn * tstep : cB;
        for (int t = 0; t < nt; t += 2) {
            const bool last = (t == nt - 2);
            const char* a1 = cA + (size_t)(t + 1) * kstep;
            const char* a2 = last ? nA : cA + (size_t)(t + 2) * kstep; const char* b2 = last ? nB : cB + (size_t)(t + 2) * kstep;
            const char* a3 = a2 + kstep; const char* b3 = b2 + kstep;
            if (last && has_next) S.a_ready(nxt);
            if constexpr (SP2) {
            PG8_LDB(B0, 0, 0); PG8_LDB(B1, 0, 1); PG8_SCHED; PG8_LDA(At, 0, 0); PG8_STAGE(PG8_SA(1, 1), a1 + hstep, voffA);
            PG8_WAIT_V(8); PG8_WAIT_L(0); PG8_BAR; PG8_MMA(0, 0, At, B0); PG8_MMA(0, 1, At, B1); PG8_BAR; PG8_SCHED;
            PG8_LDA(At, 0, 1); PG8_STAGE(PG8_SB(0, 0), b2, voffB); PG8_STAGE(PG8_SB(0, 1), b2 + hstep, voffB); PG8_STAGE(PG8_SA(0, 0), a2, voffA);
            PG8_WAIT_V(8); PG8_WAIT_L(0); PG8_BAR; PG8_MMA(1, 0, At, B0); PG8_MMA(1, 1, At, B1); PG8_BAR; PG8_SCHED;
            PG8_LDB(B0, 1, 0); PG8_LDB(B1, 1, 1); PG8_SCHED; PG8_LDA(At, 1, 0); PG8_STAGE(PG8_SA(0, 1), a2 + hstep, voffA);
            PG8_WAIT_V(8); PG8_WAIT_L(0); PG8_BAR; PG8_MMA(0, 0, At, B0); PG8_MMA(0, 1, At, B1); PG8_BAR; PG8_SCHED;
            PG8_LDA(At, 1, 1); PG8_STAGE(PG8_SB(1, 0), b3, voffB); PG8_STAGE(PG8_SB(1, 1), b3 + hstep, voffB); PG8_STAGE(PG8_SA(1, 0), a3, voffA);
            PG8_WAIT_V(8); PG8_WAIT_L(0); PG8_BAR; PG8_MMA(1, 0, At, B0); PG8_MMA(1, 1, At, B1); PG8_BAR; PG8_SCHED;
            } else {
            PG8_LDB(B0, 0, 0); PG8_SCHED; PG8_LDA(At, 0, 0); PG8_STAGE(PG8_SA(1, 1), a1 + hstep, voffA);
            PG8_WAIT_L(8); PG8_BAR; PG8_WAIT_L(0); PG8_MMA(0, 0, At, B0); PG8_BAR; PG8_SCHED;
            PG8_LDB(B1, 0, 1); PG8_STAGE(PG8_SB(0, 0), b2, voffB);
            PG8_BAR; PG8_WAIT_L(0); PG8_MMA(0, 1, At, B1); PG8_BAR;
            PG8_LDA(At, 0, 1); PG8_STAGE(PG8_SA(0, 0), a2, voffA);
            PG8_BAR; PG8_WAIT_L(0); PG8_MMA(1, 0, At, B0); PG8_BAR; PG8_SCHED;
            PG8_STAGE(PG8_SB(0, 1), b2 + hstep, voffB);
            PG8_WAIT_V(6); PG8_BAR; PG8_MMA(1, 1, At, B1); PG8_BAR;
            PG8_LDB(B0, 1, 0); PG8_SCHED; PG8_LDA(At, 1, 0); PG8_STAGE(PG8_SA(0, 1), a2 + hstep, voffA);
            PG8_WAIT_L(8); PG8_BAR; PG8_WAIT_L(0); PG8_MMA(0, 0, At, B0); PG8_BAR; PG8_SCHED;
            PG8_LDB(B1, 1, 1); PG8_STAGE(PG8_SB(1, 0), b3, voffB);
            PG8_BAR; PG8_WAIT_L(0); PG8_MMA(0, 1, At, B1); PG8_BAR;
            PG8_LDA(At, 1, 1); PG8_STAGE(PG8_SA(1, 0), a3, voffA);
            PG8_BAR; PG8_WAIT_L(0); PG8_MMA(1, 0, At, B0); PG8_BAR; PG8_SCHED;
            PG8_STAGE(PG8_SB(1, 1), b3 + hstep, voffB);
            PG8_WAIT_V(6); PG8_BAR; PG8_MMA(1, 1, At, B1); PG8_BAR;
            }
        }
        if constexpr (ALIGN_EPI) { if (wr == 0) PG8_BAR; }
        if constexpr (!Epi::AFTER_DRAIN) { E(acc, cur, wr, wc, fr, fq); S.done(cur); }
        if (!has_next) break;
#pragma unroll
        for (int a = 0; a < 2; ++a)
#pragma unroll
            for (int b = 0; b < 2; ++b)
#pragma unroll
                for (int m = 0; m < 4; ++m)
#pragma unroll
                    for (int n = 0; n < 2; ++n) acc[a][b][m][n] = (f32x4){0.f, 0.f, 0.f, 0.f};
        cur = nxt; cA = nA; cB = nB; ++ui;
        if constexpr (ALIGN_EPI) { if (wr == 1) PG8_BAR; }
    }
    PG8_WAIT_V(0);
    if constexpr (!ALIGN_EPI) { if (wr == 0) PG8_BAR; }
    PG8_BAR;
    if constexpr (Epi::AFTER_DRAIN) { E.fused(acc, cur, wr, wc, fr, fq, lds, wid, lane); S.done(cur); }
#undef PG8_SA
#undef PG8_SB
#undef PG8_STAGE
#undef PG8_LDA
#undef PG8_LDB
#undef PG8_MMA
#undef PG8_WAIT_V
#undef PG8_WAIT_L
#undef PG8_BAR
#undef PG8_SCHED
}
}
#define GAS __attribute__((address_space(1)))
#define LAS __attribute__((address_space(3)))
typedef unsigned short bf16;
typedef unsigned v4u __attribute__((ext_vector_type(4)));
typedef float f32x4 __attribute__((ext_vector_type(4)));
typedef short bf16x8 __attribute__((ext_vector_type(8)));
typedef GAS unsigned gu32;
typedef GAS unsigned long long gu64;
#define RLX_AGENT __ATOMIC_RELAXED, __HIP_MEMORY_SCOPE_AGENT
#define LDS_WAIT() asm volatile("s_waitcnt lgkmcnt(0)" ::: "memory")
#define VM_WAIT() asm volatile("s_waitcnt vmcnt(0)" ::: "memory")
__device__ __forceinline__ unsigned long long rt() { return __builtin_amdgcn_s_memrealtime(); }
__device__ __forceinline__ unsigned f2bf(float f) { unsigned u = __builtin_bit_cast(unsigned, f); return (u + 0x7fffu + ((u >> 16) & 1u)) >> 16; }
__device__ __forceinline__ unsigned pk2(float lo, float hi) { return f2bf(lo) | (f2bf(hi) << 16); }

#define XB_TMO      128
#define XB_XCNT(j)  (256  + 64 * (j))
#define XB_XSUB(j)  (1280 + 64 * (j))
#define XB_XGEN(j)  (2304 + 64 * (j))
#define XB_TOP      3328
#define XB_TOPGEN   3392
#define XCD_BAR_WORDS 3456
#define XB_SPIN_CAP (1u << 18)

__device__ __forceinline__ unsigned xb_ld(unsigned* p)              { return __hip_atomic_load(p, __ATOMIC_RELAXED, __HIP_MEMORY_SCOPE_AGENT); }
__device__ __forceinline__ unsigned xb_add(unsigned* p, unsigned v) { return __hip_atomic_fetch_add(p, v, __ATOMIC_RELAXED, __HIP_MEMORY_SCOPE_AGENT); }
__device__ __forceinline__ unsigned xb_xcc_id() { return (unsigned)__builtin_amdgcn_s_getreg((3 << 11) | 20) & 0xFu; }
#define XB_SPIN(cond, bar) do { unsigned _sp = 0; while (cond) { __builtin_amdgcn_s_sleep(1); \
    if ((++_sp & 255u) == 0u) { if (xb_ld(&(bar)[XB_TMO])) break; if (_sp > XB_SPIN_CAP) { atomicAdd(&(bar)[XB_TMO], 1u); break; } } } } while (0)

struct XcdBarrier {
    unsigned* bar; unsigned x;
    volatile LAS unsigned* st;
};

__device__ __forceinline__ XcdBarrier xcd_barrier_post(unsigned* bar, volatile LAS unsigned* st) {
    XcdBarrier b; b.bar = bar; b.x = xb_xcc_id(); b.st = st;
    if (threadIdx.x == 0) (void)xb_add(&bar[XB_XCNT(b.x)], 1u);
    return b;
}
__device__ __forceinline__ void xcd_barrier_complete(unsigned* bar, unsigned x, unsigned& nloc, unsigned& nx) {
    const unsigned G = gridDim.x * gridDim.y * gridDim.z;
    unsigned sum, cnt, mine, sp = 0u;
    for (;;) {
        sum = 0u; cnt = 0u; mine = 0u;
#pragma unroll
        for (unsigned j = 0; j < 16; ++j) { const unsigned c = xb_ld(&bar[XB_XCNT(j)]); sum += c; cnt += (c > 0u) ? 1u : 0u; mine = (j == x) ? c : mine; }
        if (sum == G) break;
        __builtin_amdgcn_s_sleep(1);
        if ((++sp & 255u) == 0u) { if (xb_ld(&bar[XB_TMO])) break; if (sp > XB_SPIN_CAP) { atomicAdd(&bar[XB_TMO], 1u); break; } }
    }
    nloc = mine > 0u ? mine : 1u; nx = cnt > 0u ? cnt : 1u;
}

__device__ __forceinline__ void xcd_barrier(const XcdBarrier& b) {
    asm volatile("s_waitcnt vmcnt(0)" ::: "memory");
    __syncthreads();
    if (threadIdx.x == 0) {
        unsigned* bar = b.bar;
        __builtin_amdgcn_s_waitcnt(0);
        unsigned nloc = b.st[0], nx = b.st[1];
        if (nloc == 0u) { xcd_barrier_complete(bar, b.x, nloc, nx); b.st[0] = nloc; b.st[1] = nx; }
        const unsigned old = xb_add(&bar[XB_XSUB(b.x)], 1u);
        const unsigned gen = old / nloc;
        if (old + 1u == (gen + 1u) * nloc) {
            __builtin_amdgcn_fence(__ATOMIC_RELEASE, "agent");
            asm volatile("s_waitcnt vmcnt(0)" ::: "memory");
            const unsigned og = xb_add(&bar[XB_TOP], 1u);
            const unsigned tg = og / nx;
            if (og + 1u == (tg + 1u) * nx) xb_add(&bar[XB_TOPGEN], 1u);
            else XB_SPIN(xb_ld(&bar[XB_TOPGEN]) == tg, bar);
            __builtin_amdgcn_fence(__ATOMIC_ACQUIRE, "agent");
            xb_add(&bar[XB_XGEN(b.x)], 1u);
            asm volatile("s_waitcnt vmcnt(0)" ::: "memory");
        } else {
            XB_SPIN(xb_ld(&bar[XB_XGEN(b.x)]) == gen, bar);
            __builtin_amdgcn_fence(__ATOMIC_ACQUIRE, "agent");
            asm volatile("s_waitcnt vmcnt(0)" ::: "memory");
        }
    }
    __syncthreads();
}


constexpr int NWAVES = 8, NTHR = 512;
constexpr int DM = 1024, TP = 16384, TS = 1024, TALL = TP + TS, SEQ = 8192, DSEQ = 8, DBATCH = 128, PAST = 8192, PAGE = 128, NPAGES = 64;
constexpr int QLORA = 384, KVLORA = 256, ROPE = 32, NOPE = 64, QHD = 96, VHD = 64, NH = 8;
constexpr int DSSM = 512, NSTATE = 128, CONVD = 1024, SSD_HD = 64, CHUNK = 128, NCHUNK = SEQ / CHUNK;
constexpr int IN_DIM = 2216, IN_PAD = 2304;
constexpr int O_CQ = 0, O_CKV = 384, O_KPE = 640, O_Z = 672, O_XBC = 1184, O_DT = 2208;
constexpr int NMEM = 256, MH = 4, MHD = 256;
constexpr int PH = 8, NKEYS = 128, NEXP = 16384, PTOPK = 16;
constexpr float DN_ALPHA = 1.189207115002721f;
constexpr float MLA_SCALE = 0.10206207261596577f;
constexpr float LOG2E = 1.4426950408889634f;
constexpr int NPOS = 8200;

constexpr size_t OUT_YP = 0, OUT_YS = OUT_YP + (size_t)TP * DM, OUT_KVP = OUT_YS + (size_t)TS * DM, OUT_KRP = OUT_KVP + (size_t)TP * KVLORA,
    OUT_CVP = OUT_KRP + (size_t)TP * ROPE, OUT_SSP = OUT_CVP + 2 * 3 * CONVD, OUT_MKP = OUT_SSP + 2 * 8 * 64 * 128, OUT_MVP = OUT_MKP + 512 * 1024,
    OUT_KVS = OUT_MVP + 512 * 1024, OUT_KRS = OUT_KVS + (size_t)TS * KVLORA, OUT_CVS = OUT_KRS + (size_t)TS * ROPE, OUT_SSS = OUT_CVS + 128 * 3 * CONVD,
    OUT_END = OUT_SSS + (size_t)128 * 8 * 64 * 128;

constexpr size_t al64k(size_t x) { return (x + 65535) & ~(size_t)65535; }
constexpr size_t WS_CTL = 0, CTL_ZERO_BYTES = 1u << 20;
constexpr size_t WS_ROPE = WS_CTL + CTL_ZERO_BYTES;
constexpr size_t WS_WIN = WS_ROPE + al64k((size_t)NPOS * 16 * 2 * 4);
constexpr size_t WS_WUQ = WS_WIN + al64k((size_t)IN_PAD * DM * 2);
constexpr size_t WS_WABS = WS_WUQ + al64k((size_t)768 * 384 * 2);
constexpr size_t WS_WKV = WS_WABS + al64k((size_t)2048 * 384 * 2);
constexpr size_t WS_WUVBD = WS_WKV + al64k((size_t)1024 * 256 * 2);
constexpr size_t WS_WOUT = WS_WUVBD + al64k((size_t)512 * 2048 * 2);
constexpr size_t WS_MWQ = WS_WOUT + al64k((size_t)DM * DM * 2);
constexpr size_t WS_MWO = WS_MWQ + al64k((size_t)DM * DM * 2);
constexpr size_t WS_MWKV = WS_MWO + al64k((size_t)DM * DM * 2);
constexpr size_t WS_PWQ = WS_MWKV + al64k((size_t)2048 * DM * 2);
constexpr size_t WS_PKEYS = WS_PWQ + al64k((size_t)2048 * DM * 2);
constexpr size_t WS_PU = WS_PKEYS + al64k((size_t)16 * 128 * 128 * 2);
constexpr size_t WS_PV = WS_PU + al64k((size_t)NEXP * DM * 2);
constexpr size_t WS_XB = WS_PV + al64k((size_t)NEXP * DM * 2);
constexpr size_t WS_MEMB = WS_XB + al64k((size_t)TALL * DM * 2);
constexpr size_t WS_U = WS_MEMB + al64k((size_t)512 * DM * 2);
constexpr size_t WS_CQN = WS_U + al64k((size_t)TALL * IN_PAD * 2);
constexpr size_t WS_CKV = WS_CQN + al64k((size_t)TALL * QLORA * 2);
constexpr size_t WS_KR = WS_CKV + al64k((size_t)TALL * KVLORA * 2);
constexpr size_t WS_XBC = WS_KR + al64k((size_t)TALL * ROPE * 2);
constexpr size_t WS_DT = WS_XBC + al64k((size_t)TALL * CONVD * 2);
constexpr size_t WS_Q = WS_DT + al64k((size_t)TALL * 8 * 4);
constexpr size_t WS_KNV = WS_Q + al64k((size_t)TALL * 768 * 2);
constexpr size_t WS_QLAT = WS_KNV + al64k((size_t)TP * 1024 * 2);
constexpr size_t WS_MK = WS_QLAT + al64k((size_t)TS * 2048 * 2);
constexpr size_t WS_MV = WS_MK + al64k((size_t)512 * DM * 2);
constexpr size_t WS_MKS = WS_MV + al64k((size_t)512 * DM * 2);
constexpr size_t WS_MVS = WS_MKS + al64k((size_t)128 * 256 * DM * 2);
constexpr size_t WS_OATT = WS_MVS + al64k((size_t)128 * 256 * DM * 2);
constexpr size_t WS_OLAT = WS_OATT + al64k((size_t)TALL * 512 * 2);
constexpr size_t WS_APART = WS_OLAT + al64k((size_t)TS * 2048 * 2);
constexpr size_t WS_STATES = WS_APART + al64k((size_t)128 * 2 * 64 * 264 * 4);
constexpr size_t WS_HPREV = WS_STATES + al64k((size_t)2 * 64 * 8 * 64 * 128 * 4);
constexpr size_t WS_CDEC = WS_HPREV + al64k((size_t)2 * 64 * 8 * 64 * 128 * 2);
constexpr size_t WS_MIXA = WS_CDEC + al64k((size_t)2 * 64 * 8 * 4);
constexpr size_t WS_MIX = WS_MIXA + al64k((size_t)TALL * DM * 2);
constexpr size_t WS_H1 = WS_MIX + al64k((size_t)TALL * DM * 2);
constexpr size_t WS_H1B = WS_H1 + al64k((size_t)TALL * DM * 4);
constexpr size_t WS_H2 = WS_H1B + al64k((size_t)TALL * DM * 2);
constexpr size_t WS_H2B = WS_H2 + al64k((size_t)TALL * DM * 4);
constexpr size_t WS_QM = WS_H2B + al64k((size_t)TALL * DM * 2);
constexpr size_t WS_OM = WS_QM + al64k((size_t)TALL * DM * 2);
constexpr size_t WS_PQ = WS_OM + al64k((size_t)TALL * DM * 2);
constexpr size_t WS_PTOPS = WS_PQ + al64k((size_t)TALL * 2048 * 2);
constexpr size_t WS_PTOPI = WS_PTOPS + al64k((size_t)TALL * 256 * 4);
constexpr size_t WS_PIDX = WS_PTOPI + al64k((size_t)TALL * 256 * 4);
constexpr size_t WS_PG = WS_PIDX + al64k((size_t)TALL * 128 * 4);
constexpr size_t WS_YG = WS_PG + al64k((size_t)TALL * 128 * 4);
constexpr size_t WS_MIX2 = WS_YG + al64k((size_t)TALL * 512 * 2);
constexpr size_t WS_END = WS_MIX2 + al64k((size_t)TALL * DM * 2);
constexpr int CW_XRANK = 2048;
constexpr size_t WS_PW = WS_END;
constexpr size_t WS_H2F8 = WS_PW + al64k((size_t)TALL * 128 * 4);
constexpr size_t WS_END2 = WS_H2F8 + al64k((size_t)TALL * DM);
constexpr int CW_DIAG = 65536;

constexpr int CW_TMO = 0, CW_CODE = 1;
constexpr int CW_BAR = 4096;

constexpr int RING_OFF = 0, RING_BYTES = 131072;
constexpr int LDSCTL_OFF = RING_BYTES, MISC_OFF = LDSCTL_OFF + 320;
constexpr int LDS_BYTES = 147456;

struct Args { const void* in[38]; float* out; unsigned char* ws; int ph_lo, ph_hi; };

struct Frame {
    LAS unsigned char* lds;
    volatile LAS unsigned* MISC;
    gu32* ctl;
    int tid, lane, wave;
    int vcu, G;
    int xcc, xrank;
};

__device__ __forceinline__ float wave_sum(float v) {
#pragma unroll
    for (int o = 1; o < 64; o <<= 1) v += __shfl_xor(v, o);
    return v;
}
__device__ __forceinline__ float bf2f(unsigned short b) { return __uint_as_float((unsigned)b << 16); }
__device__ __forceinline__ float bflo(unsigned u) { return __uint_as_float(u << 16); }
__device__ __forceinline__ float bfhi(unsigned u) { return __uint_as_float(u & 0xffff0000u); }
__device__ __forceinline__ float siluf(float x) { return x / (1.f + __expf(-x)); }

__device__ __forceinline__ void transpose_tile(const float* W, int ldw, int nvalid, bf16* WT, int ldwt, LAS float* scr, int k0, int n0, int lane) {
#pragma unroll 8
    for (int i = 0; i < 32; ++i) { const int kk = 2 * i + (lane >> 5); const int n = n0 + (lane & 31);
        scr[kk * 33 + (lane & 31)] = (n < nvalid) ? W[(size_t)(k0 + kk) * ldw + n] : 0.f; }
    LDS_WAIT(); asm volatile("" ::: "memory");
    const int c = lane & 7;
#pragma unroll
    for (int j = 0; j < 4; ++j) { const int n = (lane >> 3) + 8 * j; const LAS float* s = scr + (8 * c) * 33 + n;
        v4u o; o.x = pk2(s[0 * 33], s[1 * 33]); o.y = pk2(s[2 * 33], s[3 * 33]); o.z = pk2(s[4 * 33], s[5 * 33]); o.w = pk2(s[6 * 33], s[7 * 33]);
        *(GAS v4u*)(WT + (size_t)(n0 + n) * ldwt + k0 + 8 * c) = o; }
    LDS_WAIT(); asm volatile("" ::: "memory");
}
struct TrMat { const float* W; int K, N, Npad, ldw; bf16* WT; int ldwt; };
__device__ __forceinline__ int tr_items(const TrMat& m) { return (m.K / 64) * (m.Npad / 32); }
__device__ __forceinline__ void tr_item(const TrMat& m, int r, LAS float* scr, int lane) { const int nblk = m.Npad / 32; transpose_tile(m.W, m.ldw, m.N, m.WT, m.ldwt, scr, 64 * (r / nblk), 32 * (r % nblk), lane); }
__device__ __forceinline__ void convert_bf16(const Frame& F, const float* src, bf16* dst, size_t n) {
    const size_t gt = (size_t)F.vcu * NTHR + F.tid, NGT = (size_t)F.G * NTHR; const size_t items = n / 8;
    for (size_t i0 = gt; i0 < items; i0 += 4 * NGT) { f32x4 a[4], b[4];
#pragma unroll
        for (int u = 0; u < 4; ++u) { const size_t i = i0 + u * NGT; if (i < items) { a[u] = __builtin_nontemporal_load((const GAS f32x4*)(src + 8 * i)); b[u] = __builtin_nontemporal_load((const GAS f32x4*)(src + 8 * i + 4)); } }
#pragma unroll
        for (int u = 0; u < 4; ++u) { const size_t i = i0 + u * NGT; if (i < items) { v4u o; o.x = pk2(a[u].x, a[u].y); o.y = pk2(a[u].z, a[u].w); o.z = pk2(b[u].x, b[u].y); o.w = pk2(b[u].z, b[u].w); *(GAS v4u*)(dst + 8 * i) = o; } } }
}
constexpr float PU_SCALE = 64.f, PV_SCALE = 16.f, PX_SCALE = 8.f;
__device__ __forceinline__ unsigned pk4_fp8(f32x4 v, float sc) { int r = __builtin_amdgcn_cvt_pk_fp8_f32(v.x * sc, v.y * sc, 0, false); r = __builtin_amdgcn_cvt_pk_fp8_f32(v.z * sc, v.w * sc, r, true); return (unsigned)r; }
__device__ __forceinline__ void convert_fp8(const Frame& F, const float* src, unsigned char* dst, size_t n, float sc) {
    const size_t gt = (size_t)F.vcu * NTHR + F.tid, NGT = (size_t)F.G * NTHR; const size_t items = n / 16;
    for (size_t i0 = gt; i0 < items; i0 += 2 * NGT) { f32x4 a[2][4];
#pragma unroll
        for (int u = 0; u < 2; ++u) { const size_t i = i0 + u * NGT; if (i < items) {
#pragma unroll
            for (int q = 0; q < 4; ++q) a[u][q] = __builtin_nontemporal_load((const GAS f32x4*)(src + 16 * i + 4 * q)); } }
#pragma unroll
        for (int u = 0; u < 2; ++u) { const size_t i = i0 + u * NGT; if (i < items) { v4u o; o.x = pk4_fp8(a[u][0], sc); o.y = pk4_fp8(a[u][1], sc); o.z = pk4_fp8(a[u][2], sc); o.w = pk4_fp8(a[u][3], sc); *(GAS v4u*)(dst + 16 * i) = o; } } }
}

typedef float f32x2v __attribute__((ext_vector_type(2)));
struct P {
    const float *x_prompt, *x_sample, *mem_prompt, *cache_c, *cache_r, *state_conv, *state_ssm, *cache_mk, *cache_mv; const int* page_table;
    const float *w_in, *q_a_norm, *w_uq, *kv_a_norm, *w_uk, *w_uv, *attn_out_norm, *conv_w, *conv_b, *dt_bias, *a_log, *d_skip, *ssm_norm, *w_out, *ln1_g, *ln1_b,
        *mem_wq, *mem_wk, *mem_wv, *mem_wo, *ln2_g, *ln2_b, *peer_wq, *peer_keys, *peer_u, *peer_v, *ln3_g, *ln3_b;
    float* out; unsigned char* ws;
};

__device__ __forceinline__ void p0_prologue(const Frame& F, const P& p) {
    unsigned char* ws = p.ws;
    { LAS float* scr = (LAS float*)(F.lds + RING_OFF + F.wave * 16384);
      const int gw = F.vcu * NWAVES + F.wave, NGW = F.G * NWAVES;
      const TrMat M0{p.w_in, DM, IN_DIM, IN_PAD, IN_DIM, (bf16*)(ws + WS_WIN), DM}, M1{p.w_uq, QLORA, 768, 768, 768, (bf16*)(ws + WS_WUQ), QLORA},
          M2{p.w_uk, KVLORA, 512, 512, 512, (bf16*)(ws + WS_WKV), KVLORA}, M3{p.w_uv, KVLORA, 512, 512, 512, (bf16*)(ws + WS_WKV) + (size_t)512 * KVLORA, KVLORA},
          M4{p.w_out, DM, DM, DM, DM, (bf16*)(ws + WS_WOUT), DM}, M5{p.mem_wq, DM, DM, DM, DM, (bf16*)(ws + WS_MWQ), DM}, M6{p.mem_wo, DM, DM, DM, DM, (bf16*)(ws + WS_MWO), DM},
          M7{p.mem_wk, DM, DM, DM, DM, (bf16*)(ws + WS_MWKV), DM}, M8{p.mem_wv, DM, DM, DM, DM, (bf16*)(ws + WS_MWKV) + (size_t)DM * DM, DM}, M9{p.peer_wq, DM, 2048, 2048, 2048, (bf16*)(ws + WS_PWQ), DM};
      const int n0 = tr_items(M0), n1 = tr_items(M1), n2 = tr_items(M2), n3 = tr_items(M3), n4 = tr_items(M4), n5 = tr_items(M5), n6 = tr_items(M6), n7 = tr_items(M7), n8 = tr_items(M8), n9 = tr_items(M9);
      const int ntot = n0 + n1 + n2 + n3 + n4 + n5 + n6 + n7 + n8 + n9;
      for (int it = gw; it < ntot; it += NGW) { int r = it;
          if (r < n0) { tr_item(M0, r, scr, F.lane); continue; } r -= n0;
          if (r < n1) { tr_item(M1, r, scr, F.lane); continue; } r -= n1;
          if (r < n2) { tr_item(M2, r, scr, F.lane); continue; } r -= n2;
          if (r < n3) { tr_item(M3, r, scr, F.lane); continue; } r -= n3;
          if (r < n4) { tr_item(M4, r, scr, F.lane); continue; } r -= n4;
          if (r < n5) { tr_item(M5, r, scr, F.lane); continue; } r -= n5;
          if (r < n6) { tr_item(M6, r, scr, F.lane); continue; } r -= n6;
          if (r < n7) { tr_item(M7, r, scr, F.lane); continue; } r -= n7;
          if (r < n8) { tr_item(M8, r, scr, F.lane); continue; } r -= n8;
          tr_item(M9, r, scr, F.lane); }
      { bf16* WA = (bf16*)(ws + WS_WABS); const int li = F.lane & 15, g = F.lane >> 4;
        for (int it = gw; it < 8 * 16 * 24; it += NGW) { const int h = it / 384, ct = (it % 384) / 24, kt = it % 24;
            const float* ar = p.w_uk + (size_t)(16 * ct + li) * 512 + h * 64 + 8 * g; const float* br = p.w_uq + (size_t)(16 * kt + li) * 768 + h * 96 + 8 * g;
            typedef float f4 __attribute__((ext_vector_type(4))); typedef short s8 __attribute__((ext_vector_type(8)));
            f4 acc = (f4){0.f, 0.f, 0.f, 0.f};
#pragma unroll
            for (int ks = 0; ks < 2; ++ks) { const f4 a0 = *(const GAS f4*)(ar + 32 * ks), a1 = *(const GAS f4*)(ar + 32 * ks + 4), b0 = *(const GAS f4*)(br + 32 * ks), b1 = *(const GAS f4*)(br + 32 * ks + 4);
                v4u aw, bw; aw.x = pk2(a0[0], a0[1]); aw.y = pk2(a0[2], a0[3]); aw.z = pk2(a1[0], a1[1]); aw.w = pk2(a1[2], a1[3]); bw.x = pk2(b0[0], b0[1]); bw.y = pk2(b0[2], b0[3]); bw.z = pk2(b1[0], b1[1]); bw.w = pk2(b1[2], b1[3]);
                acc = __builtin_amdgcn_mfma_f32_16x16x32_bf16(__builtin_bit_cast(s8, aw), __builtin_bit_cast(s8, bw), acc, 0, 0, 0); }
#pragma unroll
            for (int r = 0; r < 4; ++r) WA[(size_t)(h * 256 + 16 * ct + 4 * g + r) * QLORA + 16 * kt + li] = (bf16)f2bf(acc[r]); } } }
    const size_t gt = (size_t)F.vcu * NTHR + F.tid, NGT = (size_t)F.G * NTHR;
    { bf16* WB = (bf16*)(ws + WS_WUVBD);
      for (size_t i = gt; i < (size_t)512 * 2048 / 8; i += NGT) { const int n = (int)(i / 256), k8 = (int)(i % 256) * 8; const int h = n >> 6, h2 = k8 >> 8;
          v4u o = (v4u){0u, 0u, 0u, 0u};
          if (h == h2) { const int c = k8 & 255; float v[8];
#pragma unroll
              for (int j = 0; j < 8; ++j) v[j] = p.w_uv[(size_t)(c + j) * 512 + n];
              o.x = pk2(v[0], v[1]); o.y = pk2(v[2], v[3]); o.z = pk2(v[4], v[5]); o.w = pk2(v[6], v[7]); }
          *(GAS v4u*)(WB + (size_t)n * 2048 + k8) = o; } }
    { float* tab = (float*)(ws + WS_ROPE);
      for (size_t i = gt; i < (size_t)NPOS * 16; i += NGT) { const int pos = (int)(i >> 4), f = (int)(i & 15);
          const float inv = powf(10000.0f, -(float)f / 16.0f); const float ang = (float)pos * inv; float sn, cs; sincosf(ang, &sn, &cs);
          tab[2 * i] = cs; tab[2 * i + 1] = sn; } }
    convert_bf16(F, p.peer_keys, (bf16*)(ws + WS_PKEYS), (size_t)16 * 128 * 128);
    convert_fp8(F, p.peer_u, ws + WS_PU, (size_t)NEXP * DM, PU_SCALE);
    convert_fp8(F, p.peer_v, ws + WS_PV, (size_t)NEXP * DM, PV_SCALE);
    convert_bf16(F, p.x_prompt, (bf16*)(ws + WS_XB), (size_t)TP * DM);
    convert_bf16(F, p.x_sample, (bf16*)(ws + WS_XB) + (size_t)TP * DM, (size_t)TS * DM);
    convert_bf16(F, p.mem_prompt, (bf16*)(ws + WS_MEMB), (size_t)512 * DM);
}

template <class Fn> struct EpiGen8 {
    static constexpr bool PERM = true, AFTER_DRAIN = false; Fn f;
    __device__ __forceinline__ void operator()(const pg8::f32x4 (&acc)[2][2][4][2], const pg8::Unit& u, int wr, int wc, int fr, int fq) const {
#pragma unroll
        for (int ai = 0; ai < 2; ++ai)
#pragma unroll
            for (int m = 0; m < 4; ++m) { const int row = u.pm * 256 + ai * 128 + wr * 64 + m * 16 + fr;
#pragma unroll
                for (int bj = 0; bj < 2; ++bj) { const int col = u.pn * 256 + bj * 128 + wc * 32 + 8 * fq; f(row, col, acc[ai][bj][m][0], acc[ai][bj][m][1]); } }
    }
};
struct StoreBf16 { bf16* O; int ldc; float scale;
    __device__ __forceinline__ void operator()(int row, int col, f32x4 v0, f32x4 v1) const {
        v4u w; w.x = pk2(v0[0] * scale, v0[1] * scale); w.y = pk2(v0[2] * scale, v0[3] * scale); w.z = pk2(v1[0] * scale, v1[1] * scale); w.w = pk2(v1[2] * scale, v1[3] * scale);
        *(GAS v4u*)(O + (size_t)row * ldc + col) = w; } };
struct StoreMemKV { float* ok; float* ov; bf16* bk; bf16* bv;
    __device__ __forceinline__ void operator()(int row, int col, f32x4 v0, f32x4 v1) const {
        const bool isv = col >= 1024; const int c = col & 1023; float* of = (isv ? ov : ok) + (size_t)row * 1024 + c; bf16* ob = (isv ? bv : bk) + (size_t)row * 1024 + c;
        *(GAS f32x4*)of = v0; *(GAS f32x4*)(of + 4) = v1;
        v4u w; w.x = pk2(v0[0], v0[1]); w.y = pk2(v0[2], v0[3]); w.z = pk2(v1[0], v1[1]); w.w = pk2(v1[2], v1[3]); *(GAS v4u*)ob = w; } };

__device__ __forceinline__ void p2_rows(const Frame& F, const P& p) {
    unsigned char* ws = p.ws;
    const bf16* U = (const bf16*)(ws + WS_U); bf16* CQN = (bf16*)(ws + WS_CQN); bf16* CKV = (bf16*)(ws + WS_CKV); bf16* KR = (bf16*)(ws + WS_KR);
    bf16* XBC = (bf16*)(ws + WS_XBC); float* DT = (float*)(ws + WS_DT); const float* tab = (const float*)(ws + WS_ROPE);
    const int lane = F.lane; const int gw = F.vcu * NWAVES + F.wave, NGW = F.G * NWAVES;
    for (int t = gw; t < TALL; t += NGW) {
        const bool smp = t >= TP; const int ts = t - TP; const int tl = smp ? (ts & 7) : (t & (SEQ - 1)); const int pos = smp ? PAST + tl : tl;
        const unsigned* urow = (const unsigned*)(U + (size_t)t * IN_PAD);
        unsigned wq[3], wk[2]; float kx1 = 0.f, kx2 = 0.f, kcs = 0.f, ksn = 0.f, draw = 0.f;
#pragma unroll
        for (int i = 0; i < 3; ++i) wq[i] = urow[O_CQ / 2 + lane + 64 * i];
#pragma unroll
        for (int i = 0; i < 2; ++i) wk[i] = urow[O_CKV / 2 + lane + 64 * i];
        if (lane < 16) { const unsigned short* ur = (const unsigned short*)(U + (size_t)t * IN_PAD + O_KPE); kx1 = bf2f(ur[lane]); kx2 = bf2f(ur[lane + 16]); kcs = tab[((size_t)pos * 16 + lane) * 2]; ksn = tab[((size_t)pos * 16 + lane) * 2 + 1]; }
        if (lane < 8) draw = bf2f(U[(size_t)t * IN_PAD + O_DT + lane]) + p.dt_bias[lane];
        { float ss = 0.f;
#pragma unroll
          for (int i = 0; i < 3; ++i) { const float a = bflo(wq[i]), b = bfhi(wq[i]); ss += a * a + b * b; }
          const float r = rsqrtf(wave_sum(ss) * (1.f / QLORA) + 1e-6f);
#pragma unroll
          for (int i = 0; i < 3; ++i) { const int e = 2 * (lane + 64 * i); ((unsigned*)(CQN + (size_t)t * QLORA))[lane + 64 * i] = pk2(bflo(wq[i]) * r * p.q_a_norm[e], bfhi(wq[i]) * r * p.q_a_norm[e + 1]); } }
        { float ss = 0.f;
#pragma unroll
          for (int i = 0; i < 2; ++i) { const float a = bflo(wk[i]), b = bfhi(wk[i]); ss += a * a + b * b; }
          const float r = rsqrtf(wave_sum(ss) * (1.f / KVLORA) + 1e-6f);
          float* of = smp ? p.out + OUT_KVS + (size_t)ts * KVLORA : p.out + OUT_KVP + (size_t)t * KVLORA;
#pragma unroll
          for (int i = 0; i < 2; ++i) { const int e = 2 * (lane + 64 * i); const float a = bflo(wk[i]) * r * p.kv_a_norm[e], b = bfhi(wk[i]) * r * p.kv_a_norm[e + 1];
              *(GAS f32x2v*)(of + e) = (f32x2v){a, b}; ((unsigned*)(CKV + (size_t)t * KVLORA))[lane + 64 * i] = pk2(a, b); } }
        if (lane < 16) { const float o1 = kx1 * kcs - kx2 * ksn, o2 = kx2 * kcs + kx1 * ksn;
          float* of = smp ? p.out + OUT_KRS + (size_t)ts * ROPE : p.out + OUT_KRP + (size_t)t * ROPE; of[lane] = o1; of[lane + 16] = o2;
          KR[(size_t)t * ROPE + lane] = (bf16)f2bf(o1); KR[(size_t)t * ROPE + lane + 16] = (bf16)f2bf(o2); }
        if (lane < 8) DT[(size_t)t * 8 + lane] = draw > 20.f ? draw : log1pf(__expf(draw));
#pragma unroll
        for (int hf = 0; hf < 2; ++hf) { float cx[4][4][2];
#pragma unroll
            for (int i4 = 0; i4 < 4; ++i4) { const int pr = lane + 64 * (4 * hf + i4), c = 2 * pr;
#pragma unroll
                for (int k = 0; k < 4; ++k) { const int f = tl + k;
                    if (f >= 3) { const unsigned w = ((const unsigned*)(U + (size_t)(t - 3 + k) * IN_PAD + O_XBC))[pr]; cx[i4][k][0] = bflo(w); cx[i4][k][1] = bfhi(w); }
                    else if (smp) { const float* sc = p.state_conv + ((size_t)(ts >> 3) * 3 + f) * CONVD + c; cx[i4][k][0] = sc[0]; cx[i4][k][1] = sc[1]; }
                    else { cx[i4][k][0] = 0.f; cx[i4][k][1] = 0.f; } } }
#pragma unroll
            for (int i4 = 0; i4 < 4; ++i4) { const int pr = lane + 64 * (4 * hf + i4), c = 2 * pr; float a0 = p.conv_b[c], a1 = p.conv_b[c + 1];
#pragma unroll
                for (int k = 0; k < 4; ++k) { a0 += p.conv_w[k * CONVD + c] * cx[i4][k][0]; a1 += p.conv_w[k * CONVD + c + 1] * cx[i4][k][1]; }
                ((unsigned*)(XBC + (size_t)t * CONVD))[pr] = pk2(siluf(a0), siluf(a1));
                if (!smp && tl >= SEQ - 3) *(GAS f32x2v*)(p.out + OUT_CVP + ((size_t)(t >> 13) * 3 + (tl - (SEQ - 3))) * CONVD + c) = (f32x2v){cx[i4][3][0], cx[i4][3][1]};
                if (smp && tl >= DSEQ - 3) *(GAS f32x2v*)(p.out + OUT_CVS + ((size_t)(ts >> 3) * 3 + (tl - (DSEQ - 3))) * CONVD + c) = (f32x2v){cx[i4][3][0], cx[i4][3][1]}; }
            asm volatile("" ::: "memory"); }
    }
}

typedef unsigned u32x2 __attribute__((ext_vector_type(2)));
typedef short s16x4 __attribute__((ext_vector_type(4)));
typedef short v4i16_t __attribute__((ext_vector_type(4)));
struct EpiQRope {
    static constexpr bool PERM = false, AFTER_DRAIN = false;
    bf16* Q; const float* tab; float scale;
    __device__ __forceinline__ void operator()(const pg8::f32x4 (&acc)[2][2][4][2], const pg8::Unit& u, int wr, int wc, int fr, int fq) const {
#pragma unroll
        for (int ai = 0; ai < 2; ++ai)
#pragma unroll
            for (int m = 0; m < 4; ++m) { const int row = u.pm * 256 + ai * 128 + wr * 64 + m * 16 + fr;
                const int pos = row < TP ? (row & (SEQ - 1)) : PAST + ((row - TP) & 7);
#pragma unroll
                for (int bj = 0; bj < 2; ++bj) { const int grp = 8 * u.pn + 4 * bj + wc; const int col = 32 * grp + 4 * fq;
                    f32x4 a = acc[ai][bj][m][0], b = acc[ai][bj][m][1];
                    if (grp % 3 == 2) { const f32x4 t0 = *(const GAS f32x4*)(tab + ((size_t)pos * 16 + 4 * fq) * 2), t1 = *(const GAS f32x4*)(tab + ((size_t)pos * 16 + 4 * fq) * 2 + 4);
                        const float cs[4] = {t0[0], t0[2], t1[0], t1[2]}, sn[4] = {t0[1], t0[3], t1[1], t1[3]}; f32x4 o1, o2;
#pragma unroll
                        for (int i = 0; i < 4; ++i) { o1[i] = a[i] * cs[i] - b[i] * sn[i]; o2[i] = b[i] * cs[i] + a[i] * sn[i]; }
                        a = o1; b = o2; }
                    u32x2 w0, w1; w0.x = pk2(a[0] * scale, a[1] * scale); w0.y = pk2(a[2] * scale, a[3] * scale); w1.x = pk2(b[0] * scale, b[1] * scale); w1.y = pk2(b[2] * scale, b[3] * scale);
                    *(GAS u32x2*)(Q + (size_t)row * 768 + col) = w0; *(GAS u32x2*)(Q + (size_t)row * 768 + col + 16) = w1; }
                asm volatile("" ::: "memory"); }
    }
};

__device__ __forceinline__ s16x4 tr_read(const LAS unsigned char* p) { return __builtin_bit_cast(s16x4, __builtin_amdgcn_ds_read_tr16_b64_v4i16((LAS v4i16_t*)p)); }
__device__ __forceinline__ bf16x8 cat8(s16x4 a, s16x4 b) { return (bf16x8){a[0], a[1], a[2], a[3], b[0], b[1], b[2], b[3]}; }
__device__ __forceinline__ bf16x8 pack8(f32x4 a, f32x4 b) { v4u w; w.x = pk2(a[0], a[1]); w.y = pk2(a[2], a[3]); w.z = pk2(b[0], b[1]); w.w = pk2(b[2], b[3]); return __builtin_bit_cast(bf16x8, w); }
#define MFMA16(a, b, c) __builtin_amdgcn_mfma_f32_16x16x32_bf16((a), (b), (c), 0, 0, 0)

__device__ __forceinline__ bf16x8 rope_frag(bf16x8 v, int pos, int g, const float* tab) {
    const v4u m = __builtin_bit_cast(v4u, v); v4u o; o.x = (unsigned)__shfl_xor((int)m.x, 32); o.y = (unsigned)__shfl_xor((int)m.y, 32); o.z = (unsigned)__shfl_xor((int)m.z, 32); o.w = (unsigned)__shfl_xor((int)m.w, 32);
    const float* tp = tab + ((size_t)pos * 16 + 8 * (g & 1)) * 2; const f32x4 t0 = *(const GAS f32x4*)tp, t1 = *(const GAS f32x4*)(tp + 4), t2 = *(const GAS f32x4*)(tp + 8), t3 = *(const GAS f32x4*)(tp + 12);
    const float sg = g < 2 ? -1.f : 1.f;
    v4u r;
    r.x = pk2(bflo(m.x) * t0[0] + sg * bflo(o.x) * t0[1], bfhi(m.x) * t0[2] + sg * bfhi(o.x) * t0[3]);
    r.y = pk2(bflo(m.y) * t1[0] + sg * bflo(o.y) * t1[1], bfhi(m.y) * t1[2] + sg * bfhi(o.y) * t1[3]);
    r.z = pk2(bflo(m.z) * t2[0] + sg * bflo(o.z) * t2[1], bfhi(m.z) * t2[2] + sg * bfhi(o.z) * t2[3]);
    r.w = pk2(bflo(m.w) * t3[0] + sg * bflo(o.w) * t3[1], bfhi(m.w) * t3[2] + sg * bfhi(o.w) * t3[3]);
    return __builtin_bit_cast(bf16x8, r);
}

constexpr int PA_KST = 104, PA_VST = 72;
constexpr int PA_KBYTES = 64 * PA_KST * 2, PA_VBYTES = 64 * PA_VST * 2, PA_BUF = PA_KBYTES + PA_VBYTES;
__device__ __forceinline__ void attn_prompt_unit(const Frame& F, const P& p, int b, int h, int qb) {
    unsigned char* ws = p.ws;
    const bf16* Q = (const bf16*)(ws + WS_Q); const bf16* KNV = (const bf16*)(ws + WS_KNV); const bf16* KR = (const bf16*)(ws + WS_KR); bf16* OATT = (bf16*)(ws + WS_OATT);
    const int tid = F.tid, lane = F.lane, w = F.wave, li = lane & 15, g = lane >> 4;
    const size_t rowbase = (size_t)b * SEQ; const int q0 = qb * 256 + w * 32;
    LAS unsigned char* lds = F.lds + RING_OFF;
    bf16x8 qf[2][3];
#pragma unroll
    for (int j = 0; j < 2; ++j)
#pragma unroll
        for (int ks = 0; ks < 3; ++ks) qf[j][ks] = *(const GAS bf16x8*)(Q + (rowbase + q0 + 16 * j + li) * 768 + h * 96 + 32 * ks + 8 * g);
#pragma unroll
    for (int j = 0; j < 2; ++j) qf[j][2] = rope_frag(qf[j][2], q0 + 16 * j + li, g, (const float*)(ws + WS_ROPE));
    f32x4 o[4][2];
#pragma unroll
    for (int d = 0; d < 4; ++d)
#pragma unroll
        for (int j = 0; j < 2; ++j) o[d][j] = (f32x4){0.f, 0.f, 0.f, 0.f};
    float mrun[2] = {-INFINITY, -INFINITY}, lrun[2] = {0.f, 0.f};
    const int NT = 4 * (qb + 1); const int tq = 4 * qb + (w >> 1);
    const int srow = tid >> 3, sch = tid & 7, rrow = tid >> 2, rch = tid & 3;
    v4u sk, sv, sr = (v4u){0u, 0u, 0u, 0u};
#define PA_LOAD(t) do { const size_t kr_ = rowbase + (size_t)(t) * 64; \
        sk = *(const GAS v4u*)(KNV + (kr_ + srow) * 1024 + h * 64 + sch * 8); sv = *(const GAS v4u*)(KNV + (kr_ + srow) * 1024 + 512 + h * 64 + sch * 8); \
        if (tid < 256) sr = *(const GAS v4u*)(KR + (kr_ + rrow) * 32 + rch * 8); } while (0)
#define PA_STORE(buf) do { LAS unsigned char* kb_ = lds + (buf) * PA_BUF; \
        *(LAS v4u*)(kb_ + (srow * PA_KST + sch * 8) * 2) = sk; *(LAS v4u*)(kb_ + PA_KBYTES + (srow * PA_VST + sch * 8) * 2) = sv; \
        if (tid < 256) *(LAS v4u*)(kb_ + (rrow * PA_KST + 64 + rch * 8) * 2) = sr; } while (0)
    __syncthreads();
    PA_LOAD(0); PA_STORE(0); __syncthreads();
    for (int t = 0; t < NT; ++t) {
        const int buf = t & 1;
        if (t + 1 < NT) PA_LOAD(t + 1);
        if (t <= tq) {
            const LAS unsigned char* kb = lds + buf * PA_BUF; const LAS unsigned char* vb = kb + PA_KBYTES;
            f32x4 s[4][2];
#pragma unroll
            for (int kt = 0; kt < 4; ++kt) {
                bf16x8 kf[3];
#pragma unroll
                for (int ks = 0; ks < 3; ++ks) kf[ks] = *(const LAS bf16x8*)(kb + ((16 * kt + li) * PA_KST + 32 * ks + 8 * g) * 2);
#pragma unroll
                for (int j = 0; j < 2; ++j) { f32x4 a = (f32x4){0.f, 0.f, 0.f, 0.f};
#pragma unroll
                    for (int ks = 0; ks < 3; ++ks) a = MFMA16(kf[ks], qf[j][ks], a);
                    s[kt][j] = a; } }
            if (t == tq) {
#pragma unroll
                for (int j = 0; j < 2; ++j) { const int qa = q0 + 16 * j + li;
#pragma unroll
                    for (int kt = 0; kt < 4; ++kt)
#pragma unroll
                        for (int r = 0; r < 4; ++r) if (64 * t + 16 * kt + 4 * g + r > qa) s[kt][j][r] = -INFINITY; } }
            bf16x8 pf[2][2];
#pragma unroll
            for (int j = 0; j < 2; ++j) {
                float mx = -INFINITY;
#pragma unroll
                for (int kt = 0; kt < 4; ++kt)
#pragma unroll
                    for (int r = 0; r < 4; ++r) mx = fmaxf(mx, s[kt][j][r]);
                mx = fmaxf(mx, __shfl_xor(mx, 16)); mx = fmaxf(mx, __shfl_xor(mx, 32));
                const float mn = fmaxf(mrun[j], mx); const float alpha = __builtin_amdgcn_exp2f(mrun[j] - mn); mrun[j] = mn;
                float ps = 0.f;
#pragma unroll
                for (int kt = 0; kt < 4; ++kt)
#pragma unroll
                    for (int r = 0; r < 4; ++r) { const float e = __builtin_amdgcn_exp2f(s[kt][j][r] - mn); s[kt][j][r] = e; ps += e; }
                lrun[j] = lrun[j] * alpha + ps;
#pragma unroll
                for (int d = 0; d < 4; ++d) o[d][j] = o[d][j] * alpha;
                pf[j][0] = pack8(s[0][j], s[1][j]); pf[j][1] = pack8(s[2][j], s[3][j]);
            }
#pragma unroll
            for (int kk = 0; kk < 2; ++kk)
#pragma unroll
                for (int d = 0; d < 4; ++d) {
                    const LAS unsigned char* va = vb + ((32 * kk + 4 * g + (li >> 2)) * PA_VST + 16 * d + 4 * (li & 3)) * 2;
                    const bf16x8 vf = cat8(tr_read(va), tr_read(va + 16 * PA_VST * 2));
#pragma unroll
                    for (int j = 0; j < 2; ++j) o[d][j] = MFMA16(vf, pf[j][kk], o[d][j]); }
        }
        if (t + 1 < NT) PA_STORE(buf ^ 1);
        __syncthreads();
    }
#undef PA_LOAD
#undef PA_STORE
#pragma unroll
    for (int j = 0; j < 2; ++j) { float l = lrun[j]; l += __shfl_xor(l, 16); l += __shfl_xor(l, 32); const float rl = 1.f / l;
        bf16* orow = OATT + (rowbase + q0 + 16 * j + li) * 512 + h * 64 + 4 * g;
#pragma unroll
        for (int d = 0; d < 4; ++d) { u32x2 wv; wv.x = pk2(o[d][j][0] * rl, o[d][j][1] * rl); wv.y = pk2(o[d][j][2] * rl, o[d][j][3] * rl); *(GAS u32x2*)(orow + 16 * d) = wv; } }
}

constexpr int SA_ST = 296;
constexpr int SA_BUF = 64 * SA_ST * 2;
constexpr int AP_ST = 264;
__device__ __forceinline__ void attn_sample_unit(const Frame& F, const P& p, int b, int split) {
    unsigned char* ws = p.ws;
    const bf16* Q = (const bf16*)(ws + WS_Q); const bf16* QLAT = (const bf16*)(ws + WS_QLAT); const bf16* CKV = (const bf16*)(ws + WS_CKV); const bf16* KR = (const bf16*)(ws + WS_KR);
    float* APART = (float*)(ws + WS_APART);
    const int tid = F.tid, lane = F.lane, w = F.wave, li = lane & 15, g = lane >> 4, jq = w & 3, ch = w >> 2;
    LAS unsigned char* lds = F.lds + RING_OFF;
    bf16x8 qf[9];
    { const int r = 16 * jq + li, tk = r >> 3, hh = r & 7; const bf16* ql = QLAT + (size_t)(b * 8 + tk) * 2048 + hh * 256; const bf16* qp = Q + (size_t)(TP + b * 8 + tk) * 768 + hh * 96 + 64;
#pragma unroll
      for (int ks = 0; ks < 8; ++ks) qf[ks] = *(const GAS bf16x8*)(ql + 32 * ks + 8 * g);
      qf[8] = rope_frag(*(const GAS bf16x8*)(qp + 8 * g), PAST + tk, g, (const float*)(ws + WS_ROPE)); }
    f32x4 o[8];
#pragma unroll
    for (int c = 0; c < 8; ++c) o[c] = (f32x4){0.f, 0.f, 0.f, 0.f};
    float mrun = -INFINITY, lrun = 0.f;
    const int NT = 64 + split;
    const int* pt = p.page_table + b * NPAGES + split * 32;
    f32x4 st[9];
#define SA_LOAD(t) do { if ((t) < 64) { const int pg_ = pt[(t) >> 1]; const float* cl_ = p.cache_c + ((size_t)pg_ * PAGE + ((t) & 1) * 64) * KVLORA; const float* cr_ = p.cache_r + ((size_t)pg_ * PAGE + ((t) & 1) * 64) * ROPE; \
        _Pragma("unroll") for (int i_ = 0; i_ < 8; ++i_) st[i_] = __builtin_nontemporal_load((const GAS f32x4*)(cl_ + (size_t)(tid + 512 * i_) * 4)); \
        st[8] = __builtin_nontemporal_load((const GAS f32x4*)(cr_ + (size_t)tid * 4)); } } while (0)
#define SA_STORE(t, buf) do { LAS unsigned char* kb_ = lds + (buf) * SA_BUF; if ((t) < 64) { \
        _Pragma("unroll") for (int i_ = 0; i_ < 8; ++i_) { const int q_ = tid + 512 * i_; u32x2 w_; w_.x = pk2(st[i_][0], st[i_][1]); w_.y = pk2(st[i_][2], st[i_][3]); *(LAS u32x2*)(kb_ + ((q_ >> 6) * SA_ST + (q_ & 63) * 4) * 2) = w_; } \
        { u32x2 w_; w_.x = pk2(st[8][0], st[8][1]); w_.y = pk2(st[8][2], st[8][3]); *(LAS u32x2*)(kb_ + ((tid >> 3) * SA_ST + 256 + (tid & 7) * 4) * 2) = w_; } } \
      else {   \
        for (int q_ = tid; q_ < 64 * 36; q_ += 512) { const int row_ = q_ / 36, c8_ = q_ % 36; v4u v_ = (v4u){0u, 0u, 0u, 0u}; \
            if (row_ < 8) v_ = c8_ < 32 ? *(const GAS v4u*)(CKV + (size_t)(TP + b * 8 + row_) * KVLORA + c8_ * 8) : *(const GAS v4u*)(KR + (size_t)(TP + b * 8 + row_) * ROPE + (c8_ - 32) * 8); \
            *(LAS v4u*)(kb_ + (row_ * SA_ST + c8_ * 8) * 2) = v_; } } } while (0)
    __syncthreads();
    SA_LOAD(0); SA_STORE(0, 0); __syncthreads();
    for (int t = 0; t < NT; ++t) {
        const int buf = t & 1;
        if (t + 1 < NT) SA_LOAD(t + 1);
        const LAS unsigned char* kb = lds + buf * SA_BUF;
        f32x4 s[4];
#pragma unroll
        for (int kt = 0; kt < 4; ++kt) { f32x4 a = (f32x4){0.f, 0.f, 0.f, 0.f};
#pragma unroll
            for (int ks = 0; ks < 9; ++ks) { const bf16x8 kf = *(const LAS bf16x8*)(kb + ((16 * kt + li) * SA_ST + 32 * ks + 8 * g) * 2); a = MFMA16(kf, qf[ks], a); }
            s[kt] = a; }
        if (t == 64) { const int tk = (16 * jq + li) >> 3;
#pragma unroll
            for (int kt = 0; kt < 4; ++kt)
#pragma unroll
                for (int r = 0; r < 4; ++r) if (16 * kt + 4 * g + r > tk) s[kt][r] = -INFINITY; }
        float mx = -INFINITY;
#pragma unroll
        for (int kt = 0; kt < 4; ++kt)
#pragma unroll
            for (int r = 0; r < 4; ++r) mx = fmaxf(mx, s[kt][r]);
        mx = fmaxf(mx, __shfl_xor(mx, 16)); mx = fmaxf(mx, __shfl_xor(mx, 32));
        const float mn = fmaxf(mrun, mx); const float alpha = __builtin_amdgcn_exp2f(mrun - mn); mrun = mn;
        float ps = 0.f;
#pragma unroll
        for (int kt = 0; kt < 4; ++kt)
#pragma unroll
            for (int r = 0; r < 4; ++r) { const float e = __builtin_amdgcn_exp2f(s[kt][r] - mn); s[kt][r] = e; ps += e; }
        lrun = lrun * alpha + ps;
#pragma unroll
        for (int c = 0; c < 8; ++c) o[c] = o[c] * alpha;
        const bf16x8 pf0 = pack8(s[0], s[1]), pf1 = pack8(s[2], s[3]);
#pragma unroll
        for (int c = 0; c < 8; ++c) {
            const LAS unsigned char* va = kb + ((4 * g + (li >> 2)) * SA_ST + 128 * ch + 16 * c + 4 * (li & 3)) * 2;
            const bf16x8 v0 = cat8(tr_read(va), tr_read(va + 16 * SA_ST * 2)); const bf16x8 v1 = cat8(tr_read(va + 32 * SA_ST * 2), tr_read(va + 48 * SA_ST * 2));
            o[c] = MFMA16(v0, pf0, o[c]); o[c] = MFMA16(v1, pf1, o[c]); }
        if (t + 1 < NT) SA_STORE(t + 1, buf ^ 1);
        __syncthreads();
    }
#undef SA_LOAD
#undef SA_STORE
    { float l = lrun; l += __shfl_xor(l, 16); l += __shfl_xor(l, 32);
      float* pr = APART + ((size_t)(b * 2 + split) * 64 + 16 * jq + li) * AP_ST;
#pragma unroll
      for (int c = 0; c < 8; ++c) *(GAS f32x4*)(pr + 128 * ch + 16 * c + 4 * g) = o[c];
      if (ch == 0 && g == 0) { pr[256] = mrun; pr[257] = l; } }
}
__device__ __forceinline__ void attn_sample_finish(const Frame& F, const P& p) {
    const float* APART = (const float*)(p.ws + WS_APART); bf16* OLAT = (bf16*)(p.ws + WS_OLAT); bf16* OATT = (bf16*)(p.ws + WS_OATT); const bf16* WKV = (const bf16*)(p.ws + WS_WKV);
    const int gw = F.vcu * NWAVES + F.wave, NGW = F.G * NWAVES, lane = F.lane, li = lane & 15, g = lane >> 4;
    for (int it = gw; it < DBATCH * 8; it += NGW) { const int b = it >> 3, h = it & 7, tok = li & 7, r = 8 * tok + h;
        const float* p0 = APART + ((size_t)(b * 2 + 0) * 64 + r) * AP_ST; const float* p1 = APART + ((size_t)(b * 2 + 1) * 64 + r) * AP_ST;
        const float m0 = p0[256], l0 = p0[257], m1 = p1[256], l1 = p1[257]; const float m = fmaxf(m0, m1); const float w0 = __builtin_amdgcn_exp2f(m0 - m), w1 = __builtin_amdgcn_exp2f(m1 - m);
        const float rl = 1.f / (w0 * l0 + w1 * l1); const float c0 = w0 * rl, c1 = w1 * rl;
        bf16x8 afr[8];
#pragma unroll
        for (int ks = 0; ks < 8; ++ks) { const f32x4 a0 = *(const GAS f32x4*)(p0 + 32 * ks + 8 * g), a1 = *(const GAS f32x4*)(p0 + 32 * ks + 8 * g + 4), b0 = *(const GAS f32x4*)(p1 + 32 * ks + 8 * g), b1 = *(const GAS f32x4*)(p1 + 32 * ks + 8 * g + 4);
            afr[ks] = pack8(a0 * c0 + b0 * c1, a1 * c0 + b1 * c1);
            if (li < 8) *(GAS bf16x8*)(OLAT + (size_t)(b * 8 + tok) * 2048 + h * 256 + 32 * ks + 8 * g) = afr[ks]; }
#pragma unroll
        for (int nt = 0; nt < 4; ++nt) { f32x4 acc = (f32x4){0.f, 0.f, 0.f, 0.f}; const bf16* wr = WKV + (size_t)(512 + h * 64 + 16 * nt + li) * KVLORA + 8 * g;
#pragma unroll
            for (int ks = 0; ks < 8; ++ks) acc = MFMA16(afr[ks], *(const GAS bf16x8*)(wr + 32 * ks), acc);
            if (g < 2) {
#pragma unroll
                for (int rr = 0; rr < 4; ++rr) OATT[(size_t)(TP + b * 8 + 4 * g + rr) * 512 + h * 64 + 16 * nt + li] = (bf16)f2bf(acc[rr]); } }
    }
}

constexpr int SB_BUF = 32 * SA_ST * 2;
constexpr int PD_BUF = 20 * 1024;
__device__ __forceinline__ void attn_merged(const Frame& F, const P& p, int u) {
    unsigned char* ws = p.ws; asm volatile("" : "+s"(ws));
    const bf16* Q = (const bf16*)(ws + WS_Q); const bf16* KNV = (const bf16*)(ws + WS_KNV); const bf16* KR = (const bf16*)(ws + WS_KR); bf16* OATT = (bf16*)(ws + WS_OATT);
    const bf16* QLAT = (const bf16*)(ws + WS_QLAT); const bf16* CKV = (const bf16*)(ws + WS_CKV); float* APART = (float*)(ws + WS_APART); const float* tab = (const float*)(ws + WS_ROPE);
    const int tid = F.tid, lane = F.lane, w = F.wave, li = lane & 15, g = lane >> 4;
    LAS unsigned char* lds = F.lds + RING_OFF; LAS unsigned char* sbase = lds + 2 * PD_BUF;
    const int bh = u >> 4, s_ = u & 15, bc = bh >> 3, h = bh & 7; const size_t rowbase = (size_t)bc * SEQ;
    int qb = 31 - s_, cu = 0, ct = 0; int NT = 4 * (qb + 1), tq = 4 * qb + (w >> 1), q0 = qb * 256 + w * 32;
    bf16x8 qf[2][3]; f32x4 o[4][2]; float mrun[2], lrun[2];
#define PM_INIT() do { \
        _Pragma("unroll") for (int j = 0; j < 2; ++j) { _Pragma("unroll") for (int ks = 0; ks < 3; ++ks) qf[j][ks] = *(const GAS bf16x8*)(Q + (rowbase + q0 + 16 * j + li) * 768 + h * 96 + 32 * ks + 8 * g); \
            qf[j][2] = rope_frag(qf[j][2], q0 + 16 * j + li, g, tab); mrun[j] = -INFINITY; lrun[j] = 0.f; \
            _Pragma("unroll") for (int d = 0; d < 4; ++d) o[d][j] = (f32x4){0.f, 0.f, 0.f, 0.f}; } } while (0)
    PM_INIT();
#define PD_PIECE(t, buf, id) do { const int id_ = (id); const size_t kr_ = rowbase + (size_t)(t) * 64; const bf16* src_; \
        if (id_ < 8) src_ = KNV + (kr_ + lane) * 1024 + h * 64 + id_ * 8; else if (id_ < 12) src_ = KR + (kr_ + lane) * 32 + (id_ - 8) * 8; \
        else { const int v_ = id_ - 12; src_ = KNV + (kr_ + 16 * (v_ & 3) + (lane >> 2)) * 1024 + 512 + h * 64 + (v_ >> 2) * 32 + (lane & 3) * 8; } \
        __builtin_amdgcn_global_load_lds((const GAS unsigned*)src_, (LAS unsigned*)(lds + (buf) * PD_BUF + id_ * 1024), 16, 0, 0); } while (0)
#define PA_LOAD(t, buf) do { PD_PIECE(t, buf, w); PD_PIECE(t, buf, w + 8); if (w < 4) PD_PIECE(t, buf, w + 16); } while (0)
    const int bs = u >> 1, split = u & 1, jq = w & 3, ch = w >> 2; const int NTS = 128 + split;
    LAS unsigned char* sqb = sbase + 2 * SB_BUF + ((16 * jq + li) * SA_ST + 8 * g) * 2;
    __syncthreads();
    { const int r = 16 * jq + li, tk = r >> 3, hh = r & 7; const bf16* ql = QLAT + (size_t)(bs * 8 + tk) * 2048 + hh * 256; const bf16* qp = Q + (size_t)(TP + bs * 8 + tk) * 768 + hh * 96 + 64;
      if (ch == 0) {
#pragma unroll
      for (int ks = 0; ks < 8; ++ks) *(LAS bf16x8*)(sqb + 64 * ks) = *(const GAS bf16x8*)(ql + 32 * ks + 8 * g);
      }
      const bf16x8 rq = rope_frag(*(const GAS bf16x8*)(qp + 8 * g), PAST + tk, g, tab); if (ch == 0) *(LAS bf16x8*)(sqb + 64 * 8) = rq; }
    f32x4 so[8];
#pragma unroll
    for (int c = 0; c < 8; ++c) so[c] = (f32x4){0.f, 0.f, 0.f, 0.f};
    float smrun = -INFINITY, slrun = 0.f;
    const int* pt = p.page_table + bs * NPAGES + split * 32;
    f32x4 st[5];
#define SB_LOAD(j) do { if ((j) < 128) { const int pg_ = pt[(j) >> 2]; const float* cl_ = p.cache_c + ((size_t)pg_ * PAGE + ((j) & 3) * 32) * KVLORA; const float* cr_ = p.cache_r + ((size_t)pg_ * PAGE + ((j) & 3) * 32) * ROPE; \
        _Pragma("unroll") for (int i_ = 0; i_ < 4; ++i_) st[i_] = __builtin_nontemporal_load((const GAS f32x4*)(cl_ + (size_t)(tid + 512 * i_) * 4)); \
        if (tid < 256) st[4] = __builtin_nontemporal_load((const GAS f32x4*)(cr_ + (size_t)tid * 4)); } } while (0)
#define SB_STORE(j, buf) do { LAS unsigned char* kb_ = sbase + (buf) * SB_BUF; if ((j) < 128) { \
        _Pragma("unroll") for (int i_ = 0; i_ < 4; ++i_) { const int q_ = tid + 512 * i_; u32x2 w_; w_.x = pk2(st[i_][0], st[i_][1]); w_.y = pk2(st[i_][2], st[i_][3]); *(LAS u32x2*)(kb_ + ((q_ >> 6) * SA_ST + (q_ & 63) * 4) * 2) = w_; } \
        if (tid < 256) { u32x2 w_; w_.x = pk2(st[4][0], st[4][1]); w_.y = pk2(st[4][2], st[4][3]); *(LAS u32x2*)(kb_ + ((tid >> 3) * SA_ST + 256 + (tid & 7) * 4) * 2) = w_; } } \
      else { for (int q_ = tid; q_ < 32 * 36; q_ += 512) { const int row_ = q_ / 36, c8_ = q_ % 36; v4u v_ = (v4u){0u, 0u, 0u, 0u}; \
            if (row_ < 8) v_ = c8_ < 32 ? *(const GAS v4u*)(CKV + (size_t)(TP + bs * 8 + row_) * KVLORA + c8_ * 8) : *(const GAS v4u*)(KR + (size_t)(TP + bs * 8 + row_) * ROPE + (c8_ - 32) * 8); \
            *(LAS v4u*)(kb_ + (row_ * SA_ST + c8_ * 8) * 2) = v_; } } } while (0)
    PA_LOAD(0, 0); SB_LOAD(0); SB_STORE(0, 0); __syncthreads();
    int sj = 0;
    for (int i = 0; i < 132; ++i) {
        const int buf = i & 1;
        const bool cnext = (ct + 1 < NT) || (cu == 0); const int tnext = (ct + 1 < NT) ? ct + 1 : 0;
        if (cnext) PA_LOAD(tnext, buf ^ 1);
        const bool dos = sj < NTS;
        if (dos && sj + 1 < NTS) SB_LOAD(sj + 1);
        if (ct <= tq) {
            const LAS unsigned char* kb = lds + buf * PD_BUF; const LAS unsigned char* vb = kb + 12 * 1024;
            f32x4 s[4][2];
#pragma unroll
            for (int kt = 0; kt < 4; ++kt) {
                bf16x8 kf[3];
#pragma unroll
                for (int ks = 0; ks < 3; ++ks) kf[ks] = *(const LAS bf16x8*)(kb + (4 * ks + g) * 1024 + (16 * kt + li) * 16);
#pragma unroll
                for (int j = 0; j < 2; ++j) { f32x4 a = (f32x4){0.f, 0.f, 0.f, 0.f};
#pragma unroll
                    for (int ks = 0; ks < 3; ++ks) a = MFMA16(kf[ks], qf[j][ks], a);
                    s[kt][j] = a; } }
            if (ct == tq) {
#pragma unroll
                for (int j = 0; j < 2; ++j) { const int qa = q0 + 16 * j + li;
#pragma unroll
                    for (int kt = 0; kt < 4; ++kt)
#pragma unroll
                        for (int r = 0; r < 4; ++r) if (64 * ct + 16 * kt + 4 * g + r > qa) s[kt][j][r] = -INFINITY; } }
            bf16x8 pf[2][2];
#pragma unroll
            for (int j = 0; j < 2; ++j) {
                float mx = -INFINITY;
#pragma unroll
                for (int kt = 0; kt < 4; ++kt)
#pragma unroll
                    for (int r = 0; r < 4; ++r) mx = fmaxf(mx, s[kt][j][r]);
                mx = fmaxf(mx, __shfl_xor(mx, 16)); mx = fmaxf(mx, __shfl_xor(mx, 32));
                const float mn = fmaxf(mrun[j], mx); const float alpha = __builtin_amdgcn_exp2f(mrun[j] - mn); mrun[j] = mn;
                float ps = 0.f;
#pragma unroll
                for (int kt = 0; kt < 4; ++kt)
#pragma unroll
                    for (int r = 0; r < 4; ++r) { const float e = __builtin_amdgcn_exp2f(s[kt][j][r] - mn); s[kt][j][r] = e; ps += e; }
                lrun[j] = lrun[j] * alpha + ps;
#pragma unroll
                for (int d = 0; d < 4; ++d) o[d][j] = o[d][j] * alpha;
                pf[j][0] = pack8(s[0][j], s[1][j]); pf[j][1] = pack8(s[2][j], s[3][j]);
            }
#pragma unroll
            for (int kk = 0; kk < 2; ++kk)
#pragma unroll
                for (int d = 0; d < 4; ++d) {
                    const LAS unsigned char* va = vb + ((d >> 1) * 4 + 2 * kk) * 1024 + (4 * g + (li >> 2)) * 64 + ((d & 1) * 16 + 4 * (li & 3)) * 2;
                    const bf16x8 vf = cat8(tr_read(va), tr_read(va + 1024));
#pragma unroll
                    for (int j = 0; j < 2; ++j) o[d][j] = MFMA16(vf, pf[j][kk], o[d][j]); }
        }
        asm volatile("" ::: "memory"); __builtin_amdgcn_sched_barrier(0);
        if (dos) {
            const LAS unsigned char* kb = sbase + (sj & 1) * SB_BUF;
            f32x4 s[2];
#pragma unroll
            for (int kt = 0; kt < 2; ++kt) { f32x4 a = (f32x4){0.f, 0.f, 0.f, 0.f};
#pragma unroll
                for (int ks = 0; ks < 9; ++ks) { const bf16x8 kf = *(const LAS bf16x8*)(kb + ((16 * kt + li) * SA_ST + 32 * ks + 8 * g) * 2); a = MFMA16(kf, *(const LAS bf16x8*)(sqb + 64 * ks), a); }
                s[kt] = a; }
            if (sj == 128) { const int tk = (16 * jq + li) >> 3;
#pragma unroll
                for (int kt = 0; kt < 2; ++kt)
#pragma unroll
                    for (int r = 0; r < 4; ++r) if (16 * kt + 4 * g + r > tk) s[kt][r] = -INFINITY; }
            float mx = -INFINITY;
#pragma unroll
            for (int kt = 0; kt < 2; ++kt)
#pragma unroll
                for (int r = 0; r < 4; ++r) mx = fmaxf(mx, s[kt][r]);
            mx = fmaxf(mx, __shfl_xor(mx, 16)); mx = fmaxf(mx, __shfl_xor(mx, 32));
            const float mn = fmaxf(smrun, mx); const float alpha = __builtin_amdgcn_exp2f(smrun - mn); smrun = mn;
            float ps = 0.f;
#pragma unroll
            for (int kt = 0; kt < 2; ++kt)
#pragma unroll
                for (int r = 0; r < 4; ++r) { const float e = __builtin_amdgcn_exp2f(s[kt][r] - mn); s[kt][r] = e; ps += e; }
            slrun = slrun * alpha + ps;
#pragma unroll
            for (int c = 0; c < 8; ++c) so[c] = so[c] * alpha;
            const bf16x8 pf0 = pack8(s[0], s[1]);
#pragma unroll
            for (int c = 0; c < 8; ++c) {
                const LAS unsigned char* va = kb + ((4 * g + (li >> 2)) * SA_ST + 128 * ch + 16 * c + 4 * (li & 3)) * 2;
                so[c] = MFMA16(cat8(tr_read(va), tr_read(va + 16 * SA_ST * 2)), pf0, so[c]); }
        }
        asm volatile("" ::: "memory"); __builtin_amdgcn_sched_barrier(0);
        if (dos) { if (sj + 1 < NTS) SB_STORE(sj + 1, (sj + 1) & 1); ++sj; }
        ++ct;
        if (ct == NT) {
#pragma unroll
            for (int j = 0; j < 2; ++j) { float l = lrun[j]; l += __shfl_xor(l, 16); l += __shfl_xor(l, 32); const float rl = 1.f / l;
                bf16* orow = OATT + (rowbase + q0 + 16 * j + li) * 512 + h * 64 + 4 * g;
#pragma unroll
                for (int d = 0; d < 4; ++d) { u32x2 wv; wv.x = pk2(o[d][j][0] * rl, o[d][j][1] * rl); wv.y = pk2(o[d][j][2] * rl, o[d][j][3] * rl); *(GAS u32x2*)(orow + 16 * d) = wv; } }
            if (cu == 0) { cu = 1; ct = 0; qb = s_; NT = 4 * (qb + 1); tq = 4 * qb + (w >> 1); q0 = qb * 256 + w * 32; PM_INIT(); }
        }
        __syncthreads();
    }
#undef PA_LOAD
#undef PD_PIECE
#undef SB_LOAD
#undef SB_STORE
#undef PM_INIT
    { float l = slrun; l += __shfl_xor(l, 16); l += __shfl_xor(l, 32);
      float* pr = APART + ((size_t)(bs * 2 + split) * 64 + 16 * jq + li) * AP_ST;
#pragma unroll
      for (int c = 0; c < 8; ++c) *(GAS f32x4*)(pr + 128 * ch + 16 * c + 4 * g) = so[c];
      if (ch == 0 && g == 0) { pr[256] = smrun; pr[257] = l; } }
}

__device__ __forceinline__ void small_gemm(const Frame& F, const bf16* A, const bf16* Bt, int M, int N, int K, bf16* C, int ldc, float scale) {
    const int w = F.wave, li = F.lane & 15, g = F.lane >> 4, rt = w & 3, ch = w >> 2; const int ntn = N / 64, ntiles = (M / 64) * ntn;
    for (int tile = F.vcu; tile < ntiles; tile += F.G) { const int tm = tile / ntn, tn = tile % ntn;
        const bf16* ar = A + (size_t)(64 * tm + 16 * rt + li) * K + 8 * g; const bf16* b0 = Bt + (size_t)(64 * tn + 32 * ch + li) * K + 8 * g; const bf16* b1 = b0 + (size_t)16 * K;
        f32x4 acc0 = (f32x4){0.f, 0.f, 0.f, 0.f}, acc1 = (f32x4){0.f, 0.f, 0.f, 0.f};
#pragma unroll 8
        for (int ks = 0; ks < K / 32; ++ks) { const bf16x8 af = *(const GAS bf16x8*)(ar + 32 * ks); acc0 = MFMA16(*(const GAS bf16x8*)(b0 + 32 * ks), af, acc0); acc1 = MFMA16(*(const GAS bf16x8*)(b1 + 32 * ks), af, acc1); }
        bf16* cr = C + (size_t)(64 * tm + 16 * rt + li) * ldc + 64 * tn + 32 * ch + 4 * g;
        u32x2 o0, o1; o0.x = pk2(acc0[0] * scale, acc0[1] * scale); o0.y = pk2(acc0[2] * scale, acc0[3] * scale); o1.x = pk2(acc1[0] * scale, acc1[1] * scale); o1.y = pk2(acc1[2] * scale, acc1[3] * scale);
        *(GAS u32x2*)cr = o0; *(GAS u32x2*)(cr + 16) = o1; }
}

constexpr int SD_XST = 72, SD_BST = 136;
__device__ __forceinline__ void cumsum128(LAS float* a, LAS float* acum, int lane) {
    float v0 = a[2 * lane], v1 = a[2 * lane + 1]; float s = v0 + v1;
#pragma unroll
    for (int o = 1; o < 64; o <<= 1) { const float n = __shfl_up(s, o); if (lane >= o) s += n; }
    acum[2 * lane] = s - v1; acum[2 * lane + 1] = s;
}
__device__ __forceinline__ void ssd_a_unit(const Frame& F, const P& p, int b, int c, int h) {
    unsigned char* ws = p.ws; const bf16* XBC = (const bf16*)(ws + WS_XBC); const float* DT = (const float*)(ws + WS_DT);
    float* STATES = (float*)(ws + WS_STATES); float* CDEC = (float*)(ws + WS_CDEC);
    const int tid = F.tid, lane = F.lane, w = F.wave, li = lane & 15, g = lane >> 4, g2 = h >> 2;
    LAS unsigned char* lds = F.lds + RING_OFF;
    LAS unsigned char* xs_l = lds;
    LAS unsigned char* b_l = lds + 18432;
    LAS float* a_l = (LAS float*)(lds + 18432 + 34816);
    LAS float* ac_l = a_l + 128; LAS float* dt_l = a_l + 256;
    const size_t t0 = (size_t)b * SEQ + (size_t)c * CHUNK;
    const float Ah = -__expf(p.a_log[h]);
    __syncthreads();
    if (tid < 128) { const float d = DT[(t0 + tid) * 8 + h]; dt_l[tid] = d; a_l[tid] = d * Ah; }
#pragma unroll
    for (int i = 0; i < 4; ++i) { const int q = tid + 512 * i, row = q >> 4, ch8 = q & 15; *(LAS v4u*)(b_l + (row * SD_BST + ch8 * 8) * 2) = *(const GAS v4u*)(XBC + (t0 + row) * CONVD + 512 + g2 * 128 + ch8 * 8); }
    __syncthreads();
    if (w == 0) cumsum128(a_l, ac_l, lane);
    __syncthreads();
    const float alast = ac_l[127];
#pragma unroll
    for (int i = 0; i < 2; ++i) { const int q = tid + 512 * i, row = q >> 3, ch8 = q & 7; const v4u v = *(const GAS v4u*)(XBC + (t0 + row) * CONVD + h * 64 + ch8 * 8);
        const float sc = dt_l[row] * __expf(alast - ac_l[row]); v4u o;
        o.x = pk2(bflo(v.x) * sc, bfhi(v.x) * sc); o.y = pk2(bflo(v.y) * sc, bfhi(v.y) * sc); o.z = pk2(bflo(v.z) * sc, bfhi(v.z) * sc); o.w = pk2(bflo(v.w) * sc, bfhi(v.w) * sc);
        *(LAS v4u*)(xs_l + (row * SD_XST + ch8 * 8) * 2) = o; }
    __syncthreads();
    if (tid == 0) CDEC[(b * NCHUNK + c) * 8 + h] = __expf(alast);
    f32x4 acc[4];
#pragma unroll
    for (int pt = 0; pt < 4; ++pt) acc[pt] = (f32x4){0.f, 0.f, 0.f, 0.f};
#pragma unroll
    for (int kk = 0; kk < 4; ++kk) {
        const LAS unsigned char* ba = b_l + ((32 * kk + 8 * g + (li >> 2)) * SD_BST + 16 * w + 4 * (li & 3)) * 2;
        const bf16x8 bfr = cat8(tr_read(ba), tr_read(ba + 4 * SD_BST * 2));
#pragma unroll
        for (int pt = 0; pt < 4; ++pt) {
            const LAS unsigned char* xa = xs_l + ((32 * kk + 8 * g + (li >> 2)) * SD_XST + 16 * pt + 4 * (li & 3)) * 2;
            const bf16x8 xfr = cat8(tr_read(xa), tr_read(xa + 4 * SD_XST * 2));
            acc[pt] = MFMA16(xfr, bfr, acc[pt]); } }
    float* so = STATES + ((size_t)((b * NCHUNK + c) * 8 + h) * 64) * 128;
#pragma unroll
    for (int pt = 0; pt < 4; ++pt)
#pragma unroll
        for (int r = 0; r < 4; ++r) so[(size_t)(16 * pt + 4 * g + r) * 128 + 16 * w + li] = acc[pt][r];
}
__device__ __forceinline__ void ssd_b_scan(const Frame& F, const P& p) {
    unsigned char* ws = p.ws; const float* STATES = (const float*)(ws + WS_STATES); const float* CDEC = (const float*)(ws + WS_CDEC); bf16* HPREV = (bf16*)(ws + WS_HPREV);
    const size_t gt = (size_t)F.vcu * NTHR + F.tid, NGT = (size_t)F.G * NTHR;
    for (size_t e = gt; e < (size_t)2 * 8 * 64 * 128; e += NGT) { const int b = (int)(e >> 16), h = (int)(e >> 13) & 7, pn = (int)(e & 8191);
        float hcur = 0.f;
        for (int c0 = 0; c0 < NCHUNK; c0 += 16) { float sv[16];
#pragma unroll
            for (int i = 0; i < 16; ++i) sv[i] = STATES[((size_t)((b * NCHUNK + c0 + i) * 8 + h)) * 8192 + pn];
#pragma unroll
            for (int i = 0; i < 16; ++i) { HPREV[((size_t)((b * NCHUNK + c0 + i) * 8 + h)) * 8192 + pn] = (bf16)f2bf(hcur); hcur = CDEC[(b * NCHUNK + c0 + i) * 8 + h] * hcur + sv[i]; } }
        p.out[OUT_SSP + e] = hcur; }
}
__device__ __forceinline__ void ssd_c_unit(const Frame& F, const P& p, int b, int c, int h) {
    unsigned char* ws = p.ws; const bf16* XBC = (const bf16*)(ws + WS_XBC); const float* DT = (const float*)(ws + WS_DT); const bf16* HPREV = (const bf16*)(ws + WS_HPREV);
    const bf16* U = (const bf16*)(ws + WS_U);
    const int tid = F.tid, lane = F.lane, w = F.wave, li = lane & 15, g = lane >> 4, g2 = h >> 2;
    LAS unsigned char* lds = F.lds + RING_OFF;
    LAS unsigned char* x_l = lds;
    LAS unsigned char* b_l = lds + 18432;
    LAS unsigned char* c_l = lds + 18432 + 34816;
    LAS unsigned char* h_l = lds + 18432 + 2 * 34816;
    LAS float* a_l = (LAS float*)(lds + 18432 + 2 * 34816 + 17408);
    LAS float* ac_l = a_l + 128; LAS float* dt_l = a_l + 256;
    const size_t t0 = (size_t)b * SEQ + (size_t)c * CHUNK;
    const float Ah = -__expf(p.a_log[h]);
    __syncthreads();
    if (tid < 128) { const float d = DT[(t0 + tid) * 8 + h]; dt_l[tid] = d; a_l[tid] = d * Ah; }
#pragma unroll
    for (int i = 0; i < 4; ++i) { const int q = tid + 512 * i, row = q >> 4, ch8 = q & 15;
        *(LAS v4u*)(b_l + (row * SD_BST + ch8 * 8) * 2) = *(const GAS v4u*)(XBC + (t0 + row) * CONVD + 512 + g2 * 128 + ch8 * 8);
        *(LAS v4u*)(c_l + (row * SD_BST + ch8 * 8) * 2) = *(const GAS v4u*)(XBC + (t0 + row) * CONVD + 768 + g2 * 128 + ch8 * 8); }
#pragma unroll
    for (int i = 0; i < 2; ++i) { const int q = tid + 512 * i, row = q >> 4, ch8 = q & 15;
        *(LAS v4u*)(h_l + (row * SD_BST + ch8 * 8) * 2) = *(const GAS v4u*)(HPREV + ((size_t)((b * NCHUNK + c) * 8 + h) * 64 + row) * 128 + ch8 * 8); }
    __syncthreads();
    if (w == 0) cumsum128(a_l, ac_l, lane);
    __syncthreads();
#pragma unroll
    for (int i = 0; i < 2; ++i) { const int q = tid + 512 * i, row = q >> 3, ch8 = q & 7; const v4u v = *(const GAS v4u*)(XBC + (t0 + row) * CONVD + h * 64 + ch8 * 8);
        const float sc = dt_l[row]; v4u o;
        o.x = pk2(bflo(v.x) * sc, bfhi(v.x) * sc); o.y = pk2(bflo(v.y) * sc, bfhi(v.y) * sc); o.z = pk2(bflo(v.z) * sc, bfhi(v.z) * sc); o.w = pk2(bflo(v.w) * sc, bfhi(v.w) * sc);
        *(LAS v4u*)(x_l + (row * SD_XST + ch8 * 8) * 2) = o; }
    __syncthreads();
    bf16x8 cf[4];
#pragma unroll
    for (int ks = 0; ks < 4; ++ks) cf[ks] = *(const LAS bf16x8*)(c_l + ((16 * w + li) * SD_BST + 32 * ks + 8 * g) * 2);
    const float acl = ac_l[16 * w + li];
    f32x4 yd[4], yo[4];
#pragma unroll
    for (int pt = 0; pt < 4; ++pt) { yd[pt] = (f32x4){0.f, 0.f, 0.f, 0.f}; yo[pt] = (f32x4){0.f, 0.f, 0.f, 0.f}; }
#pragma unroll
    for (int kk = 0; kk < 4; ++kk) {
        if (2 * kk <= w) {
            f32x4 sg[2];
#pragma unroll
            for (int u = 0; u < 2; ++u) { const int stile = 2 * kk + u; f32x4 a = (f32x4){0.f, 0.f, 0.f, 0.f};
                if (stile <= w) {
#pragma unroll
                    for (int ks = 0; ks < 4; ++ks) { const bf16x8 bfr = *(const LAS bf16x8*)(b_l + ((16 * stile + li) * SD_BST + 32 * ks + 8 * g) * 2); a = MFMA16(bfr, cf[ks], a); }
#pragma unroll
                    for (int r = 0; r < 4; ++r) { const int s = 16 * stile + 4 * g + r; const int l = 16 * w + li; a[r] = (s <= l) ? a[r] * __expf(acl - ac_l[s]) : 0.f; } }
                sg[u] = a; }
            const bf16x8 pf = pack8(sg[0], sg[1]);
#pragma unroll
            for (int pt = 0; pt < 4; ++pt) {
                const LAS unsigned char* xa = x_l + ((32 * kk + 4 * g + (li >> 2)) * SD_XST + 16 * pt + 4 * (li & 3)) * 2;
                const bf16x8 xfr = cat8(tr_read(xa), tr_read(xa + 16 * SD_XST * 2));
                yd[pt] = MFMA16(xfr, pf, yd[pt]); } } }
#pragma unroll
    for (int pt = 0; pt < 4; ++pt)
#pragma unroll
        for (int ks = 0; ks < 4; ++ks) { const bf16x8 hfr = *(const LAS bf16x8*)(h_l + ((16 * pt + li) * SD_BST + 32 * ks + 8 * g) * 2); yo[pt] = MFMA16(hfr, cf[ks], yo[pt]); }
    const float eal = __expf(acl); const float dsk = p.d_skip[h]; const size_t t = t0 + 16 * w + li;
    bf16* YGB = (bf16*)(ws + WS_YG);
#pragma unroll
    for (int pt = 0; pt < 4; ++pt) { const int pc = h * 64 + 16 * pt + 4 * g;
        const u32x2 xv = *(const GAS u32x2*)(XBC + t * CONVD + pc); const u32x2 zv = *(const GAS u32x2*)(U + t * IN_PAD + O_Z + pc);
        const float xs[4] = {bflo(xv.x), bfhi(xv.x), bflo(xv.y), bfhi(xv.y)}, zs[4] = {bflo(zv.x), bfhi(zv.x), bflo(zv.y), bfhi(zv.y)}; float y[4];
#pragma unroll
        for (int r = 0; r < 4; ++r) y[r] = (yd[pt][r] + eal * yo[pt][r] + dsk * xs[r]) * siluf(zs[r]);
        u32x2 wv; wv.x = pk2(y[0], y[1]); wv.y = pk2(y[2], y[3]); *(GAS u32x2*)(YGB + t * 512 + pc) = wv; }
}

__device__ __forceinline__ void ssd_sample_unit(const Frame& F, const P& p, int b, int h) {
    unsigned char* ws = p.ws; const bf16* XBC = (const bf16*)(ws + WS_XBC); const float* DT = (const float*)(ws + WS_DT); const bf16* U = (const bf16*)(ws + WS_U);
    bf16* YGB = (bf16*)(ws + WS_YG);
    const int tid = F.tid, g2 = h >> 2; const int pp = tid >> 3, nc = (tid & 7) * 16;
    LAS float* fl = (LAS float*)(F.lds + RING_OFF);
    LAS float* Bs = fl;
    LAS float* Cs = fl + 1024;
    LAS float* Xs = fl + 2048;
    LAS float* Gs = fl + 2560;
    LAS float* ac = fl + 2624;
    LAS float* dts = fl + 2632;
    const size_t t0 = (size_t)TP + (size_t)b * 8;
    __syncthreads();
    for (int q = tid; q < 1024; q += 512) { const int l = q >> 7, n = q & 127; Bs[q] = bf2f(XBC[(t0 + l) * CONVD + 512 + g2 * 128 + n]); Cs[q] = bf2f(XBC[(t0 + l) * CONVD + 768 + g2 * 128 + n]); }
    { const int l = tid >> 6, pq = tid & 63; Xs[tid] = bf2f(XBC[(t0 + l) * CONVD + h * 64 + pq]); }
    if (tid == 0) { const float Ah = -__expf(p.a_log[h]); float s = 0.f; for (int l = 0; l < 8; ++l) { const float d = DT[(t0 + l) * 8 + h]; dts[l] = d; s += d * Ah; ac[l] = s; } }
    __syncthreads();
    { const int l = pp >> 3, s = pp & 7; float a = 0.f;
#pragma unroll
      for (int i = 0; i < 16; ++i) a += Cs[l * 128 + nc + i] * Bs[s * 128 + nc + i];
      a += __shfl_xor(a, 1); a += __shfl_xor(a, 2); a += __shfl_xor(a, 4);
      if ((tid & 7) == 0) Gs[pp] = a; }
    const float* h0p = p.state_ssm + ((size_t)(b * 8 + h) * 64 + pp) * 128 + nc; float h0[16];
#pragma unroll
    for (int i = 0; i < 4; ++i) { const f32x4 v = *(const GAS f32x4*)(h0p + 4 * i); h0[4 * i] = v[0]; h0[4 * i + 1] = v[1]; h0[4 * i + 2] = v[2]; h0[4 * i + 3] = v[3]; }
    __syncthreads();
    float yoff[8];
#pragma unroll
    for (int l = 0; l < 8; ++l) { float a = 0.f;
#pragma unroll
        for (int i = 0; i < 16; ++i) a += Cs[l * 128 + nc + i] * h0[i];
        a += __shfl_xor(a, 1); a += __shfl_xor(a, 2); a += __shfl_xor(a, 4); yoff[l] = a; }
    const float a7 = ac[7]; float hn[16]; const float e7 = __expf(a7);
#pragma unroll
    for (int i = 0; i < 16; ++i) hn[i] = e7 * h0[i];
#pragma unroll
    for (int l = 0; l < 8; ++l) { const float cf = Xs[l * 64 + pp] * dts[l] * __expf(a7 - ac[l]);
#pragma unroll
        for (int i = 0; i < 16; ++i) hn[i] += cf * Bs[l * 128 + nc + i]; }
    float* ho = p.out + OUT_SSS + ((size_t)(b * 8 + h) * 64 + pp) * 128 + nc;
#pragma unroll
    for (int i = 0; i < 4; ++i) *(GAS f32x4*)(ho + 4 * i) = (f32x4){hn[4 * i], hn[4 * i + 1], hn[4 * i + 2], hn[4 * i + 3]};
    { const int l = tid & 7; float yv = 0.f;
#pragma unroll
      for (int l2 = 0; l2 < 8; ++l2) { float yd = 0.f;
#pragma unroll
          for (int s = 0; s < 8; ++s) if (s <= l2) yd += Gs[l2 * 8 + s] * __expf(ac[l2] - ac[s]) * Xs[s * 64 + pp] * dts[s];
          const float tot = yd + __expf(ac[l2]) * yoff[l2] + p.d_skip[h] * Xs[l2 * 64 + pp];
          if (l2 == l) yv = tot; }
      const float z = bf2f(U[(t0 + l) * IN_PAD + O_Z + h * 64 + pp]);
      YGB[(t0 + l) * 512 + h * 64 + pp] = (bf16)f2bf(yv * siluf(z)); }
}

__device__ __forceinline__ void mixa_rows(const Frame& F, const P& p) {
    const bf16* OATT = (const bf16*)(p.ws + WS_OATT); const bf16* YG = (const bf16*)(p.ws + WS_YG); bf16* MIXA = (bf16*)(p.ws + WS_MIXA);
    const int lane = F.lane; const int gw = F.vcu * NWAVES + F.wave, NGW = F.G * NWAVES;
    float ga[8], gs[8];
#pragma unroll
    for (int i = 0; i < 8; ++i) { ga[i] = p.attn_out_norm[8 * lane + i]; gs[i] = p.ssm_norm[8 * lane + i]; }
    for (int t0 = gw; t0 < TALL; t0 += 2 * NGW) {
        v4u va[2], vs[2];
#pragma unroll
        for (int u = 0; u < 2; ++u) { const int t = t0 + u * NGW; if (t < TALL) { va[u] = *(const GAS v4u*)(OATT + (size_t)t * 512 + 8 * lane); vs[u] = *(const GAS v4u*)(YG + (size_t)t * 512 + 8 * lane); } }
#pragma unroll
        for (int u = 0; u < 2; ++u) { const int t = t0 + u * NGW; if (t < TALL) {
            { const v4u v = va[u]; float x[8] = {bflo(v.x), bfhi(v.x), bflo(v.y), bfhi(v.y), bflo(v.z), bfhi(v.z), bflo(v.w), bfhi(v.w)}; float ss = 0.f;
#pragma unroll
              for (int i = 0; i < 8; ++i) ss += x[i] * x[i];
              const float r = rsqrtf(wave_sum(ss) * (1.f / 512.f) + 1e-6f); v4u o;
              o.x = pk2(x[0] * r * ga[0], x[1] * r * ga[1]); o.y = pk2(x[2] * r * ga[2], x[3] * r * ga[3]); o.z = pk2(x[4] * r * ga[4], x[5] * r * ga[5]); o.w = pk2(x[6] * r * ga[6], x[7] * r * ga[7]);
              *(GAS v4u*)(MIXA + (size_t)t * DM + 8 * lane) = o; }
            { const v4u v = vs[u]; float x[8] = {bflo(v.x), bfhi(v.x), bflo(v.y), bfhi(v.y), bflo(v.z), bfhi(v.z), bflo(v.w), bfhi(v.w)}; float ss = 0.f;
#pragma unroll
              for (int i = 0; i < 8; ++i) ss += x[i] * x[i];
#pragma unroll
              for (int o_ = 1; o_ < 32; o_ <<= 1) ss += __shfl_xor(ss, o_);
              const float r = rsqrtf(ss * (1.f / 256.f) + 1e-6f); v4u o;
              o.x = pk2(x[0] * r * gs[0], x[1] * r * gs[1]); o.y = pk2(x[2] * r * gs[2], x[3] * r * gs[3]); o.z = pk2(x[4] * r * gs[4], x[5] * r * gs[5]); o.w = pk2(x[6] * r * gs[6], x[7] * r * gs[7]);
              *(GAS v4u*)(MIXA + (size_t)t * DM + 512 + 8 * lane) = o; } } }
    }
}

__device__ __forceinline__ void ln_rows(const Frame& F, const bf16* res, const bf16* delta, const float* gam, const float* bet, bf16* outb, unsigned char* out8) {
    const int lane = F.lane; const int gw = F.vcu * NWAVES + F.wave, NGW = F.G * NWAVES;
    f32x4 gg[4], bb[4];
#pragma unroll
    for (int j = 0; j < 4; ++j) { gg[j] = *(const GAS f32x4*)(gam + 256 * j + 4 * lane); bb[j] = *(const GAS f32x4*)(bet + 256 * j + 4 * lane); }
    for (int t0 = gw; t0 < TALL; t0 += 2 * NGW) {
        u32x2 r[2][4], d[2][4];
#pragma unroll
        for (int u = 0; u < 2; ++u) { const int t = t0 + u * NGW; if (t < TALL) {
#pragma unroll
            for (int j = 0; j < 4; ++j) { r[u][j] = *(const GAS u32x2*)(res + (size_t)t * DM + 256 * j + 4 * lane); d[u][j] = *(const GAS u32x2*)(delta + (size_t)t * DM + 256 * j + 4 * lane); } } }
#pragma unroll
        for (int u = 0; u < 2; ++u) { const int t = t0 + u * NGW; if (t < TALL) {
            f32x4 v[4]; float s = 0.f;
#pragma unroll
            for (int j = 0; j < 4; ++j) { v[j] = (f32x4){DN_ALPHA * bflo(r[u][j].x) + bflo(d[u][j].x), DN_ALPHA * bfhi(r[u][j].x) + bfhi(d[u][j].x), DN_ALPHA * bflo(r[u][j].y) + bflo(d[u][j].y), DN_ALPHA * bfhi(r[u][j].y) + bfhi(d[u][j].y)}; s += (v[j][0] + v[j][1]) + (v[j][2] + v[j][3]); }
            const float mean = wave_sum(s) * (1.f / DM); float s2 = 0.f;
#pragma unroll
            for (int j = 0; j < 4; ++j) { v[j] = v[j] - mean; s2 += (v[j][0] * v[j][0] + v[j][1] * v[j][1]) + (v[j][2] * v[j][2] + v[j][3] * v[j][3]); }
            const float rstd = rsqrtf(wave_sum(s2) * (1.f / DM) + 1e-5f);
#pragma unroll
            for (int j = 0; j < 4; ++j) { const f32x4 o = v[j] * rstd * gg[j] + bb[j]; u32x2 w; w.x = pk2(o[0], o[1]); w.y = pk2(o[2], o[3]); *(GAS u32x2*)(outb + (size_t)t * DM + 256 * j + 4 * lane) = w;
                if (out8) *(GAS unsigned*)(out8 + (size_t)t * DM + 256 * j + 4 * lane) = pk4_fp8(o, PX_SCALE); } } }
    }
}

constexpr int MA_ST = 264;
constexpr int MA_TILE = 64 * MA_ST * 2;
__device__ __forceinline__ void mem_attn_prompt_unit(const Frame& F, const P& p, int b, int hm, int qblk) {
    unsigned char* ws = p.ws; const bf16* QM = (const bf16*)(ws + WS_QM); const bf16* MK = (const bf16*)(ws + WS_MK); const bf16* MV = (const bf16*)(ws + WS_MV); bf16* OM = (bf16*)(ws + WS_OM);
    const int tid = F.tid, lane = F.lane, w = F.wave, li = lane & 15, g = lane >> 4;
    LAS unsigned char* kl = F.lds + RING_OFF; LAS unsigned char* vl = kl + MA_TILE;
    const size_t qrow = (size_t)b * SEQ + (size_t)qblk * 128 + 16 * w + li;
    bf16x8 qf[8];
#pragma unroll
    for (int ks = 0; ks < 8; ++ks) qf[ks] = *(const GAS bf16x8*)(QM + qrow * DM + hm * 256 + 32 * ks + 8 * g);
    f32x4 o[16];
#pragma unroll
    for (int d = 0; d < 16; ++d) o[d] = (f32x4){0.f, 0.f, 0.f, 0.f};
    float mrun = -INFINITY, lrun = 0.f;
    v4u sk[4], sv[4];
#define MA_LOAD(t) do { _Pragma("unroll") for (int i_ = 0; i_ < 4; ++i_) { const int q_ = tid + 512 * i_, row_ = q_ >> 5, c8_ = q_ & 31; const size_t off_ = ((size_t)b * NMEM + (t) * 64 + row_) * DM + hm * 256 + c8_ * 8; \
        sk[i_] = *(const GAS v4u*)(MK + off_); sv[i_] = *(const GAS v4u*)(MV + off_); } } while (0)
#define MA_STORE() do { _Pragma("unroll") for (int i_ = 0; i_ < 4; ++i_) { const int q_ = tid + 512 * i_, row_ = q_ >> 5, c8_ = q_ & 31; \
        *(LAS v4u*)(kl + (row_ * MA_ST + c8_ * 8) * 2) = sk[i_]; *(LAS v4u*)(vl + (row_ * MA_ST + c8_ * 8) * 2) = sv[i_]; } } while (0)
    MA_LOAD(0);
    for (int t = 0; t < 4; ++t) {
        __syncthreads();
        MA_STORE();
        __syncthreads();
        if (t + 1 < 4) MA_LOAD(t + 1);
        f32x4 s[4];
#pragma unroll
        for (int kt = 0; kt < 4; ++kt) { f32x4 a = (f32x4){0.f, 0.f, 0.f, 0.f};
#pragma unroll
            for (int ks = 0; ks < 8; ++ks) { const bf16x8 kf = *(const LAS bf16x8*)(kl + ((16 * kt + li) * MA_ST + 32 * ks + 8 * g) * 2); a = MFMA16(kf, qf[ks], a); }
            s[kt] = a; }
        float mx = -INFINITY;
#pragma unroll
        for (int kt = 0; kt < 4; ++kt)
#pragma unroll
            for (int r = 0; r < 4; ++r) mx = fmaxf(mx, s[kt][r]);
        mx = fmaxf(mx, __shfl_xor(mx, 16)); mx = fmaxf(mx, __shfl_xor(mx, 32));
        const float mn = fmaxf(mrun, mx); const float alpha = __builtin_amdgcn_exp2f(mrun - mn); mrun = mn;
        float ps = 0.f;
#pragma unroll
        for (int kt = 0; kt < 4; ++kt)
#pragma unroll
            for (int r = 0; r < 4; ++r) { const float e = __builtin_amdgcn_exp2f(s[kt][r] - mn); s[kt][r] = e; ps += e; }
        lrun = lrun * alpha + ps;
#pragma unroll
        for (int d = 0; d < 16; ++d) o[d] = o[d] * alpha;
        const bf16x8 pf0 = pack8(s[0], s[1]), pf1 = pack8(s[2], s[3]);
#pragma unroll
        for (int d = 0; d < 16; ++d) {
            const LAS unsigned char* va = vl + ((4 * g + (li >> 2)) * MA_ST + 16 * d + 4 * (li & 3)) * 2;
            const bf16x8 v0 = cat8(tr_read(va), tr_read(va + 16 * MA_ST * 2)); const bf16x8 v1 = cat8(tr_read(va + 32 * MA_ST * 2), tr_read(va + 48 * MA_ST * 2));
            o[d] = MFMA16(v0, pf0, o[d]); o[d] = MFMA16(v1, pf1, o[d]); }
    }
#undef MA_LOAD
#undef MA_STORE
    { float l = lrun; l += __shfl_xor(l, 16); l += __shfl_xor(l, 32); const float rl = 1.f / l; bf16* orow = OM + qrow * DM + hm * 256 + 4 * g;
#pragma unroll
      for (int d = 0; d < 16; ++d) { u32x2 wv; wv.x = pk2(o[d][0] * rl, o[d][1] * rl); wv.y = pk2(o[d][2] * rl, o[d][3] * rl); *(GAS u32x2*)(orow + 16 * d) = wv; } }
    __syncthreads();
}
__device__ __forceinline__ void mem_attn_sample_unit(const Frame& F, const P& p, int b, int hm) {
    unsigned char* ws = p.ws; const bf16* QM = (const bf16*)(ws + WS_QM); bf16* OM = (bf16*)(ws + WS_OM);
    const int tid = F.tid, lane = F.lane, w = F.wave, li = lane & 15, g = lane >> 4; LAS float* fl = (LAS float*)(F.lds + RING_OFF);
    LAS float* Ps = fl;
    LAS float* Rs = fl + 2048;
    __syncthreads();
    { bf16x8 qf[8]; const bf16* qr = QM + (size_t)(TP + b * 8 + (li & 7)) * DM + hm * 256 + 8 * g;
#pragma unroll
      for (int ks = 0; ks < 8; ++ks) qf[ks] = *(const GAS bf16x8*)(qr + 32 * ks);
#pragma unroll
      for (int kt = 0; kt < 2; ++kt) { const float* kr = p.cache_mk + (((size_t)b * NMEM + 32 * w + 16 * kt + li) * MH + hm) * MHD + 8 * g; f32x4 ka[8], kb[8];
#pragma unroll
          for (int ks = 0; ks < 8; ++ks) { ka[ks] = __builtin_nontemporal_load((const GAS f32x4*)(kr + 32 * ks)); kb[ks] = __builtin_nontemporal_load((const GAS f32x4*)(kr + 32 * ks + 4)); }
          f32x4 a = (f32x4){0.f, 0.f, 0.f, 0.f};
#pragma unroll
          for (int ks = 0; ks < 8; ++ks) a = MFMA16(pack8(ka[ks], kb[ks]), qf[ks], a);
          if (li < 8) { LAS float* d = Ps + li * 256 + 32 * w + 16 * kt + 4 * g; d[0] = a[0]; d[1] = a[1]; d[2] = a[2]; d[3] = a[3]; } } }
    __syncthreads();
    { float v[4]; float mx = -INFINITY;
#pragma unroll
      for (int i = 0; i < 4; ++i) { v[i] = Ps[w * 256 + lane + 64 * i]; mx = fmaxf(mx, v[i]); }
#pragma unroll
      for (int o_ = 1; o_ < 64; o_ <<= 1) mx = fmaxf(mx, __shfl_xor(mx, o_));
      float s = 0.f;
#pragma unroll
      for (int i = 0; i < 4; ++i) { v[i] = __builtin_amdgcn_exp2f(v[i] - mx); s += v[i]; Ps[w * 256 + lane + 64 * i] = v[i]; }
      s = wave_sum(s); if (lane == 0) Rs[w] = 1.f / s; }
    __syncthreads();
    { const int dv = tid & 255, half = tid >> 8; const float* vr = p.cache_mv + ((size_t)b * NMEM * MH + hm) * MHD + dv; float acc[4] = {0.f, 0.f, 0.f, 0.f};
#pragma unroll 16
      for (int m = 0; m < NMEM; ++m) { const float vv = __builtin_nontemporal_load(vr + (size_t)m * (MH * MHD));
#pragma unroll
          for (int tk = 0; tk < 4; ++tk) acc[tk] += Ps[(4 * half + tk) * 256 + m] * vv; }
#pragma unroll
      for (int tk = 0; tk < 4; ++tk) OM[(size_t)(TP + b * 8 + 4 * half + tk) * DM + hm * 256 + dv] = (bf16)f2bf(acc[tk] * Rs[4 * half + tk]); }
}

__device__ __forceinline__ void peer_scores_unit(const Frame& F, const P& p, int tb, int gg) {
    unsigned char* ws = p.ws; const bf16* PQ = (const bf16*)(ws + WS_PQ); const bf16* KEYS = (const bf16*)(ws + WS_PKEYS); float* TOPS = (float*)(ws + WS_PTOPS);
    const int lane = F.lane, w = F.wave, li = lane & 15, g = lane >> 4;
    bf16x8 tf[2][4];
#pragma unroll
    for (int j = 0; j < 2; ++j)
#pragma unroll
        for (int ks = 0; ks < 4; ++ks) tf[j][ks] = *(const GAS bf16x8*)(PQ + (size_t)(tb * 256 + 32 * w + 16 * j + li) * 2048 + gg * 128 + 32 * ks + 8 * g);
    f32x4 s[2][8];
#pragma unroll
    for (int kt = 0; kt < 8; ++kt) { bf16x8 kf[4];
#pragma unroll
        for (int ks = 0; ks < 4; ++ks) kf[ks] = *(const GAS bf16x8*)(KEYS + ((size_t)gg * 128 + 16 * kt + li) * 128 + 32 * ks + 8 * g);
#pragma unroll
        for (int j = 0; j < 2; ++j) { f32x4 a = (f32x4){0.f, 0.f, 0.f, 0.f};
#pragma unroll
            for (int ks = 0; ks < 4; ++ks) a = MFMA16(kf[ks], tf[j][ks], a);
            s[j][kt] = a; } }
#pragma unroll
    for (int j = 0; j < 2; ++j) {
        float top[16];
#pragma unroll
        for (int i = 0; i < 16; ++i) top[i] = -INFINITY;
#pragma unroll
        for (int kt = 0; kt < 8; ++kt)
#pragma unroll
            for (int r = 0; r < 4; ++r) { float cv = __uint_as_float((__float_as_uint(s[j][kt][r]) & ~127u) | (unsigned)(16 * kt + 4 * g + r));
#pragma unroll
                for (int i = 0; i < 16; ++i) { const float hi_ = fmaxf(top[i], cv), lo_ = fminf(top[i], cv); top[i] = hi_; cv = lo_; } }
#pragma unroll
        for (int off = 16; off <= 32; off <<= 1) {
            float c[16];
#pragma unroll
            for (int i = 0; i < 16; ++i) c[i] = fmaxf(top[i], __shfl_xor(top[15 - i], off));
#pragma unroll
            for (int d = 8; d >= 1; d >>= 1)
#pragma unroll
                for (int i = 0; i < 16; ++i) if ((i & d) == 0) { const float hi_ = fmaxf(c[i], c[i + d]), lo_ = fminf(c[i], c[i + d]); c[i] = hi_; c[i + d] = lo_; }
#pragma unroll
            for (int i = 0; i < 16; ++i) top[i] = c[i]; }
        float* to = TOPS + ((size_t)(tb * 256 + 32 * w + 16 * j + li) * 16 + gg) * 16;
        *(GAS f32x4*)(to + 4 * g) = (f32x4){g == 0 ? top[0] : g == 1 ? top[4] : g == 2 ? top[8] : top[12], g == 0 ? top[1] : g == 1 ? top[5] : g == 2 ? top[9] : top[13],
                                            g == 0 ? top[2] : g == 1 ? top[6] : g == 2 ? top[10] : top[14], g == 0 ? top[3] : g == 1 ? top[7] : g == 2 ? top[11] : top[15]};
    }
}
__device__ __forceinline__ void peer_cand(const Frame& F, const P& p) {
    const float* TOPS = (const float*)(p.ws + WS_PTOPS); int* PIDX = (int*)(p.ws + WS_PIDX); float* PG = (float*)(p.ws + WS_PG);
    const int lane = F.lane; const size_t gw = (size_t)F.vcu * NWAVES + F.wave, NGW = (size_t)F.G * NWAVES;
    LAS float* wl = (LAS float*)(F.lds + RING_OFF) + F.wave * 2176;
    for (size_t wi = gw; wi < (size_t)TALL * PH / 64; wi += NGW) {
        const size_t it = wi * 64 + lane;
        LDS_WAIT(); asm volatile("" ::: "memory");
#pragma unroll
        for (int q = 0; q < 8; ++q) { const int f = (q * 64 + lane) * 4; const f32x4 v = *(const GAS f32x4*)(TOPS + wi * 2048 + f); const int row = f >> 5, col = f & 31; LAS float* d = wl + row * 33 + col; d[0] = v[0]; d[1] = v[1]; d[2] = v[2]; d[3] = v[3]; }
        LDS_WAIT(); asm volatile("" ::: "memory");
        const LAS float* ta = wl + lane * 33; const LAS float* tb_ = ta + 16;
        float val[16]; int idx[16];
#pragma unroll
        for (int i = 0; i < 16; ++i) { val[i] = -INFINITY; idx[i] = 0; }
        for (int i = 0; i < 16; ++i) { const unsigned ua = __float_as_uint(ta[i]); const float va = __uint_as_float(ua & ~127u); const int ia = (int)(ua & 127u); const int nj = 16 / (i + 1);
            for (int j = 0; j < nj; ++j) { const unsigned ub = __float_as_uint(tb_[j]); float cv = va + __uint_as_float(ub & ~127u); int ci = ia * NKEYS + (int)(ub & 127u);
#pragma unroll
                for (int k = 0; k < 16; ++k) { const bool gt_ = cv > val[k]; const float nv = gt_ ? cv : val[k]; const float nc = gt_ ? val[k] : cv; const int ni = gt_ ? ci : idx[k]; const int nci = gt_ ? idx[k] : ci;
                    val[k] = nv; cv = nc; idx[k] = ni; ci = nci; } } }
        float s = 0.f; float e[16];
#pragma unroll
        for (int k = 0; k < 16; ++k) { e[k] = __expf(val[k] - val[0]); s += e[k]; }
        const float rs = 1.f / s;
#pragma unroll
        for (int k = 0; k < 4; ++k) { *(GAS v4u*)(PIDX + it * 16 + 4 * k) = (v4u){(unsigned)idx[4 * k], (unsigned)idx[4 * k + 1], (unsigned)idx[4 * k + 2], (unsigned)idx[4 * k + 3]};
            *(GAS f32x4*)(PG + it * 16 + 4 * k) = (f32x4){e[4 * k] * rs, e[4 * k + 1] * rs, e[4 * k + 2] * rs, e[4 * k + 3] * rs}; }
    }
}
typedef float f32x2 __attribute__((ext_vector_type(2)));
#define FP8_DOT(uvv, xb, a2) do { \
        a2 = __builtin_amdgcn_cvt_pk_f32_fp8((int)(uvv).x, false) * x[(xb) + 0] + a2; a2 = __builtin_amdgcn_cvt_pk_f32_fp8((int)(uvv).x, true) * x[(xb) + 1] + a2; \
        a2 = __builtin_amdgcn_cvt_pk_f32_fp8((int)(uvv).y, false) * x[(xb) + 2] + a2; a2 = __builtin_amdgcn_cvt_pk_f32_fp8((int)(uvv).y, true) * x[(xb) + 3] + a2; \
        a2 = __builtin_amdgcn_cvt_pk_f32_fp8((int)(uvv).z, false) * x[(xb) + 4] + a2; a2 = __builtin_amdgcn_cvt_pk_f32_fp8((int)(uvv).z, true) * x[(xb) + 5] + a2; \
        a2 = __builtin_amdgcn_cvt_pk_f32_fp8((int)(uvv).w, false) * x[(xb) + 6] + a2; a2 = __builtin_amdgcn_cvt_pk_f32_fp8((int)(uvv).w, true) * x[(xb) + 7] + a2; } while (0)
__device__ __forceinline__ void peer_pass_a(const Frame& F, const P& p, int s_lo, int s_hi, int rank, int nranks) {
    unsigned char* ws = p.ws; const bf16* H2B = (const bf16*)(ws + WS_H2B); const unsigned char* PU8 = ws + WS_PU;
    const int* PIDX = (const int*)(ws + WS_PIDX); const float* PG = (const float*)(ws + WS_PG); float* PW = (float*)(ws + WS_PW);
    const int lane = F.lane, sub = lane & 15, rs = lane >> 4;
    LAS int* le = (LAS int*)(F.lds + RING_OFF) + F.wave * 384; LAS int* lk = le + 128; LAS float* lg = (LAS float*)(le + 256);
    const unsigned long long ltmask = (1ull << lane) - 1ull; const int tstep = nranks * NWAVES;
    for (int slice = s_lo; slice < s_hi; ++slice) {
    int t = rank * NWAVES + F.wave;
    int e0n = 0, e1n = 0; float g0n = 0.f, g1n = 0.f; v4u xan[4], xbn[4];
#define PA_PREFETCH(tt) do { if ((tt) < TALL) { e0n = PIDX[(size_t)(tt) * 128 + lane]; e1n = PIDX[(size_t)(tt) * 128 + 64 + lane]; g0n = PG[(size_t)(tt) * 128 + lane]; g1n = PG[(size_t)(tt) * 128 + 64 + lane]; \
        _Pragma("unroll") for (int c = 0; c < 4; ++c) { xan[c] = *(const GAS v4u*)(H2B + (size_t)(tt) * DM + 256 * c + 16 * sub); xbn[c] = *(const GAS v4u*)(H2B + (size_t)(tt) * DM + 256 * c + 16 * sub + 8); } } } while (0)
    PA_PREFETCH(t);
    for (; t < TALL; t += tstep) {
        const int e0 = e0n, e1 = e1n; const float g0 = g0n, g1 = g1n; v4u xa[4], xb[4];
#pragma unroll
        for (int c = 0; c < 4; ++c) { xa[c] = xan[c]; xb[c] = xbn[c]; }
        PA_PREFETCH(t + tstep);
        const bool m0 = (e0 >> 11) == slice, m1 = (e1 >> 11) == slice; const unsigned long long b0 = __ballot(m0), b1 = __ballot(m1); const int n0 = __popcll(b0), n = n0 + __popcll(b1);
        LDS_WAIT(); asm volatile("" ::: "memory");
        if (m0) { const int q = __popcll(b0 & ltmask); le[q] = e0; lk[q] = lane; lg[q] = g0; }
        if (m1) { const int q = n0 + __popcll(b1 & ltmask); le[q] = e1; lk[q] = lane + 64; lg[q] = g1; }
        f32x2 x[32];
#pragma unroll
        for (int c = 0; c < 4; ++c) { const v4u a = xa[c], b = xb[c];
            x[8 * c + 0] = (f32x2){bflo(a.x), bfhi(a.x)}; x[8 * c + 1] = (f32x2){bflo(a.y), bfhi(a.y)}; x[8 * c + 2] = (f32x2){bflo(a.z), bfhi(a.z)}; x[8 * c + 3] = (f32x2){bflo(a.w), bfhi(a.w)};
            x[8 * c + 4] = (f32x2){bflo(b.x), bfhi(b.x)}; x[8 * c + 5] = (f32x2){bflo(b.y), bfhi(b.y)}; x[8 * c + 6] = (f32x2){bflo(b.z), bfhi(b.z)}; x[8 * c + 7] = (f32x2){bflo(b.w), bfhi(b.w)}; }
        LDS_WAIT(); asm volatile("" ::: "memory");
        for (int j0 = 0; j0 < n; j0 += 16) {
            v4u uv[4][4]; float asum[4];
#pragma unroll
            for (int st = 0; st < 4; ++st) if (j0 + 4 * st < n) { const int j = j0 + 4 * st + rs; const int jj = j < n ? j : 0; const unsigned char* ur = PU8 + (size_t)le[jj] * DM + 16 * sub;
#pragma unroll
                for (int c = 0; c < 4; ++c) uv[st][c] = *(const GAS v4u*)(ur + 256 * c); }
#pragma unroll
            for (int st = 0; st < 4; ++st) { asum[st] = 0.f; if (j0 + 4 * st < n) { f32x2 a2 = (f32x2){0.f, 0.f};
#pragma unroll
                for (int c = 0; c < 4; ++c) FP8_DOT(uv[st][c], 8 * c, a2);
                float a = a2.x + a2.y;
                a += __shfl_xor(a, 1); a += __shfl_xor(a, 2); a += __shfl_xor(a, 4); a += __shfl_xor(a, 8); asum[st] = a; } }
            { const float a = (sub == 0 ? asum[0] : sub == 1 ? asum[1] : sub == 2 ? asum[2] : asum[3]) * (1.f / PU_SCALE); const int j = j0 + 4 * sub + rs;
              if (sub < 4 && j < n) { const float act = 0.5f * a * (1.f + erff(a * 0.70710678118654752f)); PW[(size_t)t * 128 + lk[j]] = lg[j] * act * (1.f / PV_SCALE); } } }
    }
#undef PA_PREFETCH
    }
}
__device__ __forceinline__ void peer_pass_b(const Frame& F, const P& p) {
    unsigned char* ws = p.ws; const bf16* H2B = (const bf16*)(ws + WS_H2B); const unsigned char* PV8 = ws + WS_PV;
    const int* PIDX = (const int*)(ws + WS_PIDX); const float* PW = (const float*)(ws + WS_PW);
    const int lane = F.lane, sub = lane & 15, rs = lane >> 4; const int gw = F.vcu * NWAVES + F.wave, NGW = F.G * NWAVES;
    LAS int* widx = (LAS int*)(F.lds + RING_OFF) + F.wave * 384; LAS float* ww = (LAS float*)(widx + 128);
    for (int t = gw; t < TALL; t += NGW) {
        LDS_WAIT(); asm volatile("" ::: "memory");
        widx[lane] = PIDX[(size_t)t * 128 + lane]; widx[lane + 64] = PIDX[(size_t)t * 128 + lane + 64]; ww[lane] = PW[(size_t)t * 128 + lane]; ww[lane + 64] = PW[(size_t)t * 128 + lane + 64];
        LDS_WAIT(); asm volatile("" ::: "memory");
        f32x2 acc[32];
#pragma unroll
        for (int i = 0; i < 32; ++i) acc[i] = (f32x2){0.f, 0.f};
#pragma unroll 4
        for (int it = 0; it < 32; ++it) { const int k = 4 * it + rs; const int e = widx[k]; const unsigned char* vr = PV8 + (size_t)e * DM + 16 * sub; const float wk = ww[k]; const f32x2 w2 = (f32x2){wk, wk};
            v4u vv[4];
#pragma unroll
            for (int c = 0; c < 4; ++c) vv[c] = *(const GAS v4u*)(vr + 256 * c);
#pragma unroll
            for (int c = 0; c < 4; ++c) {
                acc[8 * c + 0] = __builtin_amdgcn_cvt_pk_f32_fp8((int)vv[c].x, false) * w2 + acc[8 * c + 0]; acc[8 * c + 1] = __builtin_amdgcn_cvt_pk_f32_fp8((int)vv[c].x, true) * w2 + acc[8 * c + 1];
                acc[8 * c + 2] = __builtin_amdgcn_cvt_pk_f32_fp8((int)vv[c].y, false) * w2 + acc[8 * c + 2]; acc[8 * c + 3] = __builtin_amdgcn_cvt_pk_f32_fp8((int)vv[c].y, true) * w2 + acc[8 * c + 3];
                acc[8 * c + 4] = __builtin_amdgcn_cvt_pk_f32_fp8((int)vv[c].z, false) * w2 + acc[8 * c + 4]; acc[8 * c + 5] = __builtin_amdgcn_cvt_pk_f32_fp8((int)vv[c].z, true) * w2 + acc[8 * c + 5];
                acc[8 * c + 6] = __builtin_amdgcn_cvt_pk_f32_fp8((int)vv[c].w, false) * w2 + acc[8 * c + 6]; acc[8 * c + 7] = __builtin_amdgcn_cvt_pk_f32_fp8((int)vv[c].w, true) * w2 + acc[8 * c + 7]; } }
#pragma unroll
        for (int i = 0; i < 32; ++i) { acc[i].x += __shfl_xor(acc[i].x, 16); acc[i].y += __shfl_xor(acc[i].y, 16); acc[i].x += __shfl_xor(acc[i].x, 32); acc[i].y += __shfl_xor(acc[i].y, 32); }
        float v[16]; float s = 0.f;
#pragma unroll
        for (int j = 0; j < 8; ++j) { const f32x2 a = rs == 0 ? acc[j] : rs == 1 ? acc[8 + j] : rs == 2 ? acc[16 + j] : acc[24 + j]; v[2 * j] = a.x; v[2 * j + 1] = a.y; }
        const int e0 = 256 * rs + 16 * sub;
#pragma unroll
        for (int q = 0; q < 4; ++q) { const u32x2 r = *(const GAS u32x2*)(H2B + (size_t)t * DM + e0 + 4 * q); v[4 * q] += DN_ALPHA * bflo(r.x); v[4 * q + 1] += DN_ALPHA * bfhi(r.x); v[4 * q + 2] += DN_ALPHA * bflo(r.y); v[4 * q + 3] += DN_ALPHA * bfhi(r.y); }
#pragma unroll
        for (int i = 0; i < 16; ++i) s += v[i];
        const float mean = wave_sum(s) * (1.f / DM); float s2 = 0.f;
#pragma unroll
        for (int i = 0; i < 16; ++i) { v[i] -= mean; s2 += v[i] * v[i]; }
        const float rstd = rsqrtf(wave_sum(s2) * (1.f / DM) + 1e-5f);
        float* yo = p.out + OUT_YP + (size_t)t * DM + e0;
#pragma unroll
        for (int q = 0; q < 4; ++q) { const f32x4 gq = *(const GAS f32x4*)(p.ln3_g + e0 + 4 * q), bq = *(const GAS f32x4*)(p.ln3_b + e0 + 4 * q);
            *(GAS f32x4*)(yo + 4 * q) = (f32x4){v[4 * q] * rstd * gq[0] + bq[0], v[4 * q + 1] * rstd * gq[1] + bq[1], v[4 * q + 2] * rstd * gq[2] + bq[2], v[4 * q + 3] * rstd * gq[3] + bq[3]}; }
    }
}

#if MK_DIAG
__constant__ int DG_TL[24] = {0, 1, 2, 3, 15, 16, 17, 31, 32, 33, 63, 64, 65, 127, 128, 129, 255, 256, 257, 511, 512, 4095, 4096, 8191};
constexpr int NCHK = 24;
__device__ __forceinline__ unsigned dh(unsigned i, unsigned k) { unsigned x = i * 2654435761u + k * 40503u + 12345u; x ^= x >> 15; x *= 2246822519u; x ^= x >> 13; return x; }
struct DAcc { float d2, r2; };
__device__ __forceinline__ void dacc(DAcc& a, float fast, float ref) { float e = fast - ref; if (!(e == e) || !(fabsf(e) < 1e18f)) e = 1e18f; a.d2 += e * e; a.r2 += ref * ref; }
__device__ __forceinline__ void dflush(const Frame& F, int k, DAcc a) { const float d = wave_sum(a.d2), r = wave_sum(a.r2); if (F.lane == 0) { float* dg = (float*)(F.ctl + CW_DIAG) + 2 * k; atomicAdd(dg, d); atomicAdd(dg + 1, r); } }
__device__ __forceinline__ float xin(const P& p, int t, int k) { return t < TP ? p.x_prompt[(size_t)t * DM + k] : p.x_sample[(size_t)(t - TP) * DM + k]; }
__device__ __forceinline__ float gelu_ref(float a) { return 0.5f * a * (1.f + erff(a * 0.70710678118654752f)); }

__device__ __forceinline__ void diag_phase(const Frame& F, const P& p, const XcdBarrier& bar) {
    unsigned char* ws = p.ws; const int lane = F.lane; const int gw = F.vcu * NWAVES + F.wave, NGW = F.G * NWAVES;
    const bf16* U = (const bf16*)(ws + WS_U); const bf16* CQN = (const bf16*)(ws + WS_CQN); const bf16* CKV = (const bf16*)(ws + WS_CKV); const bf16* KR = (const bf16*)(ws + WS_KR);
    const bf16* XBC = (const bf16*)(ws + WS_XBC); const float* DT = (const float*)(ws + WS_DT); const bf16* Q = (const bf16*)(ws + WS_Q); const bf16* KNV = (const bf16*)(ws + WS_KNV);
    const bf16* QLAT = (const bf16*)(ws + WS_QLAT); const bf16* OATT = (const bf16*)(ws + WS_OATT); const bf16* OLAT = (const bf16*)(ws + WS_OLAT); const bf16* HPREV = (const bf16*)(ws + WS_HPREV);
    const bf16* YG = (const bf16*)(ws + WS_YG); const bf16* MIXA = (const bf16*)(ws + WS_MIXA); const bf16* MIX = (const bf16*)(ws + WS_MIX);
    const bf16* H1B = (const bf16*)(ws + WS_H1B); const bf16* QM = (const bf16*)(ws + WS_QM); const bf16* MK = (const bf16*)(ws + WS_MK); const bf16* MV = (const bf16*)(ws + WS_MV);
    const bf16* OM = (const bf16*)(ws + WS_OM); const bf16* MIX2 = (const bf16*)(ws + WS_MIX2); const bf16* H2B = (const bf16*)(ws + WS_H2B);
    const bf16* PQ = (const bf16*)(ws + WS_PQ); const float* TOPS = (const float*)(ws + WS_PTOPS); const int* PIDX = (const int*)(ws + WS_PIDX); const float* PG = (const float*)(ws + WS_PG);
    LAS float* wl = (LAS float*)(F.lds + RING_OFF) + F.wave * 4096;
    const float QSC = MLA_SCALE * LOG2E;
    { DAcc a{0.f, 0.f};
      for (int it = gw; it < 512; it += NGW) { const int t = dh(it, 1) % TALL, n = dh(it, 2) % IN_DIM; float s = 0.f;
          for (int j = 0; j < 16; ++j) { const int k = lane + 64 * j; s += xin(p, t, k) * p.w_in[(size_t)k * IN_DIM + n]; }
          s = wave_sum(s); if (lane == 0) dacc(a, bf2f(U[(size_t)t * IN_PAD + n]), s); }
      dflush(F, 1, a); }
    { DAcc a{0.f, 0.f};
      for (int it = gw; it < 96; it += NGW) { int t;
          if (it < 8) t = it; else if (it < 16) t = SEQ + (it - 8); else if (it < 20) t = SEQ - 4 + (it - 16); else if (it < 24) t = TP - 4 + (it - 20); else if (it < 40) t = TP + 8 * (dh(it, 3) % DBATCH) + ((it - 24) & 7); else t = dh(it, 4) % TALL;
          const bool smp = t >= TP; const int ts = t - TP; const int tl = smp ? (ts & 7) : (t & (SEQ - 1)); const int pos = smp ? PAST + tl : tl; const bf16* ur = U + (size_t)t * IN_PAD;
          { float v[6]; float ss = 0.f; for (int i = 0; i < 6; ++i) { v[i] = bf2f(ur[O_CQ + lane + 64 * i]); ss += v[i] * v[i]; } const float r = rsqrtf(wave_sum(ss) / 384.f + 1e-6f);
            for (int i = 0; i < 6; ++i) dacc(a, bf2f(CQN[(size_t)t * QLORA + lane + 64 * i]), v[i] * r * p.q_a_norm[lane + 64 * i]); }
          { float v[4]; float ss = 0.f; for (int i = 0; i < 4; ++i) { v[i] = bf2f(ur[O_CKV + lane + 64 * i]); ss += v[i] * v[i]; } const float r = rsqrtf(wave_sum(ss) / 256.f + 1e-6f);
            const float* of = smp ? p.out + OUT_KVS + (size_t)ts * KVLORA : p.out + OUT_KVP + (size_t)t * KVLORA;
            for (int i = 0; i < 4; ++i) { const float rf = v[i] * r * p.kv_a_norm[lane + 64 * i]; dacc(a, bf2f(CKV[(size_t)t * KVLORA + lane + 64 * i]), rf); dacc(a, of[lane + 64 * i], rf); } }
          if (lane < 32) { const int i = lane & 15; const float x1 = bf2f(ur[O_KPE + i]), x2 = bf2f(ur[O_KPE + 16 + i]); const float ang = (float)pos * powf(10000.f, -(float)i / 16.f); const float c = cosf(ang), s = sinf(ang);
            const float rf = lane < 16 ? x1 * c - x2 * s : x2 * c + x1 * s; const float* of = smp ? p.out + OUT_KRS + (size_t)ts * ROPE : p.out + OUT_KRP + (size_t)t * ROPE;
            dacc(a, bf2f(KR[(size_t)t * ROPE + lane]), rf); dacc(a, of[lane], rf); }
          if (lane < 8) { const float raw = bf2f(ur[O_DT + lane]) + p.dt_bias[lane]; dacc(a, DT[(size_t)t * 8 + lane], log1pf(expf(raw))); }
          for (int i = 0; i < 16; ++i) { const int c = lane + 64 * i; float acc = p.conv_b[c];
              for (int k = 0; k < 4; ++k) { const int f = tl + k; float x; if (f >= 3) x = bf2f(U[(size_t)(t + k - 3) * IN_PAD + O_XBC + c]); else x = smp ? p.state_conv[((size_t)(ts >> 3) * 3 + f) * CONVD + c] : 0.f; acc += p.conv_w[k * CONVD + c] * x; }
              dacc(a, bf2f(XBC[(size_t)t * CONVD + c]), acc / (1.f + expf(-acc)));
              if (!smp && tl >= SEQ - 3) dacc(a, p.out[OUT_CVP + ((size_t)(t >> 13) * 3 + (tl - (SEQ - 3))) * CONVD + c], bf2f(ur[O_XBC + c]));
              if (smp && tl >= DSEQ - 3) dacc(a, p.out[OUT_CVS + ((size_t)(ts >> 3) * 3 + (tl - (DSEQ - 3))) * CONVD + c], bf2f(ur[O_XBC + c])); } }
      dflush(F, 2, a); }
    { DAcc a{0.f, 0.f};
      for (int it = gw; it < 512; it += NGW) { const int t = dh(it, 5) % TALL, c = dh(it, 6) % 768; float s = 0.f;
          for (int j = 0; j < 6; ++j) { const int k = lane + 64 * j; s += bf2f(CQN[(size_t)t * QLORA + k]) * p.w_uq[(size_t)k * 768 + c]; }
          s = wave_sum(s) * QSC; if (lane == 0) dacc(a, bf2f(Q[(size_t)t * 768 + c]), s); }
      dflush(F, 3, a); }
    { DAcc a{0.f, 0.f};
      for (int it = gw; it < 512; it += NGW) { const int t = dh(it, 7) % TP, c = dh(it, 8) % 1024; float s = 0.f;
          for (int j = 0; j < 4; ++j) { const int k = lane + 64 * j; s += bf2f(CKV[(size_t)t * KVLORA + k]) * (c < 512 ? p.w_uk[(size_t)k * 512 + c] : p.w_uv[(size_t)k * 512 + c - 512]); }
          s = wave_sum(s); if (lane == 0) dacc(a, bf2f(KNV[(size_t)t * 1024 + c]), s); }
      dflush(F, 4, a); }
    { DAcc a{0.f, 0.f};
      for (int it = gw; it < 512; it += NGW) { const int ts = dh(it, 9) % TS, n = dh(it, 10) % 2048, h = n >> 8, c = n & 255;
          float s = bf2f(Q[(size_t)(TP + ts) * 768 + h * 96 + lane]) * p.w_uk[(size_t)c * 512 + h * 64 + lane];
          s = wave_sum(s); if (lane == 0) dacc(a, bf2f(QLAT[(size_t)ts * 2048 + n]), s); }
      dflush(F, 5, a); }
    { DAcc a{0.f, 0.f};
      for (int it = gw; it < 48; it += NGW) { const int b = it & 1, h = dh(it, 11) & 7, tl = DG_TL[it >> 1]; const size_t rb = (size_t)b * SEQ;
          LDS_WAIT(); asm volatile("" ::: "memory");
          { const bf16* qr = Q + (rb + tl) * 768 + h * 96; wl[lane] = bf2f(qr[lane]);
            if (lane < 16) { const float x1 = bf2f(qr[64 + lane]), x2 = bf2f(qr[80 + lane]); const float ang = (float)tl * powf(10000.f, -(float)lane / 16.f); const float c = cosf(ang), s = sinf(ang); wl[64 + lane] = x1 * c - x2 * s; wl[80 + lane] = x2 * c + x1 * s; } }
          LDS_WAIT(); asm volatile("" ::: "memory");
          float mx = -INFINITY;
          for (int j = lane; j <= tl; j += 64) { float s = 0.f; const bf16* kn = KNV + (rb + j) * 1024 + h * 64; const bf16* kr = KR + (rb + j) * ROPE;
              for (int d = 0; d < 64; ++d) s += wl[d] * bf2f(kn[d]); for (int r = 0; r < 32; ++r) s += wl[64 + r] * bf2f(kr[r]); mx = fmaxf(mx, s); }
          for (int o_ = 1; o_ < 64; o_ <<= 1) mx = fmaxf(mx, __shfl_xor(mx, o_));
          float l = 0.f, o[8] = {0.f, 0.f, 0.f, 0.f, 0.f, 0.f, 0.f, 0.f}; const int dv0 = it & 7;
          for (int j = lane; j <= tl; j += 64) { float s = 0.f; const bf16* kn = KNV + (rb + j) * 1024 + h * 64; const bf16* kr = KR + (rb + j) * ROPE;
              for (int d = 0; d < 64; ++d) s += wl[d] * bf2f(kn[d]); for (int r = 0; r < 32; ++r) s += wl[64 + r] * bf2f(kr[r]);
              const float pj = exp2f(s - mx); l += pj; for (int i = 0; i < 8; ++i) o[i] += pj * bf2f(kn[512 + 8 * i + dv0]); }
          l = wave_sum(l); for (int i = 0; i < 8; ++i) { const float ov = wave_sum(o[i]) / l; if (lane == 0) dacc(a, bf2f(OATT[(rb + tl) * 512 + h * 64 + 8 * i + dv0]), ov); } }
      dflush(F, 6, a); }
    { DAcc a{0.f, 0.f};
      for (int it = gw; it < 32; it += NGW) { const int b = dh(it, 12) % DBATCH, tk = it & 7, h = dh(it, 13) & 7; const int trow = TP + b * 8 + tk;
          LDS_WAIT(); asm volatile("" ::: "memory");
          for (int i = 0; i < 4; ++i) wl[lane + 64 * i] = bf2f(QLAT[(size_t)(b * 8 + tk) * 2048 + h * 256 + lane + 64 * i]);
          if (lane < 16) { const bf16* qr = Q + (size_t)trow * 768 + h * 96; const float x1 = bf2f(qr[64 + lane]), x2 = bf2f(qr[80 + lane]); const float ang = (float)(PAST + tk) * powf(10000.f, -(float)lane / 16.f); const float c = cosf(ang), s = sinf(ang);
              wl[256 + lane] = x1 * c - x2 * s; wl[272 + lane] = x2 * c + x1 * s; }
          LDS_WAIT(); asm volatile("" ::: "memory");
          const int nk = PAST + tk + 1; const int c0 = dh(it, 14) & 63; float mx = -INFINITY, l = 0.f, o[4] = {0.f, 0.f, 0.f, 0.f};
          for (int pass = 0; pass < 2; ++pass) {
              for (int j = lane; j < nk; j += 64) { float s = 0.f; float cv[4];
                  if (j < PAST) { const int pg = p.page_table[b * NPAGES + (j >> 7)]; const float* cp = p.cache_c + ((size_t)pg * PAGE + (j & 127)) * KVLORA; const float* rp = p.cache_r + ((size_t)pg * PAGE + (j & 127)) * ROPE;
                      for (int c = 0; c < 256; ++c) s += wl[c] * cp[c]; for (int r = 0; r < 32; ++r) s += wl[256 + r] * rp[r]; for (int i = 0; i < 4; ++i) cv[i] = cp[c0 + 64 * i]; }
                  else { const int jn = j - PAST; const bf16* cp = CKV + (size_t)(TP + b * 8 + jn) * KVLORA; const bf16* rp = KR + (size_t)(TP + b * 8 + jn) * ROPE;
                      for (int c = 0; c < 256; ++c) s += wl[c] * bf2f(cp[c]); for (int r = 0; r < 32; ++r) s += wl[256 + r] * bf2f(rp[r]); for (int i = 0; i < 4; ++i) cv[i] = bf2f(cp[c0 + 64 * i]); }
                  if (pass == 0) mx = fmaxf(mx, s); else { const float pj = exp2f(s - mx); l += pj; for (int i = 0; i < 4; ++i) o[i] += pj * cv[i]; } }
              if (pass == 0) for (int o_ = 1; o_ < 64; o_ <<= 1) mx = fmaxf(mx, __shfl_xor(mx, o_)); }
          l = wave_sum(l); for (int i = 0; i < 4; ++i) { const float ov = wave_sum(o[i]) / l; if (lane == 0) dacc(a, bf2f(OLAT[(size_t)(b * 8 + tk) * 2048 + h * 256 + c0 + 64 * i]), ov); } }
      dflush(F, 7, a); }
    { DAcc a{0.f, 0.f};
      for (int it = gw; it < 256; it += NGW) { const int ts = dh(it, 15) % TS, n = dh(it, 16) % 512, h = n >> 6; float s = 0.f;
          for (int j = 0; j < 4; ++j) { const int c = lane + 64 * j; s += bf2f(OLAT[(size_t)ts * 2048 + h * 256 + c]) * p.w_uv[(size_t)c * 512 + n]; }
          s = wave_sum(s); if (lane == 0) dacc(a, bf2f(OATT[(size_t)(TP + ts) * 512 + n]), s); }
      dflush(F, 8, a); }
    { DAcc a9{0.f, 0.f}, a10{0.f, 0.f};
      for (int it = gw; it < 16; it += NGW) { const int b = it & 1, h = (it >> 1) & 7, pch = dh(it, 17) & 63, g2 = h >> 2; const float Ah = -expf(p.a_log[h]); const float dsk = p.d_skip[h];
          float h0 = 0.f, h1 = 0.f;
          for (int tl = 0; tl < SEQ; ++tl) { const size_t t = (size_t)b * SEQ + tl;
              if ((tl & 127) == 0) { const bf16* hp = HPREV + ((size_t)((b * NCHUNK + (tl >> 7)) * 8 + h) * 64 + pch) * 128; dacc(a9, bf2f(hp[lane]), h0); dacc(a9, bf2f(hp[lane + 64]), h1); }
              const float dt = DT[t * 8 + h]; const float x = bf2f(XBC[t * CONVD + h * 64 + pch]); const bf16* bp = XBC + t * CONVD + 512 + g2 * 128; const bf16* cp = XBC + t * CONVD + 768 + g2 * 128;
              const float dec = expf(dt * Ah); h0 = dec * h0 + x * dt * bf2f(bp[lane]); h1 = dec * h1 + x * dt * bf2f(bp[lane + 64]);
              float y = wave_sum(h0 * bf2f(cp[lane]) + h1 * bf2f(cp[lane + 64])) + dsk * x; const float z = bf2f(U[t * IN_PAD + O_Z + h * 64 + pch]); y = y * (z / (1.f + expf(-z)));
              if (lane == 0) dacc(a10, bf2f(YG[t * 512 + h * 64 + pch]), y); }
          const float* ho = p.out + OUT_SSP + ((size_t)(b * 8 + h) * 64 + pch) * 128; dacc(a9, ho[lane], h0); dacc(a9, ho[lane + 64], h1); }
      dflush(F, 9, a9); dflush(F, 10, a10); }
    { DAcc a{0.f, 0.f};
      for (int it = gw; it < 64; it += NGW) { const int b = dh(it, 18) % DBATCH, h = it & 7, pch = dh(it, 19) & 63, g2 = h >> 2; const float Ah = -expf(p.a_log[h]); const float dsk = p.d_skip[h];
          const float* hs = p.state_ssm + ((size_t)(b * 8 + h) * 64 + pch) * 128; float h0 = hs[lane], h1 = hs[lane + 64];
          for (int l = 0; l < 8; ++l) { const size_t t = (size_t)TP + b * 8 + l; const float dt = DT[t * 8 + h]; const float x = bf2f(XBC[t * CONVD + h * 64 + pch]); const bf16* bp = XBC + t * CONVD + 512 + g2 * 128; const bf16* cp = XBC + t * CONVD + 768 + g2 * 128;
              const float dec = expf(dt * Ah); h0 = dec * h0 + x * dt * bf2f(bp[lane]); h1 = dec * h1 + x * dt * bf2f(bp[lane + 64]);
              float y = wave_sum(h0 * bf2f(cp[lane]) + h1 * bf2f(cp[lane + 64])) + dsk * x; const float z = bf2f(U[t * IN_PAD + O_Z + h * 64 + pch]); y = y * (z / (1.f + expf(-z)));
              if (lane == 0) dacc(a, bf2f(YG[t * 512 + h * 64 + pch]), y); }
          const float* ho = p.out + OUT_SSS + ((size_t)(b * 8 + h) * 64 + pch) * 128; dacc(a, ho[lane], h0); dacc(a, ho[lane + 64], h1); }
      dflush(F, 11, a); }
    { DAcc a{0.f, 0.f};
      for (int it = gw; it < 64; it += NGW) { const int t = (it < 16) ? TP + (dh(it, 20) % TS) : dh(it, 21) % TALL;
          { float v[8]; float ss = 0.f; for (int i = 0; i < 8; ++i) { v[i] = bf2f(OATT[(size_t)t * 512 + lane + 64 * i]); ss += v[i] * v[i]; } const float r = rsqrtf(wave_sum(ss) / 512.f + 1e-6f);
            for (int i = 0; i < 8; ++i) dacc(a, bf2f(MIXA[(size_t)t * DM + lane + 64 * i]), v[i] * r * p.attn_out_norm[lane + 64 * i]); }
          for (int gi = 0; gi < 2; ++gi) { float v[4]; float ss = 0.f; for (int i = 0; i < 4; ++i) { v[i] = bf2f(YG[(size_t)t * 512 + gi * 256 + lane + 64 * i]); ss += v[i] * v[i]; } const float r = rsqrtf(wave_sum(ss) / 256.f + 1e-6f);
            for (int i = 0; i < 4; ++i) dacc(a, bf2f(MIXA[(size_t)t * DM + 512 + gi * 256 + lane + 64 * i]), v[i] * r * p.ssm_norm[gi * 256 + lane + 64 * i]); } }
      dflush(F, 12, a); }
    { DAcc a{0.f, 0.f}, b15{0.f, 0.f}, b18{0.f, 0.f}, b20{0.f, 0.f};
      for (int it = gw; it < 512; it += NGW) { const int t = dh(it, 22) % TALL, n = dh(it, 23) % DM, n2 = dh(it, 24) % 2048; float s = 0.f, s15 = 0.f, s18 = 0.f, s20 = 0.f;
          for (int j = 0; j < 16; ++j) { const int k = lane + 64 * j; s += bf2f(MIXA[(size_t)t * DM + k]) * p.w_out[(size_t)k * DM + n]; s15 += bf2f(H1B[(size_t)t * DM + k]) * p.mem_wq[(size_t)k * DM + n];
              s18 += bf2f(OM[(size_t)t * DM + k]) * p.mem_wo[(size_t)k * DM + n]; s20 += bf2f(H2B[(size_t)t * DM + k]) * p.peer_wq[(size_t)k * 2048 + n2]; }
          s = wave_sum(s); s15 = wave_sum(s15) * 0.0625f * LOG2E; s18 = wave_sum(s18); s20 = wave_sum(s20);
          if (lane == 0) { dacc(a, bf2f(MIX[(size_t)t * DM + n]), s); dacc(b15, bf2f(QM[(size_t)t * DM + n]), s15); dacc(b18, bf2f(MIX2[(size_t)t * DM + n]), s18); dacc(b20, bf2f(PQ[(size_t)t * 2048 + n2]), s20); } }
      dflush(F, 13, a); dflush(F, 15, b15); dflush(F, 18, b18); dflush(F, 20, b20); }
    { DAcc a14{0.f, 0.f}, a19{0.f, 0.f};
      for (int it = gw; it < 64; it += NGW) { const int t = (it < 8) ? TP + (dh(it, 25) % TS) : dh(it, 26) % TALL;
          for (int w2 = 0; w2 < 2; ++w2) { float v[16]; float s = 0.f;
              for (int i = 0; i < 16; ++i) { const int e = lane + 64 * i; v[i] = w2 == 0 ? DN_ALPHA * xin(p, t, e) + bf2f(MIX[(size_t)t * DM + e]) : DN_ALPHA * bf2f(H1B[(size_t)t * DM + e]) + bf2f(MIX2[(size_t)t * DM + e]); s += v[i]; }
              const float mean = wave_sum(s) / DM; float s2 = 0.f; for (int i = 0; i < 16; ++i) { v[i] -= mean; s2 += v[i] * v[i]; } const float rstd = rsqrtf(wave_sum(s2) / DM + 1e-5f);
              for (int i = 0; i < 16; ++i) { const int e = lane + 64 * i; if (w2 == 0) { const float rf = v[i] * rstd * p.ln1_g[e] + p.ln1_b[e]; dacc(a14, bf2f(H1B[(size_t)t * DM + e]), rf); }
                  else { const float rf = v[i] * rstd * p.ln2_g[e] + p.ln2_b[e]; dacc(a19, bf2f(H2B[(size_t)t * DM + e]), rf); } } } }
      dflush(F, 14, a14); dflush(F, 19, a19); }
    { DAcc a{0.f, 0.f};
      for (int it = gw; it < 256; it += NGW) { const int r = dh(it, 27) % 512, n = dh(it, 28) % 2048; float s = 0.f;
          for (int j = 0; j < 16; ++j) { const int k = lane + 64 * j; s += p.mem_prompt[(size_t)r * DM + k] * (n < 1024 ? p.mem_wk[(size_t)k * DM + n] : p.mem_wv[(size_t)k * DM + n - 1024]); }
          s = wave_sum(s); if (lane == 0) { dacc(a, n < 1024 ? bf2f(MK[(size_t)r * DM + n]) : bf2f(MV[(size_t)r * DM + n - 1024]), s); dacc(a, n < 1024 ? p.out[OUT_MKP + (size_t)r * DM + n] : p.out[OUT_MVP + (size_t)r * DM + n - 1024], s); } }
      dflush(F, 16, a); }
    { DAcc a{0.f, 0.f};
      for (int it = gw; it < 64; it += NGW) { const int t = (it < 32) ? TP + (dh(it, 29) % TS) : dh(it, 30) % TP; const int hm = it & 3; const bool smp = t >= TP; const int b = smp ? (t - TP) >> 3 : t >> 13;
          LDS_WAIT(); asm volatile("" ::: "memory");
          for (int i = 0; i < 4; ++i) wl[lane + 64 * i] = bf2f(QM[(size_t)t * DM + hm * 256 + lane + 64 * i]);
          LDS_WAIT(); asm volatile("" ::: "memory");
          float sc[4]; float mx = -INFINITY;
          for (int i = 0; i < 4; ++i) { const int m = lane + 64 * i; float s = 0.f;
              if (smp) { const float* kp = p.cache_mk + (((size_t)b * NMEM + m) * MH + hm) * MHD; for (int d = 0; d < 256; ++d) s += wl[d] * kp[d]; }
              else { const bf16* kp = MK + ((size_t)b * NMEM + m) * DM + hm * 256; for (int d = 0; d < 256; ++d) s += wl[d] * bf2f(kp[d]); }
              sc[i] = s; mx = fmaxf(mx, s); }
          for (int o_ = 1; o_ < 64; o_ <<= 1) mx = fmaxf(mx, __shfl_xor(mx, o_));
          float l = 0.f, o[4] = {0.f, 0.f, 0.f, 0.f}; const int dv0 = dh(it, 31) & 63;
          for (int i = 0; i < 4; ++i) { const int m = lane + 64 * i; const float pj = exp2f(sc[i] - mx); l += pj;
              for (int q = 0; q < 4; ++q) { const int dv = dv0 + 64 * q; const float vv = smp ? p.cache_mv[(((size_t)b * NMEM + m) * MH + hm) * MHD + dv] : bf2f(MV[((size_t)b * NMEM + m) * DM + hm * 256 + dv]); o[q] += pj * vv; } }
          l = wave_sum(l); for (int q = 0; q < 4; ++q) { const float ov = wave_sum(o[q]) / l; if (lane == 0) dacc(a, bf2f(OM[(size_t)t * DM + hm * 256 + dv0 + 64 * q]), ov); } }
      dflush(F, 17, a); }
    { DAcc a{0.f, 0.f};
      for (int it = gw; it < 256; it += NGW) { const int t = dh(it, 32) % TALL, gg = it & 15; float s0 = 0.f, s1 = 0.f;
          for (int d = 0; d < 128; ++d) { const float qv = bf2f(PQ[(size_t)t * 2048 + gg * 128 + d]); s0 += qv * p.peer_keys[((size_t)gg * 128 + lane) * 128 + d]; s1 += qv * p.peer_keys[((size_t)gg * 128 + lane + 64) * 128 + d]; }
          const float* tp = TOPS + ((size_t)t * 16 + gg) * 16; float vmin = INFINITY;
          for (int i = 0; i < 16; ++i) { const unsigned u = __float_as_uint(tp[i]); const int id = (int)(u & 127u); const float v = __uint_as_float(u & ~127u); const float sr = __shfl(id < 64 ? s0 : s1, id & 63); if (lane == 0) dacc(a, v, sr); vmin = fminf(vmin, v); }
          int cnt = (s0 > vmin + 0.05f ? 1 : 0) + (s1 > vmin + 0.05f ? 1 : 0); for (int o_ = 1; o_ < 64; o_ <<= 1) cnt += __shfl_xor(cnt, o_);
          if (lane == 0 && cnt > 15) dacc(a, 100.f, 0.f); }
      dflush(F, 21, a); }
    { DAcc a{0.f, 0.f};
      for (int it = gw; it < 256; it += NGW) { const int t = dh(it, 33) % TALL, h = it & 7; const float* ta = TOPS + ((size_t)t * 16 + 2 * h) * 16; const float* tb = ta + 16;
          float cs[4]; int ce[4];
          for (int m = 0; m < 4; ++m) { const int idx = lane + 64 * m, i = idx >> 4, j = idx & 15; const unsigned ua = __float_as_uint(ta[i]), ub = __float_as_uint(tb[j]); cs[m] = __uint_as_float(ua & ~127u) + __uint_as_float(ub & ~127u); ce[m] = (int)(ua & 127u) * NKEYS + (int)(ub & 127u); }
          float rs_[16]; int re_[16];
          for (int r = 0; r < 16; ++r) { float bm = fmaxf(fmaxf(cs[0], cs[1]), fmaxf(cs[2], cs[3])); float wm = bm; for (int o_ = 1; o_ < 64; o_ <<= 1) wm = fmaxf(wm, __shfl_xor(wm, o_));
              const unsigned long long bal = __ballot(bm == wm); const int owner = __ffsll((long long)bal) - 1; int eid = 0;
              if (lane == owner) { bool done = false; for (int m = 0; m < 4; ++m) if (!done && cs[m] == wm) { eid = ce[m]; cs[m] = -INFINITY; done = true; } }
              eid = __shfl(eid, owner); rs_[r] = wm; re_[r] = eid; }
          float den = 0.f; for (int r = 0; r < 16; ++r) den += expf(rs_[r] - rs_[0]);
          if (lane < 16) { const int fe = PIDX[((size_t)t * 8 + h) * 16 + lane]; const float fg = PG[((size_t)t * 8 + h) * 16 + lane]; float rg = 0.f; for (int r = 0; r < 16; ++r) if (re_[r] == fe) rg = expf(rs_[r] - rs_[0]) / den; dacc(a, fg, rg); } }
      dflush(F, 22, a); }
    { DAcc a{0.f, 0.f};
      for (int it = gw; it < 64; it += NGW) { const int t = (it < 8) ? TP + (dh(it, 34) % TS) : dh(it, 35) % TALL; float x[16], o[16];
          for (int i = 0; i < 16; ++i) { x[i] = bf2f(H2B[(size_t)t * DM + lane + 64 * i]); o[i] = 0.f; }
          for (int k = 0; k < 128; ++k) { const int e = PIDX[(size_t)t * 128 + k]; const float* ur = p.peer_u + (size_t)e * DM; const float* vr = p.peer_v + (size_t)e * DM; float s = 0.f; for (int i = 0; i < 16; ++i) s += x[i] * ur[lane + 64 * i];
              s = wave_sum(s); const float wgt = PG[(size_t)t * 128 + k] * gelu_ref(s); for (int i = 0; i < 16; ++i) o[i] += wgt * vr[lane + 64 * i]; }
          float s = 0.f; for (int i = 0; i < 16; ++i) { o[i] += DN_ALPHA * bf2f(H2B[(size_t)t * DM + lane + 64 * i]); s += o[i]; }
          const float mean = wave_sum(s) / DM; float s2 = 0.f; for (int i = 0; i < 16; ++i) { o[i] -= mean; s2 += o[i] * o[i]; } const float rstd = rsqrtf(wave_sum(s2) / DM + 1e-5f);
          for (int i = 0; i < 16; ++i) { const int e = lane + 64 * i; dacc(a, p.out[OUT_YP + (size_t)t * DM + e], o[i] * rstd * p.ln3_g[e] + p.ln3_b[e]); } }
      dflush(F, 23, a); }
    xcd_barrier(bar);
    { const float* dg = (const float*)(F.ctl + CW_DIAG); int fk = 0; float frel = 0.f;
      for (int k = NCHK - 1; k >= 1; --k) { const float d = __hip_atomic_load(dg + 2 * k, __ATOMIC_RELAXED, __HIP_MEMORY_SCOPE_AGENT), r = __hip_atomic_load(dg + 2 * k + 1, __ATOMIC_RELAXED, __HIP_MEMORY_SCOPE_AGENT);
          const float rel = sqrtf(d / fmaxf(r, 1e-30f)); const bool bad = !(rel <= 0.03f) || !(r > 0.f); if (bad) { fk = k; frel = rel; } }
      if (fk > 0) { int dgt = 1; if (frel == frel && frel < 1.f) { const float lg = -log10f(fmaxf(frel, 1e-9f)); dgt = 1 + (int)fminf(floorf(lg), 8.f); }
          const float D = ((float)dgt + 0.5f) * powf(10.f, (float)(5 + fk));
          const size_t gt = (size_t)F.vcu * NTHR + F.tid, NGT = (size_t)F.G * NTHR; for (size_t i = gt; i < (size_t)TS * DM; i += NGT) p.out[OUT_YS + i] = D; } }
}
#endif

#ifndef MK_SINGLE
#define MK_SINGLE 1
#endif
#ifndef MK_DIAG
#define MK_DIAG 0
#endif
constexpr int NPHASE = 19 + MK_DIAG;
__global__ void __launch_bounds__(NTHR, 2) mk_fwd(Args args) {
    extern __shared__ __attribute__((aligned(16))) unsigned char lds[];
    Frame F;
    F.lds = (LAS unsigned char*)lds;
    F.MISC = (volatile LAS unsigned*)(F.lds + MISC_OFF);
    F.tid = threadIdx.x; F.lane = F.tid & 63; F.wave = __builtin_amdgcn_readfirstlane(F.tid >> 6);
    F.G = gridDim.x; { const int bx = blockIdx.x; F.vcu = (F.G % 8 == 0) ? (bx % 8) * (F.G / 8) + bx / 8 : bx; }
    F.ctl = (gu32*)(args.ws + WS_CTL);
    P p;
    { const void* const* in = args.in;
      p.x_prompt = (const float*)in[0]; p.x_sample = (const float*)in[1]; p.mem_prompt = (const float*)in[2]; p.cache_c = (const float*)in[3]; p.cache_r = (const float*)in[4];
      p.state_conv = (const float*)in[5]; p.state_ssm = (const float*)in[6]; p.cache_mk = (const float*)in[7]; p.cache_mv = (const float*)in[8]; p.page_table = (const int*)in[9];
      p.w_in = (const float*)in[10]; p.q_a_norm = (const float*)in[11]; p.w_uq = (const float*)in[12]; p.kv_a_norm = (const float*)in[13]; p.w_uk = (const float*)in[14];
      p.w_uv = (const float*)in[15]; p.attn_out_norm = (const float*)in[16]; p.conv_w = (const float*)in[17]; p.conv_b = (const float*)in[18]; p.dt_bias = (const float*)in[19];
      p.a_log = (const float*)in[20]; p.d_skip = (const float*)in[21]; p.ssm_norm = (const float*)in[22]; p.w_out = (const float*)in[23]; p.ln1_g = (const float*)in[24];
      p.ln1_b = (const float*)in[25]; p.mem_wq = (const float*)in[26]; p.mem_wk = (const float*)in[27]; p.mem_wv = (const float*)in[28]; p.mem_wo = (const float*)in[29];
      p.ln2_g = (const float*)in[30]; p.ln2_b = (const float*)in[31]; p.peer_wq = (const float*)in[32]; p.peer_keys = (const float*)in[33]; p.peer_u = (const float*)in[34];
      p.peer_v = (const float*)in[35]; p.ln3_g = (const float*)in[36]; p.ln3_b = (const float*)in[37]; p.out = args.out; p.ws = args.ws; }
    unsigned char* ws = args.ws;
    for (int u = F.tid; u < (LDS_BYTES - LDSCTL_OFF) / 4; u += NTHR) ((LAS unsigned*)(F.lds + LDSCTL_OFF))[u] = 0u;
    __syncthreads();
    const int lo = args.ph_lo, hi = args.ph_hi;
    { F.xcc = (int)xb_xcc_id(); if (F.tid == 0) F.MISC[1] = __hip_atomic_fetch_add(F.ctl + CW_XRANK + 64 * F.xcc, 1u, RLX_AGENT); __syncthreads(); F.xrank = (int)F.MISC[1]; }
    XcdBarrier bar; bar.bar = (unsigned*)(F.ctl + CW_BAR); bar.x = 0; bar.st = nullptr;
    if (hi - lo > 1) bar = xcd_barrier_post((unsigned*)(F.ctl + CW_BAR), F.MISC + 8);
#ifndef ONLY_PHASE
#define ONLY_PHASE -1
#endif
#define IN(k) ((ONLY_PHASE < 0 || ONLY_PHASE == (k)) && lo <= (k) && (k) < hi)
#ifndef PROBE_DUP
#define PROBE_DUP -1
#endif
#ifndef PROBE_DUP2
#define PROBE_DUP2 -1
#endif
#ifndef PROBE_DUP3
#define PROBE_DUP3 -1
#endif
#define REP(k) for (int rep_ = 0; rep_ < ((PROBE_DUP == (k) || PROBE_DUP2 == (k) || PROBE_DUP3 == (k)) ? 2 : 1); ++rep_)
#ifndef PROBE_G
#define PROBE_G 0
#endif
#define DUPG(bit, stmt) do { stmt; if (PROBE_G & (bit)) { stmt; } } while (0)
#define BOTH(k) (IN(k) && IN((k) + 1))
#define SEAM(k) do { if (BOTH(k)) xcd_barrier(bar); } while (0)
#define GEMM_BF16(Aptr, Btptr, M_, N_, K_, Optr, ldc_, scale_, cshift) do { pg8::Gemm g_{(const bf16*)(Aptr), (const bf16*)(Btptr), (M_), (N_), (K_)}; pg8::StaticOrder S_; \
        S_.init((M_), (N_), F.G, (int)((blockIdx.x + (unsigned)F.G - (unsigned)(cshift)) % (unsigned)F.G)); EpiGen8<StoreBf16> E_{StoreBf16{(bf16*)(Optr), (ldc_), (scale_)}}; \
        pg8::gemm_phase<EpiGen8<StoreBf16>, pg8::StaticOrder, true, true>(F.lds + RING_OFF, g_, S_, E_); __syncthreads(); } while (0)

    if (IN(0)) { REP(0) p0_prologue(F, p); SEAM(0); }

    if (IN(1)) {
        REP(1) GEMM_BF16(ws + WS_XB, ws + WS_WIN, TALL, IN_PAD, DM, ws + WS_U, IN_PAD, 1.f, 0);
        { pg8::Gemm g{(const bf16*)(ws + WS_MEMB), (const bf16*)(ws + WS_MWKV), 512, 2048, DM}; pg8::StaticOrder S; S.init(512, 2048, F.G, (int)((blockIdx.x + 128u) % (unsigned)F.G));
          EpiGen8<StoreMemKV> E{StoreMemKV{p.out + OUT_MKP, p.out + OUT_MVP, (bf16*)(ws + WS_MK), (bf16*)(ws + WS_MV)}};
          pg8::gemm_phase<EpiGen8<StoreMemKV>, pg8::StaticOrder, true, true>(F.lds + RING_OFF, g, S, E); }
        SEAM(1); }

    if (IN(2)) { REP(2) p2_rows(F, p); SEAM(2); }

    if (IN(3)) {
#ifndef P3SEL
#define P3SEL 15
#endif
        if (P3SEL & 1) GEMM_BF16(ws + WS_CQN, ws + WS_WUQ, TALL, 768, QLORA, ws + WS_Q, 768, MLA_SCALE * LOG2E, 0);
        if (P3SEL & 2) GEMM_BF16(ws + WS_CKV, ws + WS_WKV, TP, 1024, KVLORA, ws + WS_KNV, 1024, 1.f, 0);
        if (P3SEL & 4) GEMM_BF16((const bf16*)(ws + WS_CQN) + (size_t)TP * QLORA, ws + WS_WABS, TS, 2048, QLORA, ws + WS_QLAT, 2048, MLA_SCALE * LOG2E, 204);
        if (P3SEL & 8) for (int u = F.vcu; u < 2 * NCHUNK * 8; u += F.G) ssd_a_unit(F, p, u >> 9, (u >> 3) & 63, u & 7);
        SEAM(3); }

    if (IN(4)) {
        REP(40) ssd_b_scan(F, p);
#ifndef P4_MODE
#define P4_MODE 0
#endif
#ifndef P4_SMAX
#define P4_SMAX 64
#endif
        if (P4_MODE == 1) { REP(41) for (int u = F.vcu; u < 256; u += F.G) attn_merged(F, p, u); }
        else if (P4_MODE == 2 && F.G == 256) {
            if (F.vcu < 192) { const int bh = F.vcu / 12, gsel = F.vcu % 12; const int b_ = bh >> 3, h_ = bh & 7;
                if (gsel < 10) { attn_prompt_unit(F, p, b_, h_, 31 - gsel); attn_prompt_unit(F, p, b_, h_, 11 + gsel); }
                else if (gsel == 10) { attn_prompt_unit(F, p, b_, h_, 21); attn_prompt_unit(F, p, b_, h_, 10); attn_prompt_unit(F, p, b_, h_, 9); attn_prompt_unit(F, p, b_, h_, 0); }
                else { for (int q_ = 8; q_ >= 1; --q_) attn_prompt_unit(F, p, b_, h_, q_); } }
            else { for (int i_ = 0; i_ < 4; ++i_) { const int job = (F.vcu - 192) + 64 * i_; attn_sample_unit(F, p, job >> 1, job & 1); } }
        } else {
        REP(41) for (int u = F.vcu; u < 256; u += F.G) { const int bh = u >> 4, s = u & 15; attn_prompt_unit(F, p, bh >> 3, bh & 7, 31 - s); attn_prompt_unit(F, p, bh >> 3, bh & 7, s); }
        REP(42) for (int u = F.vcu; u < 256; u += F.G) attn_sample_unit(F, p, u >> 1, u & 1);
        }
        SEAM(4); }

    if (IN(5)) {
        REP(50) attn_sample_finish(F, p);
        REP(51) for (int u = F.vcu; u < 2 * NCHUNK * 8; u += F.G) ssd_c_unit(F, p, u >> 9, (u >> 3) & 63, u & 7);
        REP(52) for (int u = F.vcu; u < DBATCH * 8; u += F.G) ssd_sample_unit(F, p, u >> 3, u & 7);
        SEAM(5); }

    if (IN(5) && IN(6)) {   }

    if (IN(7)) { REP(7) mixa_rows(F, p); SEAM(7); }

    if (IN(8)) { DUPG(1, GEMM_BF16(ws + WS_MIXA, ws + WS_WOUT, TP, DM, DM, ws + WS_MIX, DM, 1.f, 0)); small_gemm(F, (const bf16*)(ws + WS_MIXA) + (size_t)TP * DM, (const bf16*)(ws + WS_WOUT), TS, DM, DM, (bf16*)(ws + WS_MIX) + (size_t)TP * DM, DM, 1.f); SEAM(8); }

    if (IN(9)) { REP(9) ln_rows(F, (const bf16*)(ws + WS_XB), (const bf16*)(ws + WS_MIX), p.ln1_g, p.ln1_b, (bf16*)(ws + WS_H1B), nullptr); SEAM(9); }

    if (IN(10)) { DUPG(1, GEMM_BF16(ws + WS_H1B, ws + WS_MWQ, TP, DM, DM, ws + WS_QM, DM, 0.0625f * LOG2E, 0)); small_gemm(F, (const bf16*)(ws + WS_H1B) + (size_t)TP * DM, (const bf16*)(ws + WS_MWQ), TS, DM, DM, (bf16*)(ws + WS_QM) + (size_t)TP * DM, DM, 0.0625f * LOG2E); SEAM(10); }

    if (IN(11)) {
        REP(111) for (int u = F.vcu; u < 512; u += F.G) mem_attn_prompt_unit(F, p, u >> 8, (u >> 6) & 3, u & 63);
        REP(112) for (int u = F.vcu; u < 512; u += F.G) mem_attn_sample_unit(F, p, u >> 2, u & 3);
        SEAM(11); }

    if (IN(12)) { DUPG(1, GEMM_BF16(ws + WS_OM, ws + WS_MWO, TP, DM, DM, ws + WS_MIX2, DM, 1.f, 0)); small_gemm(F, (const bf16*)(ws + WS_OM) + (size_t)TP * DM, (const bf16*)(ws + WS_MWO), TS, DM, DM, (bf16*)(ws + WS_MIX2) + (size_t)TP * DM, DM, 1.f); SEAM(12); }

    if (IN(13)) { REP(13) ln_rows(F, (const bf16*)(ws + WS_H1B), (const bf16*)(ws + WS_MIX2), p.ln2_g, p.ln2_b, (bf16*)(ws + WS_H2B), nullptr); SEAM(13); }

    if (IN(14)) { DUPG(2, GEMM_BF16(ws + WS_H2B, ws + WS_PWQ, TP, 2048, DM, ws + WS_PQ, 2048, 1.f, 0)); small_gemm(F, (const bf16*)(ws + WS_H2B) + (size_t)TP * DM, (const bf16*)(ws + WS_PWQ), TS, 2048, DM, (bf16*)(ws + WS_PQ) + (size_t)TP * 2048, 2048, 1.f); SEAM(14); }

    if (IN(15)) { REP(15) for (int u = F.vcu; u < 68 * 16; u += F.G) peer_scores_unit(F, p, u >> 4, u & 15); SEAM(15); }

    if (IN(16)) { REP(16) peer_cand(F, p); SEAM(16); }

    if (IN(17)) {
        bool regular = (F.G % 8 == 0);
        for (int j = 0; j < 16; ++j) { const unsigned c = __hip_atomic_load(F.ctl + CW_XRANK + 64 * j, RLX_AGENT); regular = regular && (c == (j < 8 ? (unsigned)(F.G / 8) : 0u)); }
#ifdef FORCE_REGULAR
        regular = true;
#endif
        if (regular) peer_pass_a(F, p, F.xcc, F.xcc + 1, F.xrank, F.G / 8); else peer_pass_a(F, p, 0, 8, (int)blockIdx.x, F.G);
        SEAM(17); }
    if (IN(18)) { peer_pass_b(F, p); SEAM(18); }
#if MK_DIAG
    if (IN(19)) { diag_phase(F, p, bar); }
#endif
#undef IN
#undef BOTH
#undef SEAM
}

extern "C" void kernel_launch(void* const* d_in, const int* in_sizes, int n_in, void* d_out, int out_size, void* d_ws, size_t ws_size, hipStream_t stream) {
    static int grid = 0;
    if (grid == 0) {
        if (n_in != 38 || (size_t)out_size != OUT_END || ws_size < WS_END2) { fprintf(stderr, "kernel_launch: unexpected shapes: n_in %d out %d (want %zu) ws %zu (want %zu)\n", n_in, out_size, (size_t)OUT_END, ws_size, (size_t)WS_END); grid = -1; return; }
        int dev = 0, cus = 0, per_cu = 0;
        if (hipGetDevice(&dev) != hipSuccess || hipDeviceGetAttribute(&cus, hipDeviceAttributeMultiprocessorCount, dev) != hipSuccess) { grid = -1; return; }
        if (hipFuncSetAttribute((const void*)mk_fwd, hipFuncAttributeMaxDynamicSharedMemorySize, LDS_BYTES) != hipSuccess) { fprintf(stderr, "kernel_launch: hipFuncSetAttribute failed\n"); grid = -1; return; }
        if (hipOccupancyMaxActiveBlocksPerMultiprocessor(&per_cu, (const void*)mk_fwd, NTHR, LDS_BYTES) != hipSuccess || per_cu < 1) { fprintf(stderr, "kernel_launch: occupancy query says %d\n", per_cu); }
        (void)hipGetLastError();
        grid = cus;
    }
    if (grid < 0) return;
    (void)hipMemsetAsync((char*)d_ws + WS_CTL, 0, CTL_ZERO_BYTES, stream);
    Args a{};
    for (int i = 0; i < 38; ++i) a.in[i] = d_in[i];
    a.out = (float*)d_out; a.ws = (unsigned char*)d_ws;
#if MK_SINGLE
    a.ph_lo = 0; a.ph_hi = NPHASE;
    hipLaunchKernelGGL(mk_fwd, dim3(grid), dim3(NTHR), LDS_BYTES, stream, a);
#else
    for (int ph = 0; ph < NPHASE; ++ph) { a.ph_lo = ph; a.ph_hi = ph + 1; hipLaunchKernelGGL(mk_fwd, dim3(grid), dim3(NTHR), LDS_BYTES, stream, a); }
#endif
}
```
